# Optimizing an MI355X kernel written in HIP

```python
import math
import jax, jax.numpy as jnp
from jax import lax
import numpy as np

D_MODEL = 1024
BATCH = 16
SEQ = 2048
DEPTH = 2

CHUNK = 64
Q_BLOCK = 128
N_MIXERS = 2
ATTN_HEADS = 8
ATTN_HEAD_DIM = D_MODEL // (2 * ATTN_HEADS)
ALIBI_MAX_BIAS = 8.0
MLSTM_INNER = 2 * D_MODEL
MLSTM_HEADS = 4
MLSTM_HEAD_DIM = MLSTM_INNER // MLSTM_HEADS
MLSTM_CONV = 4
QKV_BLOCK = 4
FFN_DENSE = ((8 * D_MODEL // 3 + 127) // 128) * 128
N_EXPERTS = 8
TOP_K = 2
FFN_EXPERT = 7 * D_MODEL // 2
N_ATTN_LAYERS = (DEPTH + 1) // 2
N_MLSTM_LAYERS = DEPTH // 2
NORM_EPS = 1e-6

kernel_name = 'hybrid_diffattn_mlstm_moe_trunk'


def rmsnorm(x, g):
    xf = x.astype(jnp.float32)
    y = xf * lax.rsqrt(jnp.mean(xf * xf, axis=-1, keepdims=True) + NORM_EPS)
    return (y * g.astype(jnp.float32)).astype(x.dtype)


def head_layernorm(x, g):
    xf = x.astype(jnp.float32)
    mu = jnp.mean(xf, axis=-1, keepdims=True)
    var = jnp.mean(jnp.square(xf - mu), axis=-1, keepdims=True)
    return (xf - mu) * lax.rsqrt(var + NORM_EPS) * g.astype(jnp.float32)


def modulate(x, shift, scale):
    return x * (1.0 + scale[:, None, :]) + shift[:, None, :]


def swiglu(h, w_gate, w_up, w_down):
    return (jax.nn.silu(h @ w_gate) * (h @ w_up)) @ w_down


def alibi_slopes(n_heads):
    return jnp.exp2(-ALIBI_MAX_BIAS * jnp.arange(1, n_heads + 1, dtype=jnp.float32) / n_heads)


def diff_attention(h, w_in, w_out, lam, subln_g, lambda_init):
    B, S, D = h.shape
    H, DA = ATTN_HEADS, ATTN_HEAD_DIM
    q, k, v = jnp.split(h @ w_in, 3, axis=-1)
    q = q.reshape(B, S, H, 2, DA) * (DA ** -0.5)
    k = k.reshape(B, S, H, 2, DA)
    v = v.reshape(B, S, H, 2 * DA)
    lam_f = lam.astype(jnp.float32)
    lam_full = (jnp.exp(jnp.sum(lam_f[0] * lam_f[1])) - jnp.exp(jnp.sum(lam_f[2] * lam_f[3]))
                + lambda_init)
    slopes = alibi_slopes(H)
    key_pos = jnp.arange(S)
    n_blk = S // Q_BLOCK
    q_blocks = jnp.moveaxis(q.reshape(B, n_blk, Q_BLOCK, H, 2, DA), 1, 0)

    def one_block(args):
        q_blk, blk = args
        qpos = blk * Q_BLOCK + jnp.arange(Q_BLOCK)
        dist = jnp.abs(qpos[:, None] - key_pos[None, :]).astype(jnp.float32)
        allowed = (key_pos[None, :] // CHUNK) <= (qpos[:, None] // CHUNK)
        bias = jnp.where(allowed[None], -slopes[:, None, None] * dist[None], -jnp.inf)
        s = jnp.einsum('bqhcd,bkhcd->bhcqk', q_blk, k, preferred_element_type=jnp.float32)
        p = jax.nn.softmax(s + bias[None, :, None], axis=-1)
        a = p[:, :, 0] - lam_full * p[:, :, 1]
        return jnp.einsum('bhqk,bkhe->bqhe', a.astype(v.dtype), v)

    o = lax.map(one_block, (q_blocks, jnp.arange(n_blk)))
    o = jnp.moveaxis(o, 0, 1).reshape(B, S, H, 2 * DA)
    o = rmsnorm(o, subln_g) * (1.0 - lambda_init)
    return o.reshape(B, S, D) @ w_out


def mlstm_cell(q, k, v, i_pre, f_pre):
    B, S, NH, DH = q.shape
    L = CHUNK
    NC = S // L

    def to_chunks(t):
        t = t.astype(jnp.float32).reshape((B, NC, L) + t.shape[2:])
        return jnp.moveaxis(jnp.moveaxis(t, 1, 0), 3, 2)

    qc = to_chunks(q)
    kc = to_chunks(k) * (DH ** -0.5)
    vc = to_chunks(v)
    ic = to_chunks(i_pre)
    bc = jnp.cumsum(jax.nn.log_sigmoid(to_chunks(f_pre)), axis=-1)
    causal = jnp.tril(jnp.ones((L, L), dtype=bool))

    def step(carry, inp):
        C, n, m = carry
        q_, k_, v_, i_, b_ = inp
        dlog = jnp.where(causal, b_[..., :, None] - b_[..., None, :] + i_[..., None, :], -jnp.inf)
        g = b_ + m[..., None]
        m_t = jnp.maximum(g, jnp.max(dlog, axis=-1))
        w = jnp.exp(dlog - m_t[..., None]) * jnp.einsum('bhtd,bhsd->bhts', q_, k_)
        inter = jnp.exp(g - m_t)
        num = (jnp.einsum('bhts,bhsd->bhtd', w, v_)
               + inter[..., None] * jnp.einsum('bhvd,bhtd->bhtv', C, q_))
        den = jnp.sum(w, axis=-1) + inter * jnp.einsum('bhd,bhtd->bht', n, q_)
        h = num / jnp.maximum(jnp.abs(den), jnp.exp(-m_t))[..., None]
        b_last = b_[..., -1]
        w_state = b_last[..., None] - b_ + i_
        m_new = jnp.maximum(b_last + m, jnp.max(w_state, axis=-1))
        decay = jnp.exp(b_last + m - m_new)
        ws = jnp.exp(w_state - m_new[..., None])
        C_new = decay[..., None, None] * C + jnp.einsum('bhsv,bhsd->bhvd', v_ * ws[..., None], k_)
        n_new = decay[..., None] * n + jnp.einsum('bhs,bhsd->bhd', ws, k_)
        return (C_new, n_new, m_new), h

    init = (jnp.zeros((B, NH, DH, DH), jnp.float32),
            jnp.zeros((B, NH, DH), jnp.float32),
            jnp.zeros((B, NH), jnp.float32))
    _, hs = lax.scan(step, init, (qc, kc, vc, ic, bc))
    hs = jnp.moveaxis(jnp.moveaxis(hs, 2, 3), 0, 1)
    return hs.reshape(B, S, NH, DH)


def mlstm_layer(h, w_in, conv_w, conv_b, w_q, w_k, w_v, w_gate, b_gate, skip, norm_g, w_out):
    B, S, _ = h.shape
    NH, DH = MLSTM_HEADS, MLSTM_HEAD_DIM
    x_m, z = jnp.split(h @ w_in, 2, axis=-1)
    xp = jnp.pad(x_m, ((0, 0), (MLSTM_CONV - 1, 0), (0, 0)))
    conv = sum(xp[:, j:j + S] * conv_w[j] for j in range(MLSTM_CONV)) + conv_b
    x_c = jax.nn.silu(conv)

    def headwise(t, w):
        return jnp.einsum('bsgi,gio->bsgo', t.reshape(B, S, -1, QKV_BLOCK), w).reshape(B, S, MLSTM_INNER)

    q = headwise(x_c, w_q)
    k = headwise(x_c, w_k)
    v = headwise(x_m, w_v)
    gates = (jnp.concatenate([q, k, v], axis=-1) @ w_gate + b_gate).astype(jnp.float32)
    i_pre, f_pre = gates[..., :NH], gates[..., NH:]
    hh = mlstm_cell(q.reshape(B, S, NH, DH), k.reshape(B, S, NH, DH), v.reshape(B, S, NH, DH), i_pre, f_pre)
    hh = head_layernorm(hh, norm_g.reshape(NH, DH)).reshape(B, S, MLSTM_INNER).astype(x_c.dtype)
    out = (hh + skip * x_c) * jax.nn.silu(z)
    return out @ w_out


def moe_swiglu(h, w_router, b_router, w_gate, w_up, w_down):
    B, S, D = h.shape
    t = h.reshape(B * S, D)
    logits = (t @ w_router).astype(jnp.float32) + b_router.astype(jnp.float32)
    probs = jax.nn.softmax(logits, axis=-1)
    top_p, top_i = lax.top_k(probs, TOP_K)
    top_p = top_p / jnp.sum(top_p, axis=-1, keepdims=True)
    combine = jnp.sum(jax.nn.one_hot(top_i, N_EXPERTS, dtype=jnp.float32) * top_p[..., None], axis=1)
    y = jnp.zeros_like(t)
    for e in range(N_EXPERTS):
        y = y + combine[:, e:e + 1].astype(t.dtype) * swiglu(t, w_gate[e], w_up[e], w_down[e])
    return y.reshape(B, S, D)


def setup_inputs(seed: int = 0) -> dict:
    key = jax.random.key(seed)
    ks = jax.random.split(key, 32)
    f32 = jnp.float32
    D, NA, NM = D_MODEL, N_ATTN_LAYERS, N_MLSTM_LAYERS
    DI, NH, DA = MLSTM_INNER, MLSTM_HEADS, ATTN_HEAD_DIM
    G = DI // QKV_BLOCK

    def nrm(k, shape, scale):
        return jax.random.normal(k, shape, f32) * scale

    b_gate = jnp.concatenate([nrm(ks[19], (NM, NH), 0.1),
                              jnp.linspace(3.0, 6.0, NH, dtype=f32)[None, :] + nrm(ks[20], (NM, NH), 0.1)], axis=-1)
    return {
        'x': nrm(ks[0], (BATCH, SEQ, D), 1.0),
        'c': nrm(ks[1], (BATCH, D), 1.0),
        'mod_w': nrm(ks[2], (DEPTH, D, 6 * D), D ** -0.5),
        'mod_b': nrm(ks[3], (DEPTH, 6 * D), 0.02),
        'norm_g': 1.0 + nrm(ks[4], (DEPTH, 4, D), 0.05),
        'attn_w_in': nrm(ks[5], (NA, D, 3 * D), D ** -0.5),
        'attn_w_out': nrm(ks[6], (NA, D, D), D ** -0.5),
        'attn_lambda': nrm(ks[7], (NA, 4, DA), 0.1),
        'attn_subln': 1.0 + nrm(ks[8], (NA, 2 * DA), 0.05),
        'ffn_w_gate': nrm(ks[9], (NA, D, FFN_DENSE), D ** -0.5),
        'ffn_w_up': nrm(ks[10], (NA, D, FFN_DENSE), D ** -0.5),
        'ffn_w_down': nrm(ks[11], (NA, FFN_DENSE, D), FFN_DENSE ** -0.5),
        'mlstm_w_in': nrm(ks[12], (NM, D, 2 * DI), D ** -0.5),
        'mlstm_conv_w': nrm(ks[13], (NM, MLSTM_CONV, DI), MLSTM_CONV ** -0.5),
        'mlstm_conv_b': nrm(ks[14], (NM, DI), 0.02),
        'mlstm_w_q': nrm(ks[15], (NM, G, QKV_BLOCK, QKV_BLOCK), QKV_BLOCK ** -0.5),
        'mlstm_w_k': nrm(ks[16], (NM, G, QKV_BLOCK, QKV_BLOCK), QKV_BLOCK ** -0.5),
        'mlstm_w_v': nrm(ks[17], (NM, G, QKV_BLOCK, QKV_BLOCK), QKV_BLOCK ** -0.5),
        'mlstm_w_gate': nrm(ks[18], (NM, 3 * DI, 2 * NH), (3 * DI) ** -0.5),
        'mlstm_b_gate': b_gate,
        'mlstm_skip': 1.0 + nrm(ks[21], (NM, DI), 0.05),
        'mlstm_norm': 1.0 + nrm(ks[22], (NM, DI), 0.05),
        'mlstm_w_out': nrm(ks[23], (NM, DI, D), DI ** -0.5),
        'moe_w_router': nrm(ks[24], (NM, D, N_EXPERTS), D ** -0.5),
        'moe_b_router': nrm(ks[25], (NM, N_EXPERTS), 0.01),
        'moe_w_gate': nrm(ks[26], (NM, N_EXPERTS, D, FFN_EXPERT), D ** -0.5),
        'moe_w_up': nrm(ks[27], (NM, N_EXPERTS, D, FFN_EXPERT), D ** -0.5),
        'moe_w_down': nrm(ks[28], (NM, N_EXPERTS, FFN_EXPERT, D), FFN_EXPERT ** -0.5),
    }


def reference(x, c, mod_w, mod_b, norm_g, attn_w_in, attn_w_out, attn_lambda, attn_subln,
              ffn_w_gate, ffn_w_up, ffn_w_down, mlstm_w_in, mlstm_conv_w, mlstm_conv_b,
              mlstm_w_q, mlstm_w_k, mlstm_w_v, mlstm_w_gate, mlstm_b_gate, mlstm_skip, mlstm_norm,
              mlstm_w_out, moe_w_router, moe_b_router, moe_w_gate, moe_w_up, moe_w_down):
    B = x.shape[0]
    cond = jax.nn.silu(c)
    for i in range(DEPTH):
        mod = (cond @ mod_w[i] + mod_b[i]).reshape(B, 6, D_MODEL)
        g = norm_g[i]
        j = i // N_MIXERS
        h = modulate(rmsnorm(x, g[0]), mod[:, 0], mod[:, 1])
        if i % N_MIXERS == 0:
            lambda_init = 0.8 - 0.6 * math.exp(-0.3 * i)
            y = diff_attention(h, attn_w_in[j], attn_w_out[j], attn_lambda[j], attn_subln[j], lambda_init)
        else:
            y = mlstm_layer(h, mlstm_w_in[j], mlstm_conv_w[j], mlstm_conv_b[j], mlstm_w_q[j], mlstm_w_k[j],
                            mlstm_w_v[j], mlstm_w_gate[j], mlstm_b_gate[j], mlstm_skip[j], mlstm_norm[j],
                            mlstm_w_out[j])
        x = x + mod[:, 2][:, None, :] * rmsnorm(y, g[1])
        h = modulate(rmsnorm(x, g[2]), mod[:, 3], mod[:, 4])
        if i % 2 == 0:
            y = swiglu(h, ffn_w_gate[j], ffn_w_up[j], ffn_w_down[j])
        else:
            y = moe_swiglu(h, moe_w_router[j], moe_b_router[j], moe_w_gate[j], moe_w_up[j], moe_w_down[j])
        x = x + mod[:, 5][:, None, :] * rmsnorm(y, g[3])
    return x
```

```cpp
#include <hip/hip_runtime.h>
#include <stdint.h>
#include <stdio.h>
#define HAVE_L0REST
namespace pg8 {
#define PG8_LAS __attribute__((address_space(3)))
typedef unsigned short bf16_t;
typedef short bf16x8 __attribute__((ext_vector_type(8)));
typedef float f32x4 __attribute__((ext_vector_type(4)));
typedef unsigned u32x4 __attribute__((ext_vector_type(4)));
typedef int v8i_t __attribute__((ext_vector_type(8)));
typedef int v4i_t __attribute__((ext_vector_type(4)));
constexpr int BM = 256, BK = 64, HALF = 128, HTB = HALF * BK * 2  , STAGE_BYTES = 8 * HTB, NXCD = 8, WGM = 8;

__host__ __device__ __forceinline__ int lds_byte(int r, int c) { const int st = (r >> 4) * 2 + (c >> 5), rr = r & 15, cc = c & 31, ob = rr * 64 + cc * 2; return st * 1024 + (ob ^ (((ob >> 9) & 1) << 5)); }
__host__ __device__ __forceinline__ void stage_rc(int b, int& R, int& C) { const int st = b / 1024, sb = b % 1024, swz = sb ^ (((sb >> 9) & 1) << 5); R = (st >> 1) * 16 + swz / 64; C = (st & 1) * 32 + (swz % 64) / 2; }
__host__ __device__ __forceinline__ int perm32(int rho) { const int n = rho >> 4, i = rho & 15; return 8 * (i >> 2) + 4 * n + (i & 3); }

struct Unit { int pm, pn, om, on; };
struct Gemm { const bf16_t* A; const bf16_t* Bt; int M, N, K; };

struct StaticOrder {
    int nM, nN, nwg, G, c;
    __host__ __device__ void init(int M, int N, int G_, int c_) { nM = M / BM; nN = N / BM; nwg = nM * nN; G = G_; c = c_; }
    __host__ __device__ bool next(int i, Unit& u) const {
        const long L = (long)i * G + c; if (L >= nwg) return false;
        int wgid = (int)L; { const int q = nwg / NXCD, r = nwg % NXCD, xcd = wgid % NXCD, off = wgid / NXCD; wgid = (xcd < r ? xcd * (q + 1) : r * (q + 1) + (xcd - r) * q) + off; }
        const int nig = WGM * nN, gid = wgid / nig, fm = gid * WGM, gsz = (nM - fm) < WGM ? (nM - fm) : WGM;
        u.pm = fm + ((wgid % nig) % gsz); u.pn = (wgid % nig) / gsz; u.om = u.pm; u.on = u.pn; return true;
    }
};
template <bool ABS_O> struct MoeOrder {
    int p_lo, np, nN, nwg, G, c; const int* pexp;
    __device__ void init(int p_lo_, int np_, int nN_, int G_, int c_, const int* pexp_) { p_lo = p_lo_; np = np_ < 0 ? 0 : np_; nN = nN_; nwg = np * nN; G = G_; c = c_; pexp = pexp_; }
    __device__ bool next(int i, Unit& u) const {
        const long L = (long)i * G + c; if (L >= nwg) return false;
        const int wgid = (int)L, nig = WGM * nN, gid = wgid / nig, fm = gid * WGM, gsz = (np - fm) < WGM ? (np - fm) : WGM;
        const int pr = __builtin_amdgcn_readfirstlane(fm + ((wgid % nig) % gsz)), pnl = __builtin_amdgcn_readfirstlane((wgid % nig) / gsz), e = __builtin_amdgcn_readfirstlane(pexp[p_lo + pr]);
        u.pm = pr; u.om = ABS_O ? p_lo + pr : pr; u.pn = e * nN + pnl; u.on = pnl; return true;
    }
};

__device__ __forceinline__ unsigned cvt_pk_bf16(float lo, float hi) { unsigned r; asm volatile("v_cvt_pk_bf16_f32 %0, %1, %2" : "=v"(r) : "v"(lo), "v"(hi)); return r; }

struct EpiBf16 {
    static constexpr bool PERM = true;
    bf16_t* O; int ldc; int split_cols; size_t split_stride; float scale0;
    __device__ __forceinline__ void operator()(const f32x4 (&acc)[2][2][4][2], const Unit& u, int wr, int wc, int fr, int fq) const {
        const int row0 = u.om * BM + wr * 64 + fr; int colt = u.on * BM; bf16_t* base = O;
        float sc = 1.f; if (split_cols) { const int t = colt / split_cols; base += (size_t)t * split_stride; colt -= t * split_cols; if (t == 0) sc = scale0; } else sc = scale0;
        const int col0 = colt + wc * 32 + 8 * fq;
#pragma unroll
        for (int ai = 0; ai < 2; ++ai)
#pragma unroll
            for (int m = 0; m < 4; ++m) { bf16_t* rowp = base + (size_t)(row0 + ai * HALF + m * 16) * ldc + col0;
#pragma unroll
                for (int bj = 0; bj < 2; ++bj) { const f32x4 v0 = acc[ai][bj][m][0] * sc, v1 = acc[ai][bj][m][1] * sc;
                    u32x4 w; w.x = cvt_pk_bf16(v0[0], v0[1]); w.y = cvt_pk_bf16(v0[2], v0[3]); w.z = cvt_pk_bf16(v1[0], v1[1]); w.w = cvt_pk_bf16(v1[2], v1[3]);
                    __builtin_nontemporal_store(w, (u32x4*)(rowp + bj * HALF)); } }
    }
};
__device__ __forceinline__ float silu_mul(float g, float u) { return g * u * __builtin_amdgcn_rcpf(1.0f + __builtin_amdgcn_exp2f(-1.4426950408889634f * g)); }
struct EpiSwiglu {
    static constexpr bool PERM = true;
    bf16_t* O; int ldc;
    __device__ __forceinline__ void operator()(const f32x4 (&acc)[2][2][4][2], const Unit& u, int wr, int wc, int fr, int fq) const {
        const int row0 = u.om * BM + wr * 64 + fr, col0 = u.on * HALF + wc * 32 + 8 * fq;
#pragma unroll
        for (int ai = 0; ai < 2; ++ai)
#pragma unroll
            for (int m = 0; m < 4; ++m) { bf16_t* rowp = O + (size_t)(row0 + ai * HALF + m * 16) * ldc + col0;
                const f32x4 g0 = acc[ai][0][m][0], g1 = acc[ai][0][m][1], u0 = acc[ai][1][m][0], u1 = acc[ai][1][m][1];
                u32x4 w; w.x = cvt_pk_bf16(silu_mul(g0[0], u0[0]), silu_mul(g0[1], u0[1])); w.y = cvt_pk_bf16(silu_mul(g0[2], u0[2]), silu_mul(g0[3], u0[3]));
                w.z = cvt_pk_bf16(silu_mul(g1[0], u1[0]), silu_mul(g1[1], u1[1])); w.w = cvt_pk_bf16(silu_mul(g1[2], u1[2]), silu_mul(g1[3], u1[3]));
                __builtin_nontemporal_store(w, (u32x4*)rowp); }
    }
};

template <int MODE> struct EpiProbe {
    static constexpr bool PERM = true;
    bf16_t* O; int ldc;
    __device__ __forceinline__ void operator()(const f32x4 (&acc)[2][2][4][2], const Unit& u, int wr, int wc, int fr, int fq) const {
        const int row0 = (MODE == 0 ? ((int)blockIdx.x % 64) : u.om) * BM + wr * 64 + fr; const int col0 = (MODE == 0 ? 0 : (u.on & 3) * BM) + wc * 32 + 8 * fq;
#pragma unroll
        for (int ai = 0; ai < 2; ++ai)
#pragma unroll
            for (int m = 0; m < 4; ++m) { bf16_t* rowp = O + (size_t)(row0 + ai * HALF + m * 16) * ldc + col0;
#pragma unroll
                for (int bj = 0; bj < 2; ++bj) { const f32x4 v0 = acc[ai][bj][m][0], v1 = acc[ai][bj][m][1];
                    u32x4 w; w.x = cvt_pk_bf16(v0[0], v0[1]); w.y = cvt_pk_bf16(v0[2], v0[3]); w.z = cvt_pk_bf16(v1[0], v1[1]); w.w = cvt_pk_bf16(v1[2], v1[3]);
                    if (MODE == 1) __builtin_nontemporal_store(w, (u32x4*)(rowp + bj * HALF)); else *(u32x4*)(rowp + bj * HALF) = w; } }
    }
};
struct EpiNull {
    static constexpr bool PERM = true;
    bf16_t* O;
    __device__ __forceinline__ void operator()(const f32x4 (&acc)[2][2][4][2], const Unit& u, int wr, int wc, int fr, int fq) const {
        float s = 0.f;
#pragma unroll
        for (int ai = 0; ai < 2; ++ai)
#pragma unroll
            for (int bj = 0; bj < 2; ++bj)
#pragma unroll
                for (int m = 0; m < 4; ++m)
#pragma unroll
                    for (int n = 0; n < 2; ++n) s += acc[ai][bj][m][n][0] + acc[ai][bj][m][n][1] + acc[ai][bj][m][n][2] + acc[ai][bj][m][n][3];
        if (s == 12345.6789f) O[(size_t)u.om * 256 + fr] = (bf16_t)1;
    }
};
struct EpiSwigluF8 {
    static constexpr bool PERM = true;
    unsigned char* O; int ldc; float inv_ws;
    __device__ __forceinline__ void operator()(const f32x4 (&acc)[2][2][4][2], const Unit& u, int wr, int wc, int fr, int fq) const {
        const int row0 = u.om * BM + wr * 64 + fr, col0 = u.on * HALF + wc * 32 + 8 * fq;
#pragma unroll
        for (int ai = 0; ai < 2; ++ai)
#pragma unroll
            for (int m = 0; m < 4; ++m) { unsigned char* rowp = O + (size_t)(row0 + ai * HALF + m * 16) * ldc + col0;
                const f32x4 g0 = acc[ai][0][m][0] * inv_ws, g1 = acc[ai][0][m][1] * inv_ws, u0 = acc[ai][1][m][0] * inv_ws, u1 = acc[ai][1][m][1] * inv_ws;
                unsigned w0 = 0u, w1 = 0u;
                w0 = __builtin_amdgcn_cvt_pk_fp8_f32(silu_mul(g0[0], u0[0]), silu_mul(g0[1], u0[1]), w0, false); w0 = __builtin_amdgcn_cvt_pk_fp8_f32(silu_mul(g0[2], u0[2]), silu_mul(g0[3], u0[3]), w0, true);
                w1 = __builtin_amdgcn_cvt_pk_fp8_f32(silu_mul(g1[0], u1[0]), silu_mul(g1[1], u1[1]), w1, false); w1 = __builtin_amdgcn_cvt_pk_fp8_f32(silu_mul(g1[2], u1[2]), silu_mul(g1[3], u1[3]), w1, true);
                typedef unsigned u32x2 __attribute__((ext_vector_type(2)));
                *(u32x2*)rowp = (u32x2){w0, w1}; }
    }
};

template <class Epi, class Sched, bool ALIGN_EPI, bool GATHER, bool F8 = false>
__device__ __forceinline__ void gemm_phase(PG8_LAS unsigned char* lds, const Gemm g, const Sched& S, const Epi& E, const int* rowidx) {
    const int tid = threadIdx.x, wid = __builtin_amdgcn_readfirstlane(tid >> 6), lane = tid & 63, wr = wid >> 2, wc = wid & 3, fr = lane & 15, fq = lane >> 4;
    const int K = F8 ? g.K / 2 : g.K, nt = K / BK;
    unsigned voffB[2];
#pragma unroll
    for (int i = 0; i < 2; ++i) { int R, C; stage_rc(tid * 16 + i * 8192, R, C); const int Rb = Epi::PERM ? ((R & ~31) + perm32(R & 31)) : R; voffB[i] = (unsigned)(Rb * K + C) * 2u; }
#define PG8_MKVOFF(dst, U) do { _Pragma("unroll") for (int _h = 0; _h < 2; ++_h) _Pragma("unroll") for (int _i = 0; _i < 2; ++_i) { int R_, C_; stage_rc(tid * 16 + _i * 8192, R_, C_); \
        int row_ = (U).pm * BM + _h * HALF + R_; if (GATHER) row_ = rowidx[row_]; dst[_h][_i] = (unsigned)(row_ * K + C_) * 2u; } } while (0)
    const size_t kstep = (size_t)(BK * 2);
    const size_t hstep = (size_t)HALF * K * 2;
    const size_t tstep = 2 * hstep;
    const unsigned lds0 = (unsigned)__builtin_amdgcn_readfirstlane((int)(unsigned)(size_t)lds);
    const unsigned ldsw = (unsigned)wid * 1024u;
    const unsigned ldsb = lds0 + ldsw;
    const int aoff = lds_byte(wr * 64 + fr, fq * 8), boff = lds_byte(wc * 32 + fr, fq * 8);
#define PG8_SA(b, h) (((b) * 2 + (h)) * HTB)
#define PG8_SB(b, h) ((4 + (b) * 2 + (h)) * HTB)
#define PG8_GLDS(ldsbase, coff, voff32, gptr) do { asm volatile("s_add_u32 m0, %1, %3\n\ts_nop 0\n\tglobal_load_lds_dwordx4 %0, %2" : : "v"(voff32), "s"(ldsbase), "s"(gptr), "i"(coff) : "memory", "m0", "scc"); } while (0)
#define PG8_STAGE(bufoff, gbase, v0, v1) do { const unsigned long long gb_ = (unsigned long long)(gbase); \
        const unsigned long long gp_ = ((unsigned long long)(unsigned)__builtin_amdgcn_readfirstlane((int)(unsigned)(gb_ >> 32)) << 32) | (unsigned long long)(unsigned)__builtin_amdgcn_readfirstlane((int)(unsigned)gb_); PG8_GLDS(ldsb, (bufoff), v0, gp_); PG8_GLDS(ldsb, (bufoff) + 8192, v1, gp_); } while (0)
#define PG8_LD2(p_) __builtin_shufflevector(*(const PG8_LAS v4i_t*)(p_), *(const PG8_LAS v4i_t*)((p_) + 1024), 0, 1, 2, 3, 4, 5, 6, 7)
#define PG8_LDA(dst, b, h) do { _Pragma("unroll") for (int m = 0; m < 4; ++m) dst[m] = PG8_LD2(lds + PG8_SA(b, h) + aoff + m * 2048); } while (0)
#define PG8_LDB(dst, b, h) do { _Pragma("unroll") for (int n = 0; n < 2; ++n) dst[n] = PG8_LD2(lds + PG8_SB(b, h) + boff + n * 2048); } while (0)
#define PG8_LO(v) __builtin_bit_cast(bf16x8, __builtin_shufflevector(v, v, 0, 1, 2, 3))
#define PG8_HI(v) __builtin_bit_cast(bf16x8, __builtin_shufflevector(v, v, 4, 5, 6, 7))
#define PG8_MMA(ai, bj, At, Bt) do { __builtin_amdgcn_s_setprio(1); _Pragma("unroll") for (int m = 0; m < 4; ++m) _Pragma("unroll") for (int n = 0; n < 2; ++n) { \
        if constexpr (F8) { acc[ai][bj][m][n] = __builtin_amdgcn_mfma_scale_f32_16x16x128_f8f6f4(Bt[n], At[m], acc[ai][bj][m][n], 0, 0, 0, 0x7f7f7f7f, 0, 0x7f7f7f7f); } \
        else { acc[ai][bj][m][n] = __builtin_amdgcn_mfma_f32_16x16x32_bf16(PG8_LO(Bt[n]), PG8_LO(At[m]), acc[ai][bj][m][n], 0, 0, 0); acc[ai][bj][m][n] = __builtin_amdgcn_mfma_f32_16x16x32_bf16(PG8_HI(Bt[n]), PG8_HI(At[m]), acc[ai][bj][m][n], 0, 0, 0); } } __builtin_amdgcn_s_setprio(0); } while (0)
#define PG8_WAIT_V(n) asm volatile("s_waitcnt vmcnt(" #n ")" ::: "memory")
#define PG8_WAIT_L(n) asm volatile("s_waitcnt lgkmcnt(" #n ")" ::: "memory")
#define PG8_BAR __builtin_amdgcn_s_barrier()
#define PG8_SCHED __builtin_amdgcn_sched_barrier(0)
    Unit cur, nxt; int ui = 0;
    if (!S.next(0, cur)) return;
    f32x4 acc[2][2][4][2];
#pragma unroll
    for (int a = 0; a < 2; ++a)
#pragma unroll
        for (int b = 0; b < 2; ++b)
#pragma unroll
            for (int m = 0; m < 4; ++m)
#pragma unroll
                for (int n = 0; n < 2; ++n) acc[a][b][m][n] = (f32x4){0.f, 0.f, 0.f, 0.f};
    v8i_t At[4], B0[2], B1[2];
    unsigned voffA[2][2], voffN[2][2], voffA1[2];
    if constexpr (GATHER) { PG8_MKVOFF(voffA, cur); }
    else {
#pragma unroll
        for (int i = 0; i < 2; ++i) { int R, C; stage_rc(tid * 16 + i * 8192, R, C); voffA1[i] = (unsigned)(R * K + C) * 2u; } }
    const char* gA = (const char*)g.A;
    const char* cA = gA + (size_t)cur.pm * tstep; const char* nA = cA;
    const char* cB = (const char*)g.Bt + (size_t)cur.pn * tstep;
#define PG8_STAGE_A(bufoff, h, koff, usenext) do { \
        if constexpr (GATHER) { const unsigned v0_ = (usenext) ? voffN[h][0] : voffA[h][0], v1_ = (usenext) ? voffN[h][1] : voffA[h][1]; PG8_STAGE(bufoff, gA + (koff), v0_, v1_); } \
        else { const char* p_ = ((usenext) ? nA : cA) + (size_t)(h) * hstep + (koff); PG8_STAGE(bufoff, p_, voffA1[0], voffA1[1]); } } while (0)
    PG8_STAGE(PG8_SB(0, 0), cB, voffB[0], voffB[1]); PG8_STAGE(PG8_SB(0, 1), cB + hstep, voffB[0], voffB[1]); PG8_STAGE_A(PG8_SA(0, 0), 0, (size_t)0, false); PG8_STAGE_A(PG8_SA(0, 1), 1, (size_t)0, false);
    if (wr == 1) PG8_BAR;
    PG8_WAIT_V(2); PG8_BAR;
    PG8_STAGE(PG8_SB(1, 0), cB + kstep, voffB[0], voffB[1]); PG8_STAGE_A(PG8_SA(1, 0), 0, kstep, false); PG8_STAGE(PG8_SB(1, 1), cB + hstep + kstep, voffB[0], voffB[1]);
    PG8_WAIT_V(6); PG8_BAR;
    for (;;) {
        const bool has_next = S.next(ui + 1, nxt);
        if constexpr (GATHER) { if (has_next) { PG8_MKVOFF(voffN, nxt); } else {
#pragma unroll
            for (int h = 0; h < 2; ++h) { voffN[h][0] = voffA[h][0]; voffN[h][1] = voffA[h][1]; } } }
        nA = has_next ? gA + (size_t)nxt.pm * tstep : cA;
        const char* nB = has_next ? (const char*)g.Bt + (size_t)nxt.pn * tstep : cB;
        for (int t = 0; t < nt; t += 2) {
            const bool last = (t == nt - 2);
            const size_t k1 = (size_t)(t + 1) * kstep;
            const size_t k2 = last ? (size_t)0 : (size_t)(t + 2) * kstep; const char* b2 = last ? nB : cB + (size_t)(t + 2) * kstep;
            const size_t k3 = k2 + kstep; const char* b3 = b2 + kstep;
            PG8_LDB(B0, 0, 0); PG8_LDB(B1, 0, 1); PG8_SCHED; PG8_LDA(At, 0, 0); PG8_STAGE_A(PG8_SA(1, 1), 1, k1, false);
            PG8_WAIT_V(8); PG8_WAIT_L(0); PG8_BAR; PG8_MMA(0, 0, At, B0); PG8_MMA(0, 1, At, B1); PG8_BAR; PG8_SCHED;
            PG8_LDA(At, 0, 1); PG8_STAGE(PG8_SB(0, 0), b2, voffB[0], voffB[1]); PG8_STAGE(PG8_SB(0, 1), b2 + hstep, voffB[0], voffB[1]); PG8_STAGE_A(PG8_SA(0, 0), 0, k2, last);
            PG8_WAIT_V(8); PG8_WAIT_L(0); PG8_BAR; PG8_MMA(1, 0, At, B0); PG8_MMA(1, 1, At, B1); PG8_BAR; PG8_SCHED;
            PG8_LDB(B0, 1, 0); PG8_LDB(B1, 1, 1); PG8_SCHED; PG8_LDA(At, 1, 0); PG8_STAGE_A(PG8_SA(0, 1), 1, k2, last);
            PG8_WAIT_V(8); PG8_WAIT_L(0); PG8_BAR; PG8_MMA(0, 0, At, B0); PG8_MMA(0, 1, At, B1); PG8_BAR; PG8_SCHED;
            PG8_LDA(At, 1, 1); PG8_STAGE(PG8_SB(1, 0), b3, voffB[0], voffB[1]); PG8_STAGE(PG8_SB(1, 1), b3 + hstep, voffB[0], voffB[1]); PG8_STAGE_A(PG8_SA(1, 0), 0, k3, last);
            PG8_WAIT_V(8); PG8_WAIT_L(0); PG8_BAR; PG8_MMA(1, 0, At, B0); PG8_MMA(1, 1, At, B1); PG8_BAR; PG8_SCHED;
        }
        if constexpr (ALIGN_EPI) { if (wr == 0) PG8_BAR; }
        { int l2_ = (int)__builtin_amdgcn_mbcnt_hi(~0u, __builtin_amdgcn_mbcnt_lo(~0u, 0u)); asm volatile("" : "+v"(l2_)); E(acc, cur, wr, wc, l2_ & 15, l2_ >> 4); }
        if (!has_next) break;
#pragma unroll
        for (int a = 0; a < 2; ++a)
#pragma unroll
            for (int b = 0; b < 2; ++b)
#pragma unroll
                for (int m = 0; m < 4; ++m)
#pragma unroll
                    for (int n = 0; n < 2; ++n) acc[a][b][m][n] = (f32x4){0.f, 0.f, 0.f, 0.f};
        cur = nxt; cB = nB; cA = nA; ++ui;
        if constexpr (GATHER) {
#pragma unroll
            for (int h = 0; h < 2; ++h) { voffA[h][0] = voffN[h][0]; voffA[h][1] = voffN[h][1]; } }
        if constexpr (ALIGN_EPI) { if (wr == 1) PG8_BAR; }
    }
    PG8_WAIT_V(0);
    if constexpr (!ALIGN_EPI) { if (wr == 0) PG8_BAR; }
    PG8_BAR;
#undef PG8_MKVOFF
#undef PG8_STAGE_A
#undef PG8_SA
#undef PG8_SB
#undef PG8_STAGE
#undef PG8_GLDS
#undef PG8_LDA
#undef PG8_LD2
#undef PG8_LO
#undef PG8_HI
#undef PG8_LDB
#undef PG8_MMA
#undef PG8_WAIT_V
#undef PG8_WAIT_L
#undef PG8_BAR
#undef PG8_SCHED
}
}
namespace fp {
constexpr int NWAVES = 8;
constexpr int B = 16, S = 2048, T = B * S, D = 1024, H = 8, F1 = 2816, DI = 2048, NH = 4, DH = 512, NE = 8, F2 = 3584;
constexpr float QSCALE = 0.125f * 1.4426950408889634f;
constexpr float LAMBDA_INIT = 0.2f;
constexpr float EPS = 1e-6f;

constexpr size_t MiB = 1u << 20;
constexpr size_t WS_NEED = 613951040;
constexpr size_t WS_CTL = 0, CTL_ZERO_BYTES = 1 * MiB;
constexpr size_t WS_MOD = 1 * MiB;
constexpr size_t WS_TAB = 2 * MiB;
constexpr size_t WS_GATE = 3 * MiB;
constexpr size_t WS_W_AIN = 4 * MiB, WS_W_AOUT = 10 * MiB, WS_W_FGU = 12 * MiB, WS_W_FD = 23 * MiB, WS_W_MIN = 29 * MiB, WS_W_MOUT = 37 * MiB;
constexpr size_t WS_ROUTE = 41 * MiB;
constexpr size_t WS_ARENA = 43 * MiB;
constexpr size_t A_(size_t mib) { return WS_ARENA + mib * MiB; }
constexpr size_t WS_Y = A_(0);
constexpr size_t WS_H = A_(64);
constexpr size_t WS_Q = A_(64), WS_K = A_(128), WS_V = A_(192), WS_O = A_(256);
constexpr size_t WS_ACT = A_(128);
constexpr size_t WS_XZ = A_(128);
constexpr size_t WS_HH = A_(384);
constexpr size_t WS_WMD = A_(0);
constexpr size_t WS_WMGU = A_(128);
constexpr size_t WS_ACT2 = A_(240);
constexpr int MOE_ROUNDS = 5;
constexpr int MPAD = 2 * T + NE * 256;
constexpr int MAXPANELS = MPAD / 256;
constexpr int PR = (MAXPANELS + MOE_ROUNDS - 1) / MOE_ROUNDS;
constexpr size_t ACT2_BYTES = (size_t)PR * 256 * F2 * 2;
constexpr size_t WS_YM = WS_ACT2 + ((ACT2_BYTES + MiB - 1) / MiB) * MiB;
constexpr size_t WS_HS = WS_YM + (size_t)MPAD * 1024 * 2;
constexpr size_t WS_END = WS_HS + (size_t)PR * 256 * 1024 * 2;
constexpr size_t WS_DIG = WS_NEED - 28 * MiB;
#ifdef REFCHECK
static_assert(WS_END <= WS_DIG, "d_ws map (refcheck)");
#else
static_assert(WS_END <= WS_NEED, "d_ws map");
#endif
constexpr int CW_FAIL = 8;
constexpr int CW_BAR = 4096;
constexpr int CW_ECNT = 200000;
constexpr int TAB_NPANELS = 0, TAB_EOFF = 16  , TAB_PEXP = 64  ;

constexpr int RING_BYTES = 131072;
constexpr int LDSCTL_OFF = RING_BYTES, MISC_OFF = LDSCTL_OFF + 320;
constexpr int LDS_BYTES = 147456;

#define GAS __attribute__((address_space(1)))
#define LAS __attribute__((address_space(3)))
typedef unsigned short bf16;
typedef unsigned v4u __attribute__((ext_vector_type(4)));
typedef unsigned v2u __attribute__((ext_vector_type(2)));
typedef float f32x4 __attribute__((ext_vector_type(4)));
typedef float f32x16 __attribute__((ext_vector_type(16)));
typedef short bf16x8 __attribute__((ext_vector_type(8)));
typedef short s16x4 __attribute__((ext_vector_type(4)));
typedef GAS unsigned gu32;
#define RLX_AGENT __ATOMIC_RELAXED, __HIP_MEMORY_SCOPE_AGENT
#define LDS_WAIT() asm volatile("s_waitcnt lgkmcnt(0)" ::: "memory")
#define VM_WAIT() asm volatile("s_waitcnt vmcnt(0)" ::: "memory")
__device__ __forceinline__ unsigned f2bf(float f) { unsigned u = __builtin_bit_cast(unsigned, f); return (u + 0x7fffu + ((u >> 16) & 1u)) >> 16; }
__device__ __forceinline__ unsigned pk2(float lo, float hi) { return f2bf(lo) | (f2bf(hi) << 16); }
__device__ __forceinline__ float bf_lo(unsigned w) { return __builtin_bit_cast(float, w << 16); }
__device__ __forceinline__ float bf_hi(unsigned w) { return __builtin_bit_cast(float, w & 0xffff0000u); }
__device__ __forceinline__ float bf2f(bf16 v) { return __builtin_bit_cast(float, (unsigned)v << 16); }
__device__ __forceinline__ float fsilu(float v) { return v * __builtin_amdgcn_rcpf(1.0f + __builtin_amdgcn_exp2f(-1.4426950408889634f * v)); }
__device__ __forceinline__ float wave_sum(float v) {
#pragma unroll
    for (int o = 1; o < 64; o <<= 1) v += __shfl_xor(v, o);
    return v;
}

#define XB_TMO      128
#define XB_XCNT(j)  (256  + 64 * (j))
#define XB_XSUB(j)  (1280 + 64 * (j))
#define XB_XGEN(j)  (2304 + 64 * (j))
#define XB_TOP      3328
#define XB_TOPGEN   3392
#define XCD_BAR_WORDS 3456
#define XB_SPIN_CAP (1u << 18)
__device__ __forceinline__ unsigned xb_ld(unsigned* p)              { return __hip_atomic_load(p, __ATOMIC_RELAXED, __HIP_MEMORY_SCOPE_AGENT); }
__device__ __forceinline__ unsigned xb_add(unsigned* p, unsigned v) { return __hip_atomic_fetch_add(p, v, __ATOMIC_RELAXED, __HIP_MEMORY_SCOPE_AGENT); }
__device__ __forceinline__ unsigned xb_xcc_id() { return (unsigned)__builtin_amdgcn_s_getreg((3 << 11) | 20) & 0xFu; }
#define XB_SPIN(cond, bar) do { unsigned _sp = 0; while (cond) { __builtin_amdgcn_s_sleep(1); \
    if ((++_sp & 255u) == 0u) { if (xb_ld(&(bar)[XB_TMO])) break; if (_sp > XB_SPIN_CAP) { atomicAdd(&(bar)[XB_TMO], 1u); break; } } } } while (0)
struct XcdBarrier { unsigned* bar; unsigned x; volatile LAS unsigned* st; };
__device__ __forceinline__ XcdBarrier xcd_barrier_post(unsigned* bar, volatile LAS unsigned* st) {
    XcdBarrier b; b.bar = bar; b.x = xb_xcc_id(); b.st = st;
    if (threadIdx.x == 0) (void)xb_add(&bar[XB_XCNT(b.x)], 1u);
    return b;
}
__device__ __forceinline__ void xcd_barrier_complete(unsigned* bar, unsigned x, unsigned& nloc, unsigned& nx) {
    const unsigned G = gridDim.x * gridDim.y * gridDim.z;
    unsigned sum, cnt, mine, sp = 0u;
    for (;;) {
        sum = 0u; cnt = 0u; mine = 0u;
#pragma unroll
        for (unsigned j = 0; j < 16; ++j) { const unsigned c = xb_ld(&bar[XB_XCNT(j)]); sum += c; cnt += (c > 0u) ? 1u : 0u; mine = (j == x) ? c : mine; }
        if (sum == G) break;
        __builtin_amdgcn_s_sleep(1);
        if ((++sp & 255u) == 0u) { if (xb_ld(&bar[XB_TMO])) break; if (sp > XB_SPIN_CAP) { atomicAdd(&bar[XB_TMO], 1u); break; } }
    }
    nloc = mine > 0u ? mine : 1u; nx = cnt > 0u ? cnt : 1u;
}
__device__ __forceinline__ void xcd_barrier(const XcdBarrier& b) {
    asm volatile("s_waitcnt vmcnt(0)" ::: "memory");
    __syncthreads();
    if (threadIdx.x == 0) {
        unsigned* bar = b.bar;
        __builtin_amdgcn_s_waitcnt(0);
        unsigned nloc = b.st[0], nx = b.st[1];
        if (nloc == 0u) { xcd_barrier_complete(bar, b.x, nloc, nx); b.st[0] = nloc; b.st[1] = nx; }
        const unsigned old = xb_add(&bar[XB_XSUB(b.x)], 1u);
        const unsigned gen = old / nloc;
        if (old + 1u == (gen + 1u) * nloc) {
            __builtin_amdgcn_fence(__ATOMIC_RELEASE, "agent");
            asm volatile("s_waitcnt vmcnt(0)" ::: "memory");
            const unsigned og = xb_add(&bar[XB_TOP], 1u);
            const unsigned tg = og / nx;
            if (og + 1u == (tg + 1u) * nx) xb_add(&bar[XB_TOPGEN], 1u);
            else XB_SPIN(xb_ld(&bar[XB_TOPGEN]) == tg, bar);
            __builtin_amdgcn_fence(__ATOMIC_ACQUIRE, "agent");
            xb_add(&bar[XB_XGEN(b.x)], 1u);
            asm volatile("s_waitcnt vmcnt(0)" ::: "memory");
        } else {
            XB_SPIN(xb_ld(&bar[XB_XGEN(b.x)]) == gen, bar);
            __builtin_amdgcn_fence(__ATOMIC_ACQUIRE, "agent");
            asm volatile("s_waitcnt vmcnt(0)" ::: "memory");
        }
    }
    __syncthreads();
}

struct Frame {
    LAS unsigned char* lds;
    volatile LAS unsigned* MISC;
    gu32* ctl;
    unsigned char* ws;
    int tid, lane, wave, G, gw, NGW;
    const float* const* in;
    float* X;
};
enum { I_X = 0, I_C, I_MODW, I_MODB, I_NORMG, I_AWIN, I_AWOUT, I_ALAM, I_ASUBLN, I_FWG, I_FWU, I_FWD, I_MWIN, I_CONVW, I_CONVB, I_WQ, I_WK, I_WV, I_WGATE, I_BGATE, I_SKIP, I_MNORM, I_MWOUT,
       I_WROUTER, I_BROUTER, I_EWG, I_EWU, I_EWD };

__device__ __forceinline__ void transpose_item(const float* W, int K, int N, bf16* WT, int mode, LAS float* scr, int item, int lane) {
    const int nblk = N / 32, kb = item / nblk, nb = item % nblk, k0 = 64 * kb, n0 = 32 * nb;
#pragma unroll 8
    for (int i = 0; i < 32; ++i) { const int kk = 2 * i + (lane >> 5); scr[kk * 33 + (lane & 31)] = W[(size_t)(k0 + kk) * N + n0 + (lane & 31)]; }
    LDS_WAIT(); asm volatile("" ::: "memory");
    const int c = lane & 7;
#pragma unroll
    for (int j = 0; j < 4; ++j) { const int n = (lane >> 3) + 8 * j; const LAS float* s = scr + (8 * c) * 33 + n;
        v4u o; o.x = pk2(s[0 * 33], s[1 * 33]); o.y = pk2(s[2 * 33], s[3 * 33]); o.z = pk2(s[4 * 33], s[5 * 33]); o.w = pk2(s[6 * 33], s[7 * 33]);
        const int ng = n0 + n; const int row = mode == 0 ? ng : ((ng >> 7) * 256 + (ng & 127) + (mode == 2 ? 128 : 0));
        *(GAS v4u*)(WT + (size_t)row * K + k0 + 8 * c) = o; }
    LDS_WAIT(); asm volatile("" ::: "memory");
}
constexpr float WS8 = 32.f;
__device__ __forceinline__ unsigned pk4_fp8(float a, float b, float c, float d) { unsigned w = 0u; w = __builtin_amdgcn_cvt_pk_fp8_f32(a, b, w, false); w = __builtin_amdgcn_cvt_pk_fp8_f32(c, d, w, true); return w; }
__device__ __forceinline__ void transpose_item_f8(const float* W, int K, int N, unsigned char* WT, int mode, LAS float* scr, int item, int lane) {
    const int nblk = N / 32, kb = item / nblk, nb = item % nblk, k0 = 64 * kb, n0 = 32 * nb;
#pragma unroll 8
    for (int i = 0; i < 32; ++i) { const int kk = 2 * i + (lane >> 5); scr[kk * 33 + (lane & 31)] = W[(size_t)(k0 + kk) * N + n0 + (lane & 31)]; }
    LDS_WAIT(); asm volatile("" ::: "memory");
    const int n = lane >> 1, half = lane & 1; const LAS float* sp = scr + (32 * half) * 33 + n;
    v4u o[2];
#pragma unroll
    for (int u = 0; u < 2; ++u) { const LAS float* s4 = sp + 16 * u * 33;
        o[u].x = pk4_fp8(s4[0 * 33] * WS8, s4[1 * 33] * WS8, s4[2 * 33] * WS8, s4[3 * 33] * WS8); o[u].y = pk4_fp8(s4[4 * 33] * WS8, s4[5 * 33] * WS8, s4[6 * 33] * WS8, s4[7 * 33] * WS8);
        o[u].z = pk4_fp8(s4[8 * 33] * WS8, s4[9 * 33] * WS8, s4[10 * 33] * WS8, s4[11 * 33] * WS8); o[u].w = pk4_fp8(s4[12 * 33] * WS8, s4[13 * 33] * WS8, s4[14 * 33] * WS8, s4[15 * 33] * WS8); }
    const int ng = n0 + n; const int row = mode == 0 ? ng : ((ng >> 7) * 256 + (ng & 127) + (mode == 2 ? 128 : 0));
    GAS v4u* dst = (GAS v4u*)(WT + (size_t)row * K + k0 + 32 * half); dst[0] = o[0]; dst[1] = o[1];
    LDS_WAIT(); asm volatile("" ::: "memory");
}
__device__ __forceinline__ void convert_matrix_f8(Frame& F, const float* W, int K, int N, unsigned char* WT, int mode) {
    LAS float* scr = (LAS float*)(F.lds + F.wave * 16384);
    const int nitems = (K / 64) * (N / 32);
    for (int it = F.gw; it < nitems; it += F.NGW) transpose_item_f8(W, K, N, WT, mode, scr, it, F.lane);
}
__device__ __forceinline__ void convert_matrix(Frame& F, const float* W, int K, int N, bf16* WT, int mode) {
    LAS float* scr = (LAS float*)(F.lds + F.wave * 16384);
    const int nitems = (K / 64) * (N / 32);
    for (int it = F.gw; it < nitems; it += F.NGW) transpose_item(W, K, N, WT, mode, scr, it, F.lane);
}

__device__ __forceinline__ void p_mlprep(Frame& F);
__device__ __forceinline__ void p_prologue(Frame& F) {
    {
        LAS float* sc = (LAS float*)(F.lds);
        LAS float* red = (LAS float*)(F.lds + 65536);
        const float* c = F.in[I_C];
        for (int e = F.tid; e < 16 * 1024; e += 512) sc[e] = fsilu(c[e]);
        __syncthreads();
        float* mod = (float*)(F.ws + WS_MOD);
        for (int cb = blockIdx.x; cb < 12288 / 64; cb += F.G) {
            const int col = cb * 64 + F.lane, i = col / 6144, n = col % 6144;
            const float* w = F.in[I_MODW] + (size_t)i * 1024 * 6144 + n;
            float acc[16];
#pragma unroll
            for (int b = 0; b < 16; ++b) acc[b] = 0.f;
            for (int k = F.wave * 128; k < F.wave * 128 + 128; ++k) { const float wv = w[(size_t)k * 6144];
#pragma unroll
                for (int b = 0; b < 16; ++b) acc[b] += sc[b * 1024 + k] * wv; }
#pragma unroll
            for (int b = 0; b < 16; ++b) red[(F.wave * 16 + b) * 64 + F.lane] = acc[b];
            __syncthreads();
            for (int e = F.tid; e < 16 * 64; e += 512) { const int b = e >> 6, l = e & 63; float s = 0.f;
#pragma unroll
                for (int w8 = 0; w8 < 8; ++w8) s += red[(w8 * 16 + b) * 64 + l];
                const int col2 = cb * 64 + l, i2 = col2 / 6144, n2 = col2 % 6144;
                mod[(size_t)(i2 * 16 + b) * 6144 + n2] = s + F.in[I_MODB][i2 * 6144 + n2]; }
            __syncthreads();
        }
        __syncthreads();
    }
    p_mlprep(F);
    convert_matrix(F, F.in[I_AWIN], 1024, 3072, (bf16*)(F.ws + WS_W_AIN), 0);
    convert_matrix(F, F.in[I_AWOUT], 1024, 1024, (bf16*)(F.ws + WS_W_AOUT), 0);
    convert_matrix(F, F.in[I_FWG], 1024, F1, (bf16*)(F.ws + WS_W_FGU), 1);
    convert_matrix(F, F.in[I_FWU], 1024, F1, (bf16*)(F.ws + WS_W_FGU), 2);
    convert_matrix(F, F.in[I_FWD], F1, 1024, (bf16*)(F.ws + WS_W_FD), 0);
    convert_matrix(F, F.in[I_MWIN], 1024, 4096, (bf16*)(F.ws + WS_W_MIN), 0);
    convert_matrix(F, F.in[I_MWOUT], 2048, 1024, (bf16*)(F.ws + WS_W_MOUT), 0);
}

struct Row16 { f32x4 v[4]; };
__device__ __forceinline__ Row16 load_row_f32(const float* p, int lane) { Row16 r; const GAS f32x4* q = (const GAS f32x4*)p + lane;
#pragma unroll
    for (int j = 0; j < 4; ++j) r.v[j] = q[64 * j]; return r; }
__device__ __forceinline__ Row16 load_row_bf16(const bf16* p, int lane) { Row16 r; const GAS v2u* q = (const GAS v2u*)p + lane;
#pragma unroll
    for (int j = 0; j < 4; ++j) { const v2u w = q[64 * j]; r.v[j] = (f32x4){bf_lo(w.x), bf_hi(w.x), bf_lo(w.y), bf_hi(w.y)}; } return r; }
__device__ __forceinline__ float row_ss(const Row16& r) { float s = 0.f;
#pragma unroll
    for (int j = 0; j < 4; ++j) s += (r.v[j].x * r.v[j].x + r.v[j].y * r.v[j].y) + (r.v[j].z * r.v[j].z + r.v[j].w * r.v[j].w);
    return wave_sum(s); }
__device__ __forceinline__ void store_row_bf16(bf16* p, int lane, const Row16& r) { GAS v2u* q = (GAS v2u*)p + lane;
#pragma unroll
    for (int j = 0; j < 4; ++j) { v2u w; w.x = pk2(r.v[j].x, r.v[j].y); w.y = pk2(r.v[j].z, r.v[j].w); q[64 * j] = w; } }
__device__ __forceinline__ void store_row_fp8(unsigned char* p, int lane, const Row16& r) { GAS unsigned* q = (GAS unsigned*)p + lane;
#pragma unroll
    for (int j = 0; j < 4; ++j) q[64 * j] = pk4_fp8(r.v[j].x, r.v[j].y, r.v[j].z, r.v[j].w); }
__device__ __forceinline__ void store_row_f32(float* p, int lane, const Row16& r) { GAS f32x4* q = (GAS f32x4*)p + lane;
#pragma unroll
    for (int j = 0; j < 4; ++j) q[64 * j] = r.v[j]; }
__device__ __forceinline__ void norm_mod_row(const Row16& x, float rstd, const float* g, const float* scale, const float* shift, bf16* out, int lane) {
    const Row16 gg = load_row_f32(g, lane), sc = load_row_f32(scale, lane), sh = load_row_f32(shift, lane); Row16 h;
#pragma unroll
    for (int j = 0; j < 4; ++j) h.v[j] = x.v[j] * rstd * gg.v[j] * (sc.v[j] + 1.0f) + sh.v[j];
    store_row_bf16(out, lane, h);
}
#define ROWBLOCK(m0, m1) const int per_ = (T + F.NGW - 1) / F.NGW; const int m0 = F.gw * per_; const int m1 = (m0 + per_ < T) ? m0 + per_ : T
__device__ __forceinline__ void p_h0(Frame& F, bf16* Hout) {
    const float* mod = (const float*)(F.ws + WS_MOD); const float* g = F.in[I_NORMG];
    ROWBLOCK(m0, m1); int bc = -1; Row16 gg = load_row_f32(g, F.lane), sc, sh;
    Row16 xnx = load_row_f32(F.in[I_X] + (size_t)m0 * D, F.lane);
    for (int m = m0; m < m1; ++m) { const int b = m >> 11;
        if (b != bc) { bc = b; const float* mb = mod + (size_t)b * 6144; sc = load_row_f32(mb + 1024, F.lane); sh = load_row_f32(mb, F.lane); }
        const Row16 x = xnx; if (m + 1 < m1) xnx = load_row_f32(F.in[I_X] + (size_t)(m + 1) * D, F.lane);
        const float rstd = rsqrtf(row_ss(x) * (1.f / D) + EPS); Row16 h;
#pragma unroll
        for (int j = 0; j < 4; ++j) h.v[j] = x.v[j] * rstd * gg.v[j] * (sc.v[j] + 1.0f) + sh.v[j];
        store_row_bf16(Hout + (size_t)m * D, F.lane, h); }
}
__device__ __forceinline__ void p_norm(Frame& F, const float* xold, const bf16* Y, const float* gpost, const float* modg, int gi, const float* gn, const float* modn, int si, bf16* Hout) {
    ROWBLOCK(m0, m1); int bc = -1; const Row16 gp = load_row_f32(gpost, F.lane), gg = load_row_f32(gn, F.lane); Row16 gt, sc, sh;
    Row16 ynx = load_row_bf16(Y + (size_t)m0 * D, F.lane), xnx = load_row_f32(xold + (size_t)m0 * D, F.lane);
    for (int m = m0; m < m1; ++m) { const int b = m >> 11;
        if (b != bc) { bc = b; gt = load_row_f32(modg + (size_t)b * 6144 + gi * 1024, F.lane); const float* mb = modn + (size_t)b * 6144; sc = load_row_f32(mb + (si + 1) * 1024, F.lane); sh = load_row_f32(mb + si * 1024, F.lane); }
        const Row16 y = ynx, xo = xnx; if (m + 1 < m1) { ynx = load_row_bf16(Y + (size_t)(m + 1) * D, F.lane); xnx = load_row_f32(xold + (size_t)(m + 1) * D, F.lane); }
        const float r1 = rsqrtf(row_ss(y) * (1.f / D) + EPS);
        Row16 xn;
#pragma unroll
        for (int j = 0; j < 4; ++j) xn.v[j] = xo.v[j] + gt.v[j] * (y.v[j] * r1 * gp.v[j]);
        store_row_f32(F.X + (size_t)m * D, F.lane, xn);
        const float r2 = rsqrtf(row_ss(xn) * (1.f / D) + EPS); Row16 h;
#pragma unroll
        for (int j = 0; j < 4; ++j) h.v[j] = xn.v[j] * r2 * gg.v[j] * (sc.v[j] + 1.0f) + sh.v[j];
        store_row_bf16(Hout + (size_t)m * D, F.lane, h); }
}
#define HAVE_ATTN 1
__device__ __forceinline__ int crow(int r, int hi) { return (r & 3) + 8 * (r >> 2) + 4 * hi; }
__device__ __forceinline__ void swap32(unsigned& a, unsigned& b) { asm volatile("s_nop 1\n\tv_permlane32_swap_b32 %0, %1\n\ts_nop 1" : "+v"(a), "+v"(b)); }
__device__ __forceinline__ float xhalf_max(float v) { unsigned a = __builtin_bit_cast(unsigned, v), b2 = a; swap32(a, b2); return fmaxf(__builtin_bit_cast(float, a), __builtin_bit_cast(float, b2)); }
__device__ __forceinline__ float xhalf_sum(float v) { unsigned a = __builtin_bit_cast(unsigned, v), b2 = a; swap32(a, b2); return __builtin_bit_cast(float, a) + __builtin_bit_cast(float, b2); }
typedef short v4i16_t __attribute__((ext_vector_type(4)));
__device__ __forceinline__ s16x4 tr16(LAS const char* p) { return __builtin_bit_cast(s16x4, __builtin_amdgcn_ds_read_tr16_b64_v4i16((LAS v4i16_t*)p)); }
typedef float f32x2_t __attribute__((ext_vector_type(2))); typedef __bf16 bf16x2_t __attribute__((ext_vector_type(2)));
__device__ __forceinline__ unsigned cvtpk(float lo, float hi) { f32x2_t v = {lo, hi}; bf16x2_t b = __builtin_convertvector(v, bf16x2_t); return __builtin_bit_cast(unsigned, b); }
__device__ __forceinline__ float max3f(float a, float b, float c) { float r; asm("v_max3_f32 %0, %1, %2, %3" : "=v"(r) : "v"(a), "v"(b), "v"(c)); return r; }
#define MFMA32(a, b, c) __builtin_amdgcn_mfma_f32_32x32x16_bf16((a), (b), (c), 0, 0, 0)

__device__ __forceinline__ void p_attn(Frame& F) {
    const bf16* Qb = (const bf16*)(F.ws + WS_Q); const bf16* Kb = (const bf16*)(F.ws + WS_K); const bf16* Vb = (const bf16*)(F.ws + WS_V); bf16* Ob = (bf16*)(F.ws + WS_O);
    const int lane = F.lane, r32 = lane & 31, hi = lane >> 5, w = F.wave, g = w >> 1, c = w & 1, tid = F.tid;
    const int vcu = F.gw >> 3;
    float l01 = 0.f, l23 = 0.f; { const float* lam = F.in[I_ALAM]; for (int i = 0; i < 64; ++i) { l01 += lam[i] * lam[64 + i]; l23 += lam[128 + i] * lam[192 + i]; } }
#ifdef LAM0
    const float lam_full = 0.f;
#else
    const float lam_full = __expf(l01) - __expf(l23) + LAMBDA_INIT;
#endif
    const int krow_ = tid >> 3, kpc = tid & 7, vrow_ = tid >> 4, vpc = tid & 15;
    const int i16 = lane & 15, q4 = i16 >> 2, p4 = i16 & 3, blk = (lane >> 4) & 1;
    LAS char* L = (LAS char*)F.lds;
    constexpr int KP = 144, VP = 320, STG = 2 * 64 * KP + 64 * VP;
    LAS float* XCH = (LAS float*)F.lds;
    for (int wi = vcu; wi < 2 * B * H; wi += F.G) {
    const int bh = wi >> 1, par = wi & 1, b = bh >> 3, h = bh & 7;
    const float slope2 = exp2f(-(float)(h + 1)) * 1.4426950408889634f;
    const size_t rowb = (size_t)b * S;
    LAS float* KNW = (LAS float*)(L + 2 * STG);
    { float mk0 = 0.f, mk1 = 0.f;
        for (int r = tid; r < S; r += 512) { const bf16* kr = Kb + (rowb + r) * 1024 + h * 128; float s0 = 0.f, s1 = 0.f;
#pragma unroll
            for (int i = 0; i < 8; ++i) { const v4u a = *(const GAS v4u*)(kr + 8 * i), bq = *(const GAS v4u*)(kr + 64 + 8 * i);
                s0 += bf_lo(a.x) * bf_lo(a.x) + bf_hi(a.x) * bf_hi(a.x) + bf_lo(a.y) * bf_lo(a.y) + bf_hi(a.y) * bf_hi(a.y) + bf_lo(a.z) * bf_lo(a.z) + bf_hi(a.z) * bf_hi(a.z) + bf_lo(a.w) * bf_lo(a.w) + bf_hi(a.w) * bf_hi(a.w);
                s1 += bf_lo(bq.x) * bf_lo(bq.x) + bf_hi(bq.x) * bf_hi(bq.x) + bf_lo(bq.y) * bf_lo(bq.y) + bf_hi(bq.y) * bf_hi(bq.y) + bf_lo(bq.z) * bf_lo(bq.z) + bf_hi(bq.z) * bf_hi(bq.z) + bf_lo(bq.w) * bf_lo(bq.w) + bf_hi(bq.w) * bf_hi(bq.w); }
            mk0 = fmaxf(mk0, s0); mk1 = fmaxf(mk1, s1); }
#pragma unroll
        for (int o = 1; o < 64; o <<= 1) { mk0 = fmaxf(mk0, __shfl_xor(mk0, o)); mk1 = fmaxf(mk1, __shfl_xor(mk1, o)); }
        __syncthreads();
        if (lane == 0) { KNW[w * 2] = mk0; KNW[w * 2 + 1] = mk1; }
        __syncthreads();
        if (tid < 2) { float mm = 0.f; for (int w8 = 0; w8 < 8; ++w8) mm = fmaxf(mm, KNW[w8 * 2 + tid]); KNW[16 + tid] = sqrtf(mm); }
        __syncthreads(); }
    const float kn = KNW[16 + c];
    for (int it = 0; it < 8; ++it) {
        const int pair = par + 2 * (it >> 1), u = (it & 1) ? 15 - pair : pair;
        const int ntu = 2 * u + 2, cq = 2 * u + (g >> 1);
        const int qpos = 128 * u + 32 * g + r32;
        bf16x8 qf[4];
        { const bf16* qp = Qb + (rowb + qpos) * 1024 + h * 128 + c * 64 + 8 * hi;
#pragma unroll
            for (int ks = 0; ks < 4; ++ks) qf[ks] = *(const GAS bf16x8*)(qp + 16 * ks); }
        float bc;
        { float qs = 0.f;
#pragma unroll
            for (int ks = 0; ks < 4; ++ks) { const v4u qw = __builtin_bit_cast(v4u, qf[ks]);
                qs += bf_lo(qw.x) * bf_lo(qw.x) + bf_hi(qw.x) * bf_hi(qw.x) + bf_lo(qw.y) * bf_lo(qw.y) + bf_hi(qw.y) * bf_hi(qw.y) + bf_lo(qw.z) * bf_lo(qw.z) + bf_hi(qw.z) * bf_hi(qw.z) + bf_lo(qw.w) * bf_lo(qw.w) + bf_hi(qw.w) * bf_hi(qw.w); }
            qs = xhalf_sum(qs);
#pragma unroll
            for (int o2 = 1; o2 < 32; o2 <<= 1) qs = fmaxf(qs, __shfl_xor(qs, o2));
            bc = sqrtf(qs) * kn * 1.001f + 0.01f; }
        v4u pk0, pk1, pv0, pv1;
#define ATT_LOADT(kt) do { const bf16* kr = Kb + (rowb + (size_t)(kt) * 64 + krow_) * 1024 + h * 128 + kpc * 8; pk0 = *(const GAS v4u*)kr; pk1 = *(const GAS v4u*)(kr + 64); \
            const bf16* vr = Vb + (rowb + (size_t)(kt) * 64 + vrow_) * 1024 + h * 128 + vpc * 8; pv0 = *(const GAS v4u*)vr; pv1 = *(const GAS v4u*)(vr + 32 * 1024); } while (0)
#define ATT_STORET(st) do { LAS char* sb = L + (st) * STG; *(LAS v4u*)(sb + krow_ * KP + kpc * 16) = pk0; *(LAS v4u*)(sb + 64 * KP + krow_ * KP + kpc * 16) = pk1; \
            *(LAS v4u*)(sb + 128 * KP + vrow_ * VP + vpc * 16) = pv0; *(LAS v4u*)(sb + 128 * KP + (vrow_ + 32) * VP + vpc * 16) = pv1; } while (0)
        ATT_LOADT(ntu - 1);
        __syncthreads();
        ATT_STORET(0);
        __syncthreads();
        float m = -1e30f, l = 0.f;
        f32x16 o[4];
#pragma unroll
        for (int et = 0; et < 4; ++et)
#pragma unroll
            for (int r = 0; r < 16; ++r) o[et][r] = 0.f;
        int nj = ntu;
        for (int j = 0; j < nj; ++j) {
            const int kt = ntu - 1 - j;
            const bool more = j + 1 < nj;
            if (more) ATT_LOADT(kt - 1);
            if (kt <= cq) {
                LAS const char* Kc = L + (j & 1) * STG + c * 64 * KP;
                LAS const char* Vs = L + (j & 1) * STG + 128 * KP;
                f32x16 sacc[2];
                const bool started = m > -1e29f; const float mref = started ? m : 0.f;
#pragma unroll
                for (int half = 0; half < 2; ++half) {
                    f32x16 acc;
                    if (kt < cq) { const float base = slope2 * (float)(kt * 64 + 32 * half + 4 * hi) - mref;
#pragma unroll
                        for (int r = 0; r < 16; ++r) acc[r] = fmaf(slope2, (float)((r & 3) + 8 * (r >> 2)), base);
                    } else { const float q2 = 2.f * (float)qpos;
#pragma unroll
                        for (int r = 0; r < 16; ++r) { const float kpos = (float)(kt * 64 + 32 * half + crow(r, hi)); acc[r] = fmaf(slope2, fminf(kpos, q2 - kpos), -mref); } }
#pragma unroll
                    for (int ks = 0; ks < 4; ++ks) { const bf16x8 kf = *(LAS const bf16x8*)(Kc + (32 * half + r32) * KP + (16 * ks + 8 * hi) * 2); acc = MFMA32(kf, qf[ks], acc); }
                    sacc[half] = acc;
                }
                float mx = fmaxf(sacc[0][0], sacc[1][0]);
#pragma unroll
                for (int r = 1; r < 16; ++r) mx = max3f(mx, sacc[0][r], sacc[1][r]);
                mx = xhalf_max(mx);
                if (!__all(started && mx <= 0.f)) {
                    const float d = fmaxf(mx, started ? 0.f : -1e30f);
                    const float alpha = started ? __builtin_amdgcn_exp2f(-d) : 0.f;
                    m = mref + d; l *= alpha;
#pragma unroll
                    for (int half = 0; half < 2; ++half)
#pragma unroll
                        for (int r = 0; r < 16; ++r) sacc[half][r] -= d;
#pragma unroll
                    for (int et = 0; et < 4; ++et)
#pragma unroll
                        for (int r = 0; r < 16; ++r) o[et][r] *= alpha;
                }
                float lsum = 0.f;
#pragma unroll
                for (int half = 0; half < 2; ++half)
#pragma unroll
                    for (int r = 0; r < 16; ++r) { const float p = __builtin_amdgcn_exp2f(sacc[half][r]); sacc[half][r] = p; lsum += p; }
                l += lsum;
                bf16x8 pf[4];
#pragma unroll
                for (int ks = 0; ks < 4; ++ks) { const int half = ks >> 1, s8 = 8 * (ks & 1); v4u pw;
                    pw.x = cvtpk(sacc[half][s8 + 0], sacc[half][s8 + 1]); pw.y = cvtpk(sacc[half][s8 + 2], sacc[half][s8 + 3]); pw.z = cvtpk(sacc[half][s8 + 4], sacc[half][s8 + 5]); pw.w = cvtpk(sacc[half][s8 + 6], sacc[half][s8 + 7]);
                    pf[ks] = __builtin_bit_cast(bf16x8, pw); }
                { bf16x8 vf[2][4];
                    LAS const char* vp0 = Vs + (4 * hi + q4) * VP + (16 * blk) * 2 + 8 * p4;
#define ATT_VLOAD(dst, et) do { _Pragma("unroll") for (int ks_ = 0; ks_ < 4; ++ks_) { const s16x4 lo_ = tr16(vp0 + 16 * ks_ * VP + (et) * 64), hi_ = tr16(vp0 + (16 * ks_ + 8) * VP + (et) * 64); dst[ks_] = __builtin_shufflevector(lo_, hi_, 0, 1, 2, 3, 4, 5, 6, 7); } } while (0)
                    ATT_VLOAD(vf[0], 0);
#pragma unroll
                    for (int et = 0; et < 4; ++et) {
                        if (et < 3) ATT_VLOAD(vf[(et + 1) & 1], et + 1);
                        __builtin_amdgcn_sched_barrier(0);
#pragma unroll
                        for (int ks = 0; ks < 4; ++ks) o[et] = MFMA32(vf[et & 1][ks], pf[ks], o[et]);
                        __builtin_amdgcn_sched_barrier(0); }
#undef ATT_VLOAD
                }
            }
            if (more) ATT_STORET((j + 1) & 1);
            if (j == 1 && ntu > 2) {
                float mmin = m;
#pragma unroll
                for (int o2 = 1; o2 < 32; o2 <<= 1) mmin = fminf(mmin, __shfl_xor(mmin, o2));
                const float x = (mmin - 100.f - bc - 63.f * slope2) / (64.f * slope2);
                int ktlo = x > 0.f ? (int)ceilf(x) : 0; if (ktlo > ntu - 2) ktlo = ntu - 2;
                if (lane == 0) ((LAS int*)(KNW + 32))[w] = ktlo; }
            __syncthreads();
            if (j == 1 && ntu > 2) { int lo8 = ntu; for (int w8 = 0; w8 < 8; ++w8) { const int v8 = ((LAS const int*)(KNW + 32))[w8]; lo8 = v8 < lo8 ? v8 : lo8; } nj = ntu - lo8; }
        }
#undef ATT_LOADT
#undef ATT_STORET
        l = xhalf_sum(l);
        const float inv = 1.0f / l;
#ifdef LSE_DIAG
        if (c == 0 && hi == 0) ((float*)(F.ws + WS_GATE))[(rowb + qpos) * 8 + h] = (m + log2f(l) - slope2 * (float)qpos) * 0.6931471805599453f;
#endif
        if (c == 1) {
#pragma unroll
            for (int et = 0; et < 4; ++et)
#pragma unroll
                for (int r = 0; r < 16; ++r) XCH[((g * 64 + et * 16 + r) * 2 + hi) * 32 + r32] = o[et][r] * inv;
        }
        __syncthreads();
        if (c == 0) {
            float ss = 0.f;
#pragma unroll
            for (int et = 0; et < 4; ++et)
#pragma unroll
                for (int r = 0; r < 16; ++r) { const float v = o[et][r] * inv - lam_full * XCH[((g * 64 + et * 16 + r) * 2 + hi) * 32 + r32]; o[et][r] = v; ss += v * v; }
            ss = xhalf_sum(ss);
            const float rn = rsqrtf(ss * (1.f / 128.f) + EPS) * (1.f - LAMBDA_INIT);
            const float* sg = F.in[I_ASUBLN];
            bf16* orow = Ob + (rowb + qpos) * 1024 + h * 128;
#pragma unroll
            for (int et = 0; et < 4; ++et)
#pragma unroll
                for (int r4 = 0; r4 < 4; ++r4) { const int e0 = et * 32 + 8 * r4 + 4 * hi; const f32x4 gv = *(const GAS f32x4*)(sg + e0);
                    v2u wv; wv.x = pk2(o[et][4 * r4 + 0] * rn * gv.x, o[et][4 * r4 + 1] * rn * gv.y); wv.y = pk2(o[et][4 * r4 + 2] * rn * gv.z, o[et][4 * r4 + 3] * rn * gv.w);
                    *(GAS v2u*)(orow + e0) = wv; }
        }
    }
    }
    __syncthreads();
}
#define HAVE_ML 1
#define MFMA16(a, b, c) __builtin_amdgcn_mfma_f32_16x16x32_bf16((a), (b), (c), 0, 0, 0)
constexpr float KSCALE = 0.04419417382415922f;
constexpr size_t WS_XM = A_(128), WS_QB = A_(0), WS_KB = A_(256), WS_ZB = A_(256), WS_H2B = A_(0);
constexpr size_t WS_WC = WS_TAB + 64 * 1024;
constexpr size_t WS_WPP = WS_TAB + 128 * 1024;
__device__ __forceinline__ f32x4 bf4_to_f32(v2u w) { return (f32x4){bf_lo(w.x), bf_hi(w.x), bf_lo(w.y), bf_hi(w.y)}; }
__device__ __forceinline__ v2u f32_to_bf4(f32x4 v) { v2u w; w.x = pk2(v.x, v.y); w.y = pk2(v.z, v.w); return w; }
__device__ __forceinline__ f32x4 conv_silu(const f32x4 (&xm)[4], const f32x4 (&cw)[4], f32x4 cb) {
    f32x4 a = cb + xm[0] * cw[0] + xm[1] * cw[1] + xm[2] * cw[2] + xm[3] * cw[3];
    return (f32x4){fsilu(a.x), fsilu(a.y), fsilu(a.z), fsilu(a.w)};
}
__device__ __forceinline__ f32x4 hw4(f32x4 x, const f32x4 (&w)[4]) { return w[0] * x.x + w[1] * x.y + w[2] * x.z + w[3] * x.w; }

__device__ __forceinline__ void p_mlprep(Frame& F) {
    LAS float* wv = (LAS float*)F.lds;
    const float* wg = F.in[I_WGATE];
    if ((int)blockIdx.x < 17) {
        for (int e = F.tid; e < 2048 * 8; e += 512) { const int f = e >> 3, o = e & 7, g = f >> 2, i = f & 3; float s = 0.f, c = 0.f;
#pragma unroll
            for (int o2 = 0; o2 < 4; ++o2) { s += F.in[I_WV][g * 16 + i * 4 + o2] * wg[(size_t)(4096 + 4 * g + o2) * 8 + o];
                c += F.in[I_WQ][g * 16 + i * 4 + o2] * wg[(size_t)(4 * g + o2) * 8 + o] + F.in[I_WK][g * 16 + i * 4 + o2] * wg[(size_t)(2048 + 4 * g + o2) * 8 + o]; }
            wv[e] = s; if (blockIdx.x == 16) ((float*)(F.ws + WS_WC))[e] = c; }
        __syncthreads();
        if (blockIdx.x < 16) { const int d = blockIdx.x * 64 + (F.tid >> 3), o = F.tid & 7; const float* wi = F.in[I_MWIN] + (size_t)d * 4096; float s = 0.f;
            for (int f = 0; f < 2048; ++f) s += wi[f] * wv[f * 8 + o];
            ((float*)(F.ws + WS_WPP))[d * 8 + o] = s; }
    }
    __syncthreads();
}

__device__ __forceinline__ void p_normb(Frame& F, const bf16* Y, const float* gpost, const float* modg, const float* gn, const float* modn, bf16* Hout) {
    LAS float* wr = (LAS float*)F.lds;
    for (int e = F.tid; e < 8192 / 4; e += 512) ((LAS f32x4*)wr)[e] = ((const GAS f32x4*)(F.ws + WS_WPP))[e];
    __syncthreads();
    float* G = (float*)(F.ws + WS_GATE); const int lane = F.lane;
    ROWBLOCK(m0, m1);
    Row16 ynx = load_row_bf16(Y + (size_t)m0 * D, lane), xnx = load_row_f32(F.X + (size_t)m0 * D, lane);
    for (int m = m0; m < m1; ++m) { const int b = m >> 11; const float* mb = modn + (size_t)b * 6144;
        const Row16 gp = load_row_f32(gpost, lane), gt = load_row_f32(modg + (size_t)b * 6144 + 5 * 1024, lane);
        const Row16 y = ynx, xo = xnx; if (m + 1 < m1) { ynx = load_row_bf16(Y + (size_t)(m + 1) * D, lane); xnx = load_row_f32(F.X + (size_t)(m + 1) * D, lane); }
        const float r1 = rsqrtf(row_ss(y) * (1.f / D) + EPS);
        Row16 xn;
#pragma unroll
        for (int j = 0; j < 4; ++j) xn.v[j] = xo.v[j] + gt.v[j] * (y.v[j] * r1 * gp.v[j]);
        store_row_f32(F.X + (size_t)m * D, lane, xn);
        const float r2 = rsqrtf(row_ss(xn) * (1.f / D) + EPS);
        const Row16 gg = load_row_f32(gn, lane), sc = load_row_f32(mb + 1024, lane), sh = load_row_f32(mb, lane); Row16 h;
#pragma unroll
        for (int j = 0; j < 4; ++j) h.v[j] = xn.v[j] * r2 * gg.v[j] * (sc.v[j] + 1.0f) + sh.v[j];
        store_row_bf16(Hout + (size_t)m * D, lane, h);
        f32x4 a0 = {0.f, 0.f, 0.f, 0.f}, a1 = {0.f, 0.f, 0.f, 0.f};
#pragma unroll
        for (int j = 0; j < 4; ++j)
#pragma unroll
            for (int c = 0; c < 4; ++c) { const int f = 4 * lane + 256 * j + c; const float hv = h.v[j][c];
                a0 += *(LAS const f32x4*)(wr + f * 8) * hv; a1 += *(LAS const f32x4*)(wr + f * 8 + 4) * hv; }
#pragma unroll
        for (int o = 1; o < 64; o <<= 1) { a0.x += __shfl_xor(a0.x, o); a0.y += __shfl_xor(a0.y, o); a0.z += __shfl_xor(a0.z, o); a0.w += __shfl_xor(a0.w, o);
            a1.x += __shfl_xor(a1.x, o); a1.y += __shfl_xor(a1.y, o); a1.z += __shfl_xor(a1.z, o); a1.w += __shfl_xor(a1.w, o); }
        if (lane == 0) { const f32x4 b0 = *(const GAS f32x4*)F.in[I_BGATE], b1 = *(const GAS f32x4*)(F.in[I_BGATE] + 4); *(GAS f32x4*)(G + (size_t)m * 8) = a0 + b0; *(GAS f32x4*)(G + (size_t)m * 8 + 4) = a1 + b1; }
    }
    __syncthreads();
}
__device__ __forceinline__ void p_h2b(Frame& F, const float* gn, const float* modn, bf16* Hout) {
    ROWBLOCK(m0, m1); int bc = -1; const Row16 gg = load_row_f32(gn, F.lane); Row16 sc, sh;
    Row16 xnx = load_row_f32(F.X + (size_t)m0 * D, F.lane);
    for (int m = m0; m < m1; ++m) { const int b = m >> 11;
        if (b != bc) { bc = b; const float* mb = modn + (size_t)b * 6144; sc = load_row_f32(mb + 1024, F.lane); sh = load_row_f32(mb, F.lane); }
        const Row16 x = xnx; if (m + 1 < m1) xnx = load_row_f32(F.X + (size_t)(m + 1) * D, F.lane);
        const float rstd = rsqrtf(row_ss(x) * (1.f / D) + EPS); Row16 h;
#pragma unroll
        for (int j = 0; j < 4; ++j) h.v[j] = x.v[j] * rstd * gg.v[j] * (sc.v[j] + 1.0f) + sh.v[j];
        store_row_bf16(Hout + (size_t)m * D, F.lane, h); }
}

__device__ __forceinline__ void p_gates2(Frame& F) {
    const bf16* XM = (const bf16*)(F.ws + WS_XM); float* G = (float*)(F.ws + WS_GATE); bf16* QB = (bf16*)(F.ws + WS_QB); bf16* KB = (bf16*)(F.ws + WS_KB);
    const int tid = F.tid, fg = tid, f0 = 4 * fg, lane = F.lane, l15 = lane & 15, q4 = lane >> 4, w = F.wave;
    constexpr int AP = 4112;
    LAS unsigned char* At = F.lds; LAS float* Pt = (LAS float*)(F.lds + 16 * AP);
    f32x4 cw[4], cb, wq[4], wk[4];
#pragma unroll
    for (int j = 0; j < 4; ++j) cw[j] = *(const GAS f32x4*)(F.in[I_CONVW] + j * 2048 + f0);
    cb = *(const GAS f32x4*)(F.in[I_CONVB] + f0);
#pragma unroll
    for (int i = 0; i < 4; ++i) { wq[i] = *(const GAS f32x4*)(F.in[I_WQ] + fg * 16 + i * 4); wk[i] = *(const GAS f32x4*)(F.in[I_WK] + fg * 16 + i * 4) * KSCALE; }
    bf16x8 bfr[8];
    { const float* wc = (const float*)(F.ws + WS_WC);
#pragma unroll
        for (int ks = 0; ks < 8; ++ks) { float v[8];
#pragma unroll
            for (int j = 0; j < 8; ++j) v[j] = l15 < 8 ? wc[(size_t)(256 * w + 32 * ks + 8 * q4 + j) * 8 + l15] : 0.f;
            v4u pw; pw.x = pk2(v[0], v[1]); pw.y = pk2(v[2], v[3]); pw.z = pk2(v[4], v[5]); pw.w = pk2(v[6], v[7]); bfr[ks] = __builtin_bit_cast(bf16x8, pw); } }
    const int vcu = F.gw >> 3;
    for (int run = vcu; run < T / 128; run += F.G) {
        const int t0 = run * 128, tb = t0 & (S - 1);
        f32x4 xm[4];
#pragma unroll
        for (int j = 0; j < 3; ++j) { const int tt = tb - 3 + j; xm[j + 1] = tt >= 0 ? bf4_to_f32(*(const GAS v2u*)(XM + (size_t)(t0 - 3 + j) * 2048 + f0)) : (f32x4){0.f, 0.f, 0.f, 0.f}; }
        for (int sb = 0; sb < 8; ++sb) {
            v2u xin[16];
#pragma unroll
            for (int tt = 0; tt < 16; ++tt) xin[tt] = *(const GAS v2u*)(XM + ((size_t)t0 + 16 * sb + tt) * 2048 + f0);
#pragma unroll
            for (int tt = 0; tt < 16; ++tt) { const size_t t = (size_t)t0 + 16 * sb + tt;
                xm[0] = xm[1]; xm[1] = xm[2]; xm[2] = xm[3];
                xm[3] = bf4_to_f32(xin[tt]);
                const f32x4 xc = conv_silu(xm, cw, cb);
                *(GAS v2u*)(QB + t * 2048 + f0) = f32_to_bf4(hw4(xc, wq));
                *(GAS v2u*)(KB + t * 2048 + f0) = f32_to_bf4(hw4(xc, wk));
                *(LAS v2u*)(At + tt * AP + fg * 8) = f32_to_bf4(xc); }
            __syncthreads();
            f32x4 acc = {0.f, 0.f, 0.f, 0.f};
#pragma unroll
            for (int ks = 0; ks < 8; ++ks) { const bf16x8 af = *(LAS const bf16x8*)(At + l15 * AP + (256 * w + 32 * ks + 8 * q4) * 2); acc = MFMA16(af, bfr[ks], acc); }
            if (l15 < 8) {
#pragma unroll
                for (int r = 0; r < 4; ++r) Pt[(w * 16 + 4 * q4 + r) * 8 + l15] = acc[r]; }
            __syncthreads();
            if (tid < 128) { const int tt = tid >> 3, o = tid & 7; float s = 0.f;
#pragma unroll
                for (int w8 = 0; w8 < 8; ++w8) s += Pt[(w8 * 16 + tt) * 8 + o];
                G[((size_t)t0 + 16 * sb + tt) * 8 + o] += s; }
        }
        __syncthreads();
    }
}

struct CellLds { static constexpr int QP = 528, VP = 288, WP = 144;
    static constexpr int QH = 0, KH = 64 * QP, VV = 2 * 64 * QP, WW = VV + 64 * VP, SC = WW + 64 * WP, NQP = SC + 2048  , PB = NQP + 2048  , END = PB + 3 * 8192 + 256; };
static_assert(CellLds::END <= RING_BYTES, "cell LDS map");
constexpr int SC_E1 = 0, SC_A = 64, SC_INTER = 128, SC_WS = 192, SC_EMT = 256, SC_HDEN = 320, SC_DECAY = 384, SC_MPREV = 385;

__device__ __forceinline__ bf16x8 cell_vfrag(LAS unsigned char* lds, int ks, int w, int q, int qq, int pp) {
    LAS const char* vp = (LAS const char*)(lds + CellLds::VV + (32 * ks + 8 * q + qq) * CellLds::VP + (16 * w + 4 * pp) * 2);
    const s16x4 lo = tr16(vp), hi4 = tr16(vp + 4 * CellLds::VP);
    return __builtin_shufflevector(lo, hi4, 0, 1, 2, 3, 4, 5, 6, 7);
}
__device__ __forceinline__ void cell_issue(v4u (&qk)[8], const bf16* QB, const bf16* KB, size_t row0, int h, int P, int tid) {
    const size_t off = (row0 + (tid >> 3)) * 2048 + h * 512 + 256 * P + (tid & 7) * 8;
#pragma unroll
    for (int i = 0; i < 4; ++i) { qk[i] = *(const GAS v4u*)(QB + off + 64 * i); qk[4 + i] = *(const GAS v4u*)(KB + off + 64 * i); }
}
__device__ __forceinline__ void cell_commit(const v4u (&qk)[8], LAS unsigned char* lds, int tid) {
    LAS unsigned char* p = lds + (tid >> 3) * CellLds::QP + (tid & 7) * 16;
#pragma unroll
    for (int i = 0; i < 4; ++i) { *(LAS v4u*)(p + CellLds::QH + 128 * i) = qk[i]; *(LAS v4u*)(p + CellLds::KH + 128 * i) = qk[4 + i]; }
}

template <int P>
__device__ __forceinline__ void cell_half_a(LAS unsigned char* lds, v2u (&ct)[32], f32x4 (&nt)[4], f32x4 (&zt)[4], f32x4 (&sacc)[2], int w, int lane) {
    using CL = CellLds;
    const int l15 = lane & 15, q = lane >> 4, qq = l15 >> 2, pp = l15 & 3;
    LAS const float* sc = (LAS const float*)(lds + CL::SC);
    { const int tt = w >> 1, st0 = 2 * (w & 1);
#pragma unroll
        for (int ks = 0; ks < 8; ++ks) { const bf16x8 af = *(LAS const bf16x8*)(lds + CL::QH + (16 * tt + l15) * CL::QP + (32 * ks + 8 * q) * 2);
#pragma unroll
            for (int j = 0; j < 2; ++j) { const bf16x8 bfr = *(LAS const bf16x8*)(lds + CL::KH + (16 * (st0 + j) + l15) * CL::QP + (32 * ks + 8 * q) * 2); sacc[j] = MFMA16(af, bfr, sacc[j]); } } }
#pragma unroll
    for (int kk = 0; kk < 8; ++kk) { const v2u c0 = ct[16 * P + 2 * kk], c1 = ct[16 * P + 2 * kk + 1];
        v4u aw; aw.x = c0.x; aw.y = c0.y; aw.z = c1.x; aw.w = c1.y;
        const bf16x8 af = __builtin_bit_cast(bf16x8, aw);
#pragma unroll
        for (int tt = 0; tt < 4; ++tt) { LAS const unsigned char* qp = lds + CL::QH + (16 * tt + l15) * CL::QP + (32 * kk + 4 * q) * 2;
            const v2u lo = *(LAS const v2u*)qp, hi2 = *(LAS const v2u*)(qp + 32);
            v4u bw; bw.x = lo.x; bw.y = lo.y; bw.z = hi2.x; bw.w = hi2.y;
            zt[tt] = MFMA16(af, __builtin_bit_cast(bf16x8, bw), zt[tt]); } }
    const bool mine = (w >> 2) == P;
    const int dl0 = 4 * (w & 3);
    if (mine) {
#pragma unroll
        for (int tt = 0; tt < 4; ++tt) { f32x4 nz = {0.f, 0.f, 0.f, 0.f};
#pragma unroll
            for (int k2 = 0; k2 < 2; ++k2) { v4u aw; aw.x = cvtpk(nt[2 * k2].x, nt[2 * k2].y); aw.y = cvtpk(nt[2 * k2].z, nt[2 * k2].w); aw.z = cvtpk(nt[2 * k2 + 1].x, nt[2 * k2 + 1].y); aw.w = cvtpk(nt[2 * k2 + 1].z, nt[2 * k2 + 1].w);
                LAS const unsigned char* qp = lds + CL::QH + (16 * tt + l15) * CL::QP + (32 * ((dl0 >> 1) + k2) + 4 * q) * 2;
                const v2u lo = *(LAS const v2u*)qp, hi2 = *(LAS const v2u*)(qp + 32);
                v4u bw; bw.x = lo.x; bw.y = lo.y; bw.z = hi2.x; bw.w = hi2.y;
                nz = MFMA16(__builtin_bit_cast(bf16x8, aw), __builtin_bit_cast(bf16x8, bw), nz); }
            if (q == 0) ((LAS float*)(lds + CL::NQP))[w * 64 + 16 * tt + l15] = nz.x; } }
}
template <int P>
__device__ __forceinline__ void cell_half_b(LAS unsigned char* lds, v2u (&ct)[32], f32x4 (&nt)[4], int w, int lane, float decay, float wsoff, LAS const float* pa) {
    using CL = CellLds;
    const int l15 = lane & 15, q = lane >> 4, qq = l15 >> 2, pp = l15 & 3;
    LAS const float* sc = (LAS const float*)(lds + CL::SC);
    const bool mine = (w >> 2) == P;
    {
        bf16x8 vpf[2], wsf[2];
#pragma unroll
        for (int ks = 0; ks < 2; ++ks) { const bf16x8 vfr = cell_vfrag(lds, ks, w, q, qq, pp);
            f32x4 w0 = *(LAS const f32x4*)(pa + 32 * ks + 8 * q) + wsoff, w1 = *(LAS const f32x4*)(pa + 32 * ks + 8 * q + 4) + wsoff;
            w0 = (f32x4){__expf(w0.x), __expf(w0.y), __expf(w0.z), __expf(w0.w)}; w1 = (f32x4){__expf(w1.x), __expf(w1.y), __expf(w1.z), __expf(w1.w)};
            const v4u vw = __builtin_bit_cast(v4u, vfr); v4u ow;
            ow.x = cvtpk(bf_lo(vw.x) * w0.x, bf_hi(vw.x) * w0.y); ow.y = cvtpk(bf_lo(vw.y) * w0.z, bf_hi(vw.y) * w0.w); ow.z = cvtpk(bf_lo(vw.z) * w1.x, bf_hi(vw.z) * w1.y); ow.w = cvtpk(bf_lo(vw.w) * w1.z, bf_hi(vw.w) * w1.w);
            vpf[ks] = __builtin_bit_cast(bf16x8, ow);
            v4u sw; if (l15 == 0) { sw.x = cvtpk(w0.x, w0.y); sw.y = cvtpk(w0.z, w0.w); sw.z = cvtpk(w1.x, w1.y); sw.w = cvtpk(w1.z, w1.w); } else { sw = (v4u){0u, 0u, 0u, 0u}; }
            wsf[ks] = __builtin_bit_cast(bf16x8, sw); }
#pragma unroll
        for (int dt = 0; dt < 16; ++dt) { f32x4 acc = bf4_to_f32(ct[16 * P + dt]) * decay;
            f32x4 nacc = {0.f, 0.f, 0.f, 0.f}; const bool nmine = mine && (dt >> 2) == (w & 3);
            if (nmine) nacc = nt[dt & 3] * decay;
#pragma unroll
            for (int ks = 0; ks < 2; ++ks) { LAS const char* kp = (LAS const char*)(lds + CL::KH + (32 * ks + 8 * q + qq) * CL::QP + (16 * dt + 4 * pp) * 2);
                const s16x4 lo = tr16(kp), hi4 = tr16(kp + 4 * CL::QP);
                const bf16x8 kf = __builtin_shufflevector(lo, hi4, 0, 1, 2, 3, 4, 5, 6, 7);
                acc = MFMA16(kf, vpf[ks], acc);
                if (nmine) nacc = MFMA16(kf, wsf[ks], nacc); }
            v2u cw2; cw2.x = cvtpk(acc.x, acc.y); cw2.y = cvtpk(acc.z, acc.w); ct[16 * P + dt] = cw2;
            if (nmine) nt[dt & 3] = nacc; } }
}

__device__ __forceinline__ void p_cell2(Frame& F) {
    using CL = CellLds;
    const bf16* XM = (const bf16*)(F.ws + WS_XM); const bf16* QB = (const bf16*)(F.ws + WS_QB); const bf16* KB = (const bf16*)(F.ws + WS_KB);
    const float* G = (const float*)(F.ws + WS_GATE); bf16* HH = (bf16*)(F.ws + WS_HH);
    LAS unsigned char* lds = F.lds;
    LAS float* sc = (LAS float*)(lds + CL::SC);
    LAS float* PB = (LAS float*)(lds + CL::PB); LAS float* PA = PB + 2048; LAS float* PM = PA + 2048; LAS float* BL = PM + 2048; LAS float* AM = BL + 32;
    const int tid0 = F.tid, w = F.wave;
    const int vcu = F.gw >> 3;
    for (int wi = vcu; wi < B * NH * 4; wi += F.G) {
        const int vs = wi & 3, h = (wi >> 2) & 3, b = wi >> 4;
        v2u ct[32]; f32x4 nt[4];
#pragma unroll
        for (int i = 0; i < 32; ++i) ct[i] = (v2u){0u, 0u};
#pragma unroll
        for (int i = 0; i < 4; ++i) nt[i] = (f32x4){0.f, 0.f, 0.f, 0.f};
        __syncthreads();
        { const int lane0 = tid0 & 63;
#pragma unroll 1
            for (int cc = 0; cc < 4; ++cc) { const int ch = 4 * w + cc; const size_t r = (size_t)b * S + 64 * ch + lane0;
                const float ip = G[r * 8 + h], fp_ = G[r * 8 + 4 + h];
                float bcum = fminf(fp_, 0.f) - __logf(1.f + __expf(-fabsf(fp_)));
#pragma unroll
                for (int o = 1; o < 64; o <<= 1) { const float t2 = __shfl_up(bcum, o); if (lane0 >= o) bcum += t2; }
                const float a = ip - bcum; float pm = a;
#pragma unroll
                for (int o = 1; o < 64; o <<= 1) { const float t2 = __shfl_up(pm, o); if (lane0 >= o) pm = fmaxf(pm, t2); }
                PB[64 * ch + lane0] = bcum; PA[64 * ch + lane0] = a; PM[64 * ch + lane0] = pm;
                if (lane0 == 63) { BL[ch] = bcum; AM[ch] = pm; } } }
        __syncthreads();
        float mprev = 0.f;
        for (int c = 0; c < S / 64; ++c) {
            int tid = tid0; asm volatile("" : "+v"(tid));
            const int lane = tid & 63, l15 = lane & 15, q = lane >> 4, qq = l15 >> 2, pp = l15 & 3;
            const size_t row0 = (size_t)b * S + 64 * c;
            const float blast = BL[c], mnew = fmaxf(blast + mprev, blast + AM[c]), decay = __expf(blast + mprev - mnew);
            { v4u q0[8]; cell_issue(q0, QB, KB, row0, h, 0, tid); cell_commit(q0, lds, tid); }
            { const int vg = tid & 31, t4 = 4 * (tid >> 5), fv = h * 512 + vs * 128 + 4 * vg;
                f32x4 wv[4];
#pragma unroll
                for (int i = 0; i < 4; ++i) wv[i] = *(const GAS f32x4*)(F.in[I_WV] + (size_t)(fv >> 2) * 16 + i * 4);
#pragma unroll
                for (int t = 0; t < 4; ++t) *(LAS v2u*)(lds + CL::VV + (t4 + t) * CL::VP + vg * 8) = f32_to_bf4(hw4(bf4_to_f32(*(const GAS v2u*)(XM + (row0 + t4 + t) * 2048 + fv)), wv)); }
            __syncthreads();
            f32x4 zt[4], sacc[2];
#pragma unroll
            for (int i = 0; i < 4; ++i) zt[i] = (f32x4){0.f, 0.f, 0.f, 0.f};
            sacc[0] = (f32x4){0.f, 0.f, 0.f, 0.f}; sacc[1] = sacc[0];
            cell_half_a<0>(lds, ct, nt, zt, sacc, w, lane);
            v4u qk[8]; cell_issue(qk, QB, KB, row0, h, 1, tid);
            cell_half_b<0>(lds, ct, nt, w, lane, decay, blast - mnew, PA + 64 * c);
            __syncthreads();
            cell_commit(qk, lds, tid);
            __syncthreads();
            { int l3 = lane; asm volatile("" : "+v"(l3)); cell_half_a<1>(lds, ct, nt, zt, sacc, w, l3);
              cell_half_b<1>(lds, ct, nt, w, l3, decay, blast - mnew, PA + 64 * c); }
            { const int tt = w >> 1, st0 = 2 * (w & 1);
#pragma unroll
                for (int j = 0; j < 2; ++j) { const int s = 16 * (st0 + j) + l15; const float as = PA[64 * c + s];
#pragma unroll
                    for (int r = 0; r < 4; ++r) { const int t = 16 * tt + 4 * q + r; const float wv2 = s <= t ? __expf(as - fmaxf(mprev, PM[64 * c + t])) * sacc[j][r] : 0.f;
                        *(LAS bf16*)(lds + CL::WW + t * CL::WP + s * 2) = (bf16)f2bf(wv2); } } }
            __syncthreads();
            { const int t = tid >> 3, part = tid & 7; const v4u ww = *(LAS const v4u*)(lds + CL::WW + t * CL::WP + part * 16);
                float ds = (bf_lo(ww.x) + bf_hi(ww.x)) + (bf_lo(ww.y) + bf_hi(ww.y)) + (bf_lo(ww.z) + bf_hi(ww.z)) + (bf_lo(ww.w) + bf_hi(ww.w));
                float nqv = ((LAS const float*)(lds + CL::NQP))[part * 64 + t];
                ds += __shfl_xor(ds, 1); ds += __shfl_xor(ds, 2); ds += __shfl_xor(ds, 4);
                nqv += __shfl_xor(nqv, 1); nqv += __shfl_xor(nqv, 2); nqv += __shfl_xor(nqv, 4);
                if (part == 0) { const float mxp = fmaxf(mprev, PM[64 * c + t]); const float den = ds + __expf(mprev - mxp) * nqv; sc[SC_HDEN + t] = 1.0f / fmaxf(fabsf(den), __expf(-(PB[64 * c + t] + mxp))); } }
#pragma unroll
            for (int tt = 0; tt < 4; ++tt) { zt[tt] = zt[tt] * __expf(mprev - fmaxf(mprev, PM[64 * c + 16 * tt + l15]));
#pragma unroll
                for (int ks = 0; ks < 2; ++ks) { const bf16x8 wf = *(LAS const bf16x8*)(lds + CL::WW + (16 * tt + l15) * CL::WP + (32 * ks + 8 * q) * 2); zt[tt] = MFMA16(cell_vfrag(lds, ks, w, q, qq, pp), wf, zt[tt]); } }
            __syncthreads();
#pragma unroll
            for (int tt = 0; tt < 4; ++tt) { const int t = 16 * tt + l15; const f32x4 o = zt[tt] * sc[SC_HDEN + t];
                *(GAS v2u*)(HH + (row0 + t) * 2048 + h * 512 + vs * 128 + 16 * w + 4 * q) = f32_to_bf4(o); }
            mprev = mnew;
        }
    }
    __syncthreads();
}

__device__ __forceinline__ void p_post(Frame& F) {
    const bf16* XM = (const bf16*)(F.ws + WS_XM); const bf16* ZB = (const bf16*)(F.ws + WS_ZB); bf16* HH = (bf16*)(F.ws + WS_HH);
    const int lane = F.lane;
    const int per = (T + F.NGW - 1) / F.NGW;
    for (int hd = 0; hd < NH; ++hd) {
        const int f0 = hd * 512 + 8 * lane;
        f32x4 cw[4][2], cb[2], sk[2], gn[2];
#pragma unroll
        for (int u = 0; u < 2; ++u) {
#pragma unroll
            for (int j = 0; j < 4; ++j) cw[j][u] = *(const GAS f32x4*)(F.in[I_CONVW] + j * 2048 + f0 + 4 * u);
            cb[u] = *(const GAS f32x4*)(F.in[I_CONVB] + f0 + 4 * u); sk[u] = *(const GAS f32x4*)(F.in[I_SKIP] + f0 + 4 * u); gn[u] = *(const GAS f32x4*)(F.in[I_MNORM] + f0 + 4 * u); }
        const int t0 = F.gw * per, t1 = (t0 + per < T) ? t0 + per : T;
        v4u xr[4];
#pragma unroll
        for (int j = 0; j < 3; ++j) { const int tt = t0 - 3 + j; xr[j + 1] = (tt >= 0 && (tt >> 11) == (t0 >> 11)) ? *(const GAS v4u*)(XM + (size_t)tt * 2048 + f0) : (v4u){0u, 0u, 0u, 0u}; }
        for (int t = t0; t < t1; ++t) {
            xr[0] = xr[1]; xr[1] = xr[2]; xr[2] = xr[3]; xr[3] = *(const GAS v4u*)(XM + (size_t)t * 2048 + f0);
            if ((t & (S - 1)) == 0) { xr[0] = (v4u){0u, 0u, 0u, 0u}; xr[1] = xr[0]; xr[2] = xr[0]; }
            const v4u hw = *(const GAS v4u*)(HH + (size_t)t * 2048 + f0);
            f32x4 hv[2] = {(f32x4){bf_lo(hw.x), bf_hi(hw.x), bf_lo(hw.y), bf_hi(hw.y)}, (f32x4){bf_lo(hw.z), bf_hi(hw.z), bf_lo(hw.w), bf_hi(hw.w)}};
            float s1 = (hv[0].x + hv[0].y) + (hv[0].z + hv[0].w) + (hv[1].x + hv[1].y) + (hv[1].z + hv[1].w);
            const float mu = wave_sum(s1) * (1.f / 512.f);
            hv[0] = hv[0] - mu; hv[1] = hv[1] - mu;
            float s2 = (hv[0].x * hv[0].x + hv[0].y * hv[0].y) + (hv[0].z * hv[0].z + hv[0].w * hv[0].w) + (hv[1].x * hv[1].x + hv[1].y * hv[1].y) + (hv[1].z * hv[1].z + hv[1].w * hv[1].w);
            const float rstd = rsqrtf(wave_sum(s2) * (1.f / 512.f) + EPS);
            f32x4 acc[2] = {cb[0], cb[1]};
#pragma unroll
            for (int j = 0; j < 4; ++j) { const v4u xw = xr[j];
                acc[0] += (f32x4){bf_lo(xw.x), bf_hi(xw.x), bf_lo(xw.y), bf_hi(xw.y)} * cw[j][0]; acc[1] += (f32x4){bf_lo(xw.z), bf_hi(xw.z), bf_lo(xw.w), bf_hi(xw.w)} * cw[j][1]; }
            const v4u zw = *(const GAS v4u*)(ZB + (size_t)t * 2048 + f0);
            const f32x4 z0 = (f32x4){bf_lo(zw.x), bf_hi(zw.x), bf_lo(zw.y), bf_hi(zw.y)}, z1 = (f32x4){bf_lo(zw.z), bf_hi(zw.z), bf_lo(zw.w), bf_hi(zw.w)};
            f32x4 o0 = hv[0] * rstd * gn[0] + sk[0] * (f32x4){fsilu(acc[0].x), fsilu(acc[0].y), fsilu(acc[0].z), fsilu(acc[0].w)};
            f32x4 o1 = hv[1] * rstd * gn[1] + sk[1] * (f32x4){fsilu(acc[1].x), fsilu(acc[1].y), fsilu(acc[1].z), fsilu(acc[1].w)};
            o0 = o0 * (f32x4){fsilu(z0.x), fsilu(z0.y), fsilu(z0.z), fsilu(z0.w)}; o1 = o1 * (f32x4){fsilu(z1.x), fsilu(z1.y), fsilu(z1.z), fsilu(z1.w)};
            v4u ow; ow.x = pk2(o0.x, o0.y); ow.y = pk2(o0.z, o0.w); ow.z = pk2(o1.x, o1.y); ow.w = pk2(o1.z, o1.w);
            *(GAS v4u*)(HH + (size_t)t * 2048 + f0) = ow;
        }
    }
}
#define HAVE_MOE 1
constexpr size_t RT_IDS = 0, RT_WTS = 256 * 1024, RT_POS = 512 * 1024, RT_STOK = 768 * 1024;
static_assert(RT_STOK + (size_t)MPAD * 4 <= 2 * MiB, "route tables");
constexpr int CW_WCNT = 150000;

__device__ __forceinline__ void p_normc(Frame& F, const bf16* Y, const float* gpost, const float* mod1, const float* gn, bf16* Hout) {
    LAS float* wr = (LAS float*)F.lds;
    for (int e = F.tid; e < 8192 / 4; e += 512) ((LAS f32x4*)wr)[e] = ((const GAS f32x4*)F.in[I_WROUTER])[e];
    __syncthreads();
    int* ids = (int*)(F.ws + WS_ROUTE + RT_IDS); float* wts = (float*)(F.ws + WS_ROUTE + RT_WTS);
    int cnt[8];
#pragma unroll
    for (int e = 0; e < 8; ++e) cnt[e] = 0;
    const int lane = F.lane;
    ROWBLOCK(m0, m1);
    for (int m = m0; m < m1; ++m) { const int b = m >> 11; const float* mb = mod1 + (size_t)b * 6144;
        const Row16 gp = load_row_f32(gpost, lane), gt = load_row_f32(mb + 2 * 1024, lane);
        const Row16 y = load_row_bf16(Y + (size_t)m * D, lane), xo = load_row_f32(F.X + (size_t)m * D, lane);
        const float r1 = rsqrtf(row_ss(y) * (1.f / D) + EPS);
        Row16 xn;
#pragma unroll
        for (int j = 0; j < 4; ++j) xn.v[j] = xo.v[j] + gt.v[j] * (y.v[j] * r1 * gp.v[j]);
        store_row_f32(F.X + (size_t)m * D, lane, xn);
        const float r2 = rsqrtf(row_ss(xn) * (1.f / D) + EPS);
        const Row16 gg = load_row_f32(gn, lane), sc = load_row_f32(mb + 4 * 1024, lane), sh = load_row_f32(mb + 3 * 1024, lane); Row16 h;
#pragma unroll
        for (int j = 0; j < 4; ++j) h.v[j] = xn.v[j] * r2 * gg.v[j] * (sc.v[j] + 1.0f) + sh.v[j];
        store_row_bf16(Hout + (size_t)m * D, lane, h);
        f32x4 a0 = {0.f, 0.f, 0.f, 0.f}, a1 = {0.f, 0.f, 0.f, 0.f};
#pragma unroll
        for (int j = 0; j < 4; ++j)
#pragma unroll
            for (int c = 0; c < 4; ++c) { const int f = 4 * lane + 256 * j + c; const float hv = h.v[j][c];
                a0 += *(LAS const f32x4*)(wr + f * 8) * hv; a1 += *(LAS const f32x4*)(wr + f * 8 + 4) * hv; }
#pragma unroll
        for (int o = 1; o < 64; o <<= 1) { a0.x += __shfl_xor(a0.x, o); a0.y += __shfl_xor(a0.y, o); a0.z += __shfl_xor(a0.z, o); a0.w += __shfl_xor(a0.w, o);
            a1.x += __shfl_xor(a1.x, o); a1.y += __shfl_xor(a1.y, o); a1.z += __shfl_xor(a1.z, o); a1.w += __shfl_xor(a1.w, o); }
        float lg[8] = {a0.x, a0.y, a0.z, a0.w, a1.x, a1.y, a1.z, a1.w};
        const float* br = F.in[I_BROUTER];
        float mx = -1e30f;
#pragma unroll
        for (int e = 0; e < 8; ++e) { lg[e] += br[e]; mx = fmaxf(mx, lg[e]); }
        int i0 = 0; float p0 = -1.f, p1 = -1.f; int i1 = 0;
#pragma unroll
        for (int e = 0; e < 8; ++e) { const float p = __expf(lg[e] - mx); if (p > p0) { p1 = p0; i1 = i0; p0 = p; i0 = e; } else if (p > p1) { p1 = p; i1 = e; } }
        const float inv = 1.0f / (p0 + p1);
        if (lane == 0) { ids[2 * m] = i0; ids[2 * m + 1] = i1; wts[2 * m] = p0 * inv; wts[2 * m + 1] = p1 * inv; }
#pragma unroll
        for (int e = 0; e < 8; ++e) cnt[e] += (i0 == e) + (i1 == e);
    }
    if (lane == 0) { unsigned* wc = (unsigned*)(F.ctl + CW_WCNT) + (size_t)F.gw * 8;
#pragma unroll
        for (int e = 0; e < 8; ++e) wc[e] = (unsigned)cnt[e]; }
    __syncthreads();
    for (int e = 0; e < NE; ++e) {
        convert_matrix(F, F.in[I_EWG] + (size_t)e * 1024 * F2, 1024, F2, (bf16*)(F.ws + WS_WMGU) + (size_t)e * 2 * F2 * 1024, 1);
        convert_matrix(F, F.in[I_EWU] + (size_t)e * 1024 * F2, 1024, F2, (bf16*)(F.ws + WS_WMGU) + (size_t)e * 2 * F2 * 1024, 2);
    }
}

__device__ __forceinline__ void p_sort(Frame& F) {
    LAS int* sh = (LAS int*)F.lds;
    const unsigned* wc = (const unsigned*)(F.ctl + CW_WCNT);
    const int NW = F.NGW;
    const int myw0 = (F.gw >> 3) << 3;
    { const int e = F.tid & 7, part = F.tid >> 3; int tot = 0, before = 0;
        for (int gwi = part; gwi < NW; gwi += 64) { const int c = (int)wc[(size_t)gwi * 8 + e]; tot += c; if (gwi < myw0) before += c; }
        for (int o = 8; o < 64; o <<= 1) { tot += __shfl_xor(tot, o); before += __shfl_xor(before, o); }
        LAS int* red = sh + 128;
        if (F.lane < 8) { red[(F.wave * 8 + e) * 2] = tot; red[(F.wave * 8 + e) * 2 + 1] = before; }
        __syncthreads();
        if (F.tid < 8) { int t2 = 0, b2 = 0; for (int w8 = 0; w8 < 8; ++w8) { t2 += red[(w8 * 8 + F.tid) * 2]; b2 += red[(w8 * 8 + F.tid) * 2 + 1]; } sh[F.tid] = t2; sh[100 + F.tid] = b2; }
        __syncthreads();
        if (F.tid == 0) { int off = 0; for (int e2 = 0; e2 < 8; ++e2) { sh[8 + e2] = off; off += (sh[e2] + 255) & ~255; } sh[16] = off; }
        if (F.tid < 64) { const int w8 = F.tid >> 3, e2 = F.tid & 7; int bs = sh[100 + e2]; for (int ww = 0; ww < w8; ++ww) bs += (int)wc[(size_t)(myw0 + ww) * 8 + e2]; sh[32 + w8 * 8 + e2] = bs; }
        __syncthreads();
    }
    int* tab = (int*)(F.ws + WS_TAB); int* stok = (int*)(F.ws + WS_ROUTE + RT_STOK); int* pos = (int*)(F.ws + WS_ROUTE + RT_POS); const int* ids = (const int*)(F.ws + WS_ROUTE + RT_IDS);
    const int mpadv = sh[16];
    if (blockIdx.x == 0) {
        if (F.tid == 0) { tab[TAB_NPANELS] = mpadv >> 8; for (int e = 0; e <= 8; ++e) tab[TAB_EOFF + e] = sh[8 + e]; }
        for (int p = F.tid; p < (mpadv >> 8); p += 512) { int e = 0; for (int e2 = 1; e2 < 8; ++e2) if (p * 256 >= sh[8 + e2]) e = e2; tab[TAB_PEXP + p] = e; }
        for (int e = 0; e < 8; ++e) for (int r = sh[8 + e] + sh[e] + F.tid; r < sh[9 + e]; r += 512) stok[r] = 0;
    }
    if (F.lane == 0) { int run[8];
#pragma unroll
        for (int e = 0; e < 8; ++e) run[e] = sh[8 + e] + sh[32 + F.wave * 8 + e];
        ROWBLOCK(m0, m1);
        for (int m = m0; m < m1; ++m) {
#pragma unroll
            for (int j = 0; j < 2; ++j) { const int e = ids[2 * m + j]; int p = 0;
#pragma unroll
                for (int e2 = 0; e2 < 8; ++e2) if (e == e2) { p = run[e2]; run[e2] = p + 1; }
                stok[p] = m; pos[2 * m + j] = p; } } }
    __syncthreads();
    for (int e = 0; e < NE; ++e) convert_matrix(F, F.in[I_EWD] + (size_t)e * F2 * 1024, F2, 1024, (bf16*)(F.ws + WS_WMD) + (size_t)e * 1024 * F2, 0);
}

__device__ __forceinline__ void p_gather(Frame& F, int p_lo, int np) {
    const bf16* H = (const bf16*)(F.ws + WS_H); bf16* HS = (bf16*)(F.ws + WS_HS); const int* stok = (const int*)(F.ws + WS_ROUTE + RT_STOK);
    for (int r = F.gw; r < np * 256; r += F.NGW) { const int tk = stok[p_lo * 256 + r];
        const GAS v4u* src = (const GAS v4u*)(H + (size_t)tk * D) + F.lane; GAS v4u* dst = (GAS v4u*)(HS + (size_t)r * D) + F.lane;
        dst[0] = src[0]; dst[64] = src[64]; }
}
__device__ __forceinline__ void p_final(Frame& F, const float* gpost, const float* mod1) {
    const bf16* YM = (const bf16*)(F.ws + WS_YM); const int* pos = (const int*)(F.ws + WS_ROUTE + RT_POS); const float* wts = (const float*)(F.ws + WS_ROUTE + RT_WTS);
    const int lane = F.lane;
    ROWBLOCK(m0, m1); int bc = -1; const Row16 gp = load_row_f32(gpost, lane); Row16 gt;
    for (int m = m0; m < m1; ++m) { const int b = m >> 11;
        if (b != bc) { bc = b; gt = load_row_f32(mod1 + (size_t)b * 6144 + 5 * 1024, lane); }
        const int p0 = pos[2 * m], p1 = pos[2 * m + 1]; const float w0 = wts[2 * m], w1 = wts[2 * m + 1];
        const Row16 y0 = load_row_bf16(YM + (size_t)p0 * D, lane), y1 = load_row_bf16(YM + (size_t)p1 * D, lane); Row16 y;
#pragma unroll
        for (int j = 0; j < 4; ++j) y.v[j] = y0.v[j] * w0 + y1.v[j] * w1;
        const float r1 = rsqrtf(row_ss(y) * (1.f / D) + EPS);
        const Row16 xo = load_row_f32(F.X + (size_t)m * D, lane); Row16 xn;
#pragma unroll
        for (int j = 0; j < 4; ++j) xn.v[j] = xo.v[j] + gt.v[j] * (y.v[j] * r1 * gp.v[j]);
        store_row_f32(F.X + (size_t)m * D, lane, xn); }
}
struct Args { const float* in[28]; float* out; unsigned char* ws; int ph_lo, ph_hi, li, pad; };
enum { PH_PRO = 0, PH_H0, PH_QKV, PH_ATTN, PH_WO, PH_NORMA, PH_FGU, PH_FD, PH_NORMB, PH_MIN, PH_GATES, PH_CELL, PH_H2B, PH_MINZ, PH_POST, PH_MOUT, PH_NORMC, PH_SORT, PH_MOE0  ,
       PH_FINAL = PH_MOE0 + 3 * MOE_ROUNDS, PH_COUNT };

__global__ void __launch_bounds__(NWAVES * 64, 2) mega(Args args) {
    extern __shared__ __attribute__((aligned(16))) unsigned char lds[];
    Frame F;
    F.lds = (LAS unsigned char*)lds;
    F.MISC = (volatile LAS unsigned*)(F.lds + MISC_OFF);
    F.tid = threadIdx.x; F.lane = F.tid & 63; F.wave = __builtin_amdgcn_readfirstlane(F.tid >> 6);
    F.G = gridDim.x; { const int bx = blockIdx.x; const int vcu = (F.G % 8 == 0) ? (bx % 8) * (F.G / 8) + bx / 8 : bx; F.gw = vcu * NWAVES + F.wave; F.NGW = F.G * NWAVES; }
    F.ws = args.ws; F.ctl = (gu32*)(args.ws + WS_CTL); F.in = args.in; F.X = args.out;
    for (int u = F.tid; u < (LDS_BYTES - LDSCTL_OFF) / 4; u += NWAVES * 64) ((LAS unsigned*)(F.lds + LDSCTL_OFF))[u] = 0u;
    __syncthreads();
    XcdBarrier bar = xcd_barrier_post((unsigned*)(F.ctl + CW_BAR) + args.li * XCD_BAR_WORDS, F.MISC + 8);
    const int lo = args.ph_lo, hi = args.ph_hi;
#define IN(k) (lo <= (k) && (k) < hi)
#define REFRESH() do { int l_ = (int)__builtin_amdgcn_mbcnt_hi(~0u, __builtin_amdgcn_mbcnt_lo(~0u, 0u)); asm volatile("" : "+v"(l_)); F.lane = l_; F.tid = F.wave * 64 + l_; } while (0)
#define SEAM(k) do { if (IN(k) && IN((k) + 1)) xcd_barrier(bar); } while (0)
#define UNI(p) ((const float*)((((unsigned long long)(unsigned)__builtin_amdgcn_readfirstlane((unsigned)((unsigned long long)(p) >> 32))) << 32) | (unsigned long long)(unsigned)__builtin_amdgcn_readfirstlane((unsigned)(unsigned long long)(p))))
#define WSP ((unsigned char*)UNI(args.ws))
#define mod0 UNI((const float*)(args.ws + WS_MOD))
#define mod1 UNI((const float*)(args.ws + WS_MOD) + 16 * 6144)
#define ng UNI(args.in[I_NORMG])

    if (IN(PH_PRO)) { REFRESH(); p_prologue(F); } SEAM(PH_PRO);
    if (IN(PH_H0)) { REFRESH(); p_h0(F, (bf16*)(WSP + WS_Y)); } SEAM(PH_H0);
    if (IN(PH_QKV)) { REFRESH();
        pg8::Gemm g{(const bf16*)(WSP + WS_Y), (const bf16*)(WSP + WS_W_AIN), T, 3072, 1024}; pg8::StaticOrder So; So.init(T, 3072, F.G, (int)blockIdx.x);
        pg8::EpiBf16 E{(bf16*)(WSP + WS_Q), 1024, 1024, (size_t)(WS_K - WS_Q) / 2, QSCALE};
        pg8::gemm_phase<pg8::EpiBf16, pg8::StaticOrder, false, false>(F.lds, g, So, E, nullptr);
    } SEAM(PH_QKV);
#ifdef HAVE_ATTN
    if (IN(PH_ATTN)) { REFRESH(); p_attn(F); } SEAM(PH_ATTN);
#endif
#ifdef HAVE_L0REST
    if (IN(PH_WO)) { REFRESH();
        pg8::Gemm g{(const bf16*)(WSP + WS_O), (const bf16*)(WSP + WS_W_AOUT), T, 1024, 1024}; pg8::StaticOrder So; So.init(T, 1024, F.G, (int)blockIdx.x);
        pg8::EpiBf16 E{(bf16*)(WSP + WS_Y), 1024, 0, 0, 1.f};
        pg8::gemm_phase<pg8::EpiBf16, pg8::StaticOrder, false, false>(F.lds, g, So, E, nullptr);
    } SEAM(PH_WO);
    if (IN(PH_NORMA)) { REFRESH(); p_norm(F, F.in[I_X], (const bf16*)(WSP + WS_Y), ng + 1024, mod0, 2, ng + 2048, mod0, 3, (bf16*)(WSP + WS_H)); } SEAM(PH_NORMA);
    if (IN(PH_FGU)) { REFRESH();
        pg8::Gemm g{(const bf16*)(WSP + WS_H), (const bf16*)(WSP + WS_W_FGU), T, 2 * F1, 1024}; pg8::StaticOrder So; So.init(T, 2 * F1, F.G, (int)blockIdx.x);
        pg8::EpiSwiglu E{(bf16*)(WSP + WS_ACT), F1};
        pg8::gemm_phase<pg8::EpiSwiglu, pg8::StaticOrder, false, false>(F.lds, g, So, E, nullptr);
    } SEAM(PH_FGU);
    if (IN(PH_FD)) { REFRESH();
        pg8::Gemm g{(const bf16*)(WSP + WS_ACT), (const bf16*)(WSP + WS_W_FD), T, 1024, F1}; pg8::StaticOrder So; So.init(T, 1024, F.G, (int)blockIdx.x);
        pg8::EpiBf16 E{(bf16*)(WSP + WS_Y), 1024, 0, 0, 1.f};
        pg8::gemm_phase<pg8::EpiBf16, pg8::StaticOrder, false, false>(F.lds, g, So, E, nullptr);
    } SEAM(PH_FD);
    if (IN(PH_NORMB)) { REFRESH(); p_normb(F, (const bf16*)(WSP + WS_Y), ng + 3072, mod0, ng + 4096, mod1, (bf16*)(WSP + WS_H)); } SEAM(PH_NORMB);
#endif
#ifdef HAVE_ML
    if (IN(PH_MIN)) { REFRESH();
        pg8::Gemm g{(const bf16*)(WSP + WS_H), (const bf16*)(WSP + WS_W_MIN), T, 2048, 1024}; pg8::StaticOrder So; So.init(T, 2048, F.G, (int)blockIdx.x);
        pg8::EpiBf16 E{(bf16*)(WSP + WS_XM), 2048, 0, 0, 1.f};
        pg8::gemm_phase<pg8::EpiBf16, pg8::StaticOrder, false, false>(F.lds, g, So, E, nullptr);
    } SEAM(PH_MIN);
    if (IN(PH_GATES)) { REFRESH(); p_gates2(F); } SEAM(PH_GATES);
    if (IN(PH_CELL)) { REFRESH(); p_cell2(F); } SEAM(PH_CELL);
    if (IN(PH_H2B)) { REFRESH(); p_h2b(F, ng + 4096, mod1, (bf16*)(WSP + WS_H2B)); } SEAM(PH_H2B);
    if (IN(PH_MINZ)) { REFRESH();
        pg8::Gemm g{(const bf16*)(WSP + WS_H2B), (const bf16*)(WSP + WS_W_MIN) + (size_t)2048 * 1024, T, 2048, 1024}; pg8::StaticOrder So; So.init(T, 2048, F.G, (int)blockIdx.x);
        pg8::EpiBf16 E{(bf16*)(WSP + WS_ZB), 2048, 0, 0, 1.f};
        pg8::gemm_phase<pg8::EpiBf16, pg8::StaticOrder, false, false>(F.lds, g, So, E, nullptr);
    } SEAM(PH_MINZ);
    if (IN(PH_POST)) { REFRESH(); p_post(F); } SEAM(PH_POST);
    if (IN(PH_MOUT)) { REFRESH();
        pg8::Gemm g{(const bf16*)(WSP + WS_HH), (const bf16*)(WSP + WS_W_MOUT), T, 1024, 2048}; pg8::StaticOrder So; So.init(T, 1024, F.G, (int)blockIdx.x);
        pg8::EpiBf16 E{(bf16*)(WSP + WS_Y), 1024, 0, 0, 1.f};
        pg8::gemm_phase<pg8::EpiBf16, pg8::StaticOrder, false, false>(F.lds, g, So, E, nullptr);
    } SEAM(PH_MOUT);
#endif
#ifdef HAVE_MOE
    if (IN(PH_NORMC)) { REFRESH(); p_normc(F, (const bf16*)(WSP + WS_Y), ng + 5120, mod1, ng + 6144, (bf16*)(WSP + WS_H)); } SEAM(PH_NORMC);
    if (IN(PH_SORT)) { REFRESH(); p_sort(F); } SEAM(PH_SORT);
#define MOE_ROUND(r) \
    if ((r) == 0 && IN(PH_MOE0 + 3 * (r))) { REFRESH(); const int* tab = (const int*)(WSP + WS_TAB); const int p_lo = (r) * PR; int np = tab[TAB_NPANELS] - p_lo; np = np > PR ? PR : np; p_gather(F, p_lo, np); } \
    if ((r) == 0) SEAM(PH_MOE0 + 3 * (r));     \
    if ((r) < MOE_ROUNDS && IN(PH_MOE0 + 3 * (r) + 1)) { REFRESH(); const int* tab = (const int*)(WSP + WS_TAB); const int p_lo = (r) * PR; int np = tab[TAB_NPANELS] - p_lo; np = np > PR ? PR : np; \
        pg8::Gemm g{(const bf16*)(WSP + WS_HS), (const bf16*)(WSP + WS_WMGU), 0, 0, 1024}; pg8::MoeOrder<false> So; So.init(p_lo, np, 2 * F2 / 256, F.G, (int)blockIdx.x, tab + TAB_PEXP); \
        pg8::EpiSwiglu E{(bf16*)(WSP + WS_ACT2), F2}; \
        pg8::gemm_phase<pg8::EpiSwiglu, pg8::MoeOrder<false>, false, false>(F.lds, g, So, E, nullptr); } \
    if ((r) < MOE_ROUNDS) SEAM(PH_MOE0 + 3 * (r) + 1); \
    if ((r) < MOE_ROUNDS && IN(PH_MOE0 + 3 * (r) + 2)) { REFRESH(); const int* tab = (const int*)(WSP + WS_TAB); const int p_lo = (r) * PR; int np = tab[TAB_NPANELS] - p_lo; np = np > PR ? PR : np; \
        pg8::Gemm g{(const bf16*)(WSP + WS_ACT2), (const bf16*)(WSP + WS_WMD), 0, 0, F2}; pg8::MoeOrder<true> So; So.init(p_lo, np, 4, F.G, (int)blockIdx.x, tab + TAB_PEXP); \
        pg8::EpiBf16 E{(bf16*)(WSP + WS_YM), 1024, 0, 0, 1.f}; \
        pg8::gemm_phase<pg8::EpiBf16, pg8::MoeOrder<true>, false, false>(F.lds, g, So, E, nullptr); \
        if ((r) + 1 < MOE_ROUNDS) { REFRESH(); const int p_lo2 = ((r) + 1) * PR; int np2 = tab[TAB_NPANELS] - p_lo2; np2 = np2 > PR ? PR : np2; p_gather(F, p_lo2, np2); } } \
    if ((r) < MOE_ROUNDS) SEAM(PH_MOE0 + 3 * (r) + 2);
    MOE_ROUND(0) MOE_ROUND(1) MOE_ROUND(2) MOE_ROUND(3) MOE_ROUND(4)
#undef MOE_ROUND
    if (IN(PH_FINAL)) { REFRESH(); p_final(F, ng + 7168, mod1); }
#endif
#undef IN
#undef SEAM
#undef WSP
#undef mod0
#undef mod1
#undef ng
#undef UNI
}
}

#ifdef REFCHECK
namespace chk {
__host__ __device__ inline int srow(int b, int j) { return (37 + 523 * j + 61 * b) % 2048; }
constexpr int DIG_COLS = 4096;
__host__ __device__ inline size_t dig_off(int stage, int b, int j) { return ((size_t)(stage * 16 + b) * 4 + j) * DIG_COLS; }
__global__ void k_sample(const float* p, int ld, int ncols, float* dig, int stage, int b) {
    const int j = blockIdx.x; const float* src = p + (size_t)srow(b, j) * ld; float* dst = dig + dig_off(stage, b, j);
    for (int c = threadIdx.x; c < ncols; c += blockDim.x) dst[c] = src[c];
}
static void digest_cb(int stage, int b, const float* p, int ld, int ncols, hipStream_t st, void* ctx) {
    hipLaunchKernelGGL(k_sample, dim3(4), dim3(256), 0, st, p, ld, ncols, (float*)ctx, stage, b);
}
__global__ void k_check(const void* fast, int is_bf16, int ld, int ncols, float fscale, const float* dig, int stage, int coff, float tol, int code, unsigned* fail) {
    __shared__ float sh[2][16];
    float se = 0.f, sb = 0.f;
    for (int r = 0; r < 64; ++r) { const int b = r >> 2, j = r & 3; const size_t row = (size_t)b * 2048 + srow(b, j); const float* d = dig + dig_off(stage, b, j) + coff;
        for (int c = threadIdx.x; c < ncols; c += blockDim.x) {
            float f;
            if (is_bf16 == 2) { const unsigned v = ((const unsigned char*)fast)[row * ld + c]; const int e = (v >> 3) & 15, mm = v & 7; f = e ? exp2f((float)(e - 7)) * (1.f + mm * 0.125f) : 0.015625f * (mm * 0.125f); if (v & 128) f = -f; }
            else f = is_bf16 ? __builtin_bit_cast(float, (unsigned)((const unsigned short*)fast)[row * ld + c] << 16) : ((const float*)fast)[row * ld + c];
            f *= fscale; const float e = f - d[c]; se += e * e; sb += d[c] * d[c]; } }
    for (int o = 32; o > 0; o >>= 1) { se += __shfl_xor(se, o); sb += __shfl_xor(sb, o); }
    if ((threadIdx.x & 63) == 0) { sh[0][threadIdx.x >> 6] = se; sh[1][threadIdx.x >> 6] = sb; }
    __syncthreads();
    if (threadIdx.x == 0) { se = 0.f; sb = 0.f; for (int i = 0; i < (int)blockDim.x / 64; ++i) { se += sh[0][i]; sb += sh[1][i]; }
        const float rel = sqrtf(se / fmaxf(sb, 1e-30f));
        if (!(rel < tol)) atomicMin(fail, (unsigned)(2 * code + (rel < 0.3f ? 0 : 1))); }
}
__global__ void k_check2(const void* fast, int is_bf16, int ld, int c0, int c1, int cmask, int cval, int rshift, int rmask, int rval, const float* dig, int stage, float tol, int bit, unsigned* fail) {
    __shared__ float sh[2][16];
    float se = 0.f, sb = 0.f;
    for (int r = 0; r < 64; ++r) { const int b = r >> 2, j = r & 3; const int pos = srow(b, j); if (((pos >> rshift) & rmask) != rval) continue;
        const size_t row = (size_t)b * 2048 + pos; const float* d = dig + dig_off(stage, b, j);
        for (int c = c0 + threadIdx.x; c < c1; c += blockDim.x) { if ((c & cmask) != cval) continue;
            const float f = is_bf16 ? __builtin_bit_cast(float, (unsigned)((const unsigned short*)fast)[row * ld + c] << 16) : ((const float*)fast)[row * ld + c];
            const float e = f - d[c]; se += e * e; sb += d[c] * d[c]; } }
    for (int o = 32; o > 0; o >>= 1) { se += __shfl_xor(se, o); sb += __shfl_xor(sb, o); }
    if ((threadIdx.x & 63) == 0) { sh[0][threadIdx.x >> 6] = se; sh[1][threadIdx.x >> 6] = sb; }
    __syncthreads();
    if (threadIdx.x == 0) { se = 0.f; sb = 0.f; for (int i = 0; i < (int)blockDim.x / 64; ++i) { se += sh[0][i]; sb += sh[1][i]; }
        const float rel = sqrtf(se / fmaxf(sb, 1e-30f));
        if (!(rel < tol)) atomicOr(fail + 1, 1u << bit); }
}
__global__ void k_initfail(unsigned* fail) { fail[0] = 0x7fffffffu; fail[1] = 0u; }
__global__ void k_scale(float* out, size_t n, const unsigned* fail) {
    unsigned f = fail[0]; if (fail[1]) f = fail[1]; if (f == 0x7fffffffu) return; const float s = exp2f((float)f);
    for (size_t i = (size_t)blockIdx.x * blockDim.x + threadIdx.x; i < n; i += (size_t)gridDim.x * blockDim.x) out[i] *= s;
}
}
#endif

#ifdef REFCHECK
static ref::In make_in(void* const* d_in) {
    ref::In in;
    const float** p = (const float**)&in;
    for (int i = 0; i < 28; ++i) p[i] = (const float*)d_in[i];
    return in;
}
#endif
static int g_grid = 0;
static void launch_phases(const fp::Args& base, int lo, int hi, int li, hipStream_t stream) {
    fp::Args a = base; a.ph_lo = lo; a.ph_hi = hi; a.li = li; a.pad = 0;
    hipLaunchKernelGGL(fp::mega, dim3(g_grid), dim3(fp::NWAVES * 64), fp::LDS_BYTES, stream, a);
}
extern "C" void kernel_launch(void* const* d_in, const int* in_sizes, int n_in, void* d_out, int out_size, void* d_ws, size_t ws_size, hipStream_t stream) {
    if (g_grid == 0) {
        if (n_in != 28 || out_size != 32768 * 1024 || ws_size < fp::WS_NEED) { fprintf(stderr, "kernel_launch: unexpected shapes (n_in %d out %d ws %zu)\n", n_in, out_size, ws_size); g_grid = -1; return; }
        int dev = 0, cus = 0, per_cu = 0;
        if (hipGetDevice(&dev) != hipSuccess || hipDeviceGetAttribute(&cus, hipDeviceAttributeMultiprocessorCount, dev) != hipSuccess) { g_grid = -1; return; }
        if (hipFuncSetAttribute((const void*)fp::mega, hipFuncAttributeMaxDynamicSharedMemorySize, fp::LDS_BYTES) != hipSuccess) { fprintf(stderr, "kernel_launch: hipFuncSetAttribute failed\n"); g_grid = -1; return; }
        if (hipOccupancyMaxActiveBlocksPerMultiprocessor(&per_cu, (const void*)fp::mega, fp::NWAVES * 64, fp::LDS_BYTES) != hipSuccess || per_cu < 1) { fprintf(stderr, "kernel_launch: occupancy query says %d\n", per_cu); }
        (void)hipGetLastError();
        g_grid = cus;
    }
    if (g_grid < 0) return;
    hipMemsetAsync((char*)d_ws + fp::WS_CTL, 0, fp::CTL_ZERO_BYTES, stream);
    fp::Args a{};
    for (int i = 0; i < 28; ++i) a.in[i] = (const float*)d_in[i];
    a.out = (float*)d_out; a.ws = (unsigned char*)d_ws;
#ifdef REFCHECK
    ref::In in = make_in(d_in);
    float* dig = (float*)((unsigned char*)d_ws + fp::WS_DIG);
    unsigned* fail = (unsigned*)d_ws + fp::CW_FAIL;
    ref::forward(in, (float*)d_out, (unsigned char*)d_ws + 2 * fp::MiB, stream, chk::digest_cb, dig);
    hipMemsetAsync((char*)d_ws + fp::WS_CTL, 0, fp::CTL_ZERO_BYTES, stream);
    hipLaunchKernelGGL(chk::k_initfail, dim3(1), dim3(1), 0, stream, fail);
    unsigned char* ws = (unsigned char*)d_ws;
#define CHECK(ptr, isbf, ld, ncols, fscale, stage, coff, tol, code) hipLaunchKernelGGL(chk::k_check, dim3(1), dim3(1024), 0, stream, (const void*)(ptr), isbf, ld, ncols, fscale, dig, stage, coff, tol, code, fail)
    int li = 0;
    for (int ph = 0; ph < REFCHECK_PHASES; ++ph) {
        launch_phases(a, ph, ph + 1, li++, stream);
        switch (ph) {
        case fp::PH_H0: CHECK(ws + fp::WS_Y, 1, 1024, 1024, 1.f, 1, 0, 0.02f, 1); break;
        case fp::PH_QKV: CHECK(ws + fp::WS_Q, 1, 1024, 1024, 1.f / fp::QSCALE, 2, 0, 0.03f, 2); CHECK(ws + fp::WS_K, 1, 1024, 1024, 1.f, 2, 1024, 0.03f, 3); CHECK(ws + fp::WS_V, 1, 1024, 1024, 1.f, 2, 2048, 0.03f, 4); break;
        case fp::PH_ATTN: CHECK(ws + fp::WS_O, 1, 1024, 1024, 1.f, 3, 0, 0.05f, 8);
#ifdef LSE_DIAG
            CHECK(ws + fp::WS_GATE, 0, 8, 8, 1.f, 0, 0, 0.01f, 6);
#endif
#ifdef ATTN_DIAG
            for (int hb = 0; hb < 4; ++hb) hipLaunchKernelGGL(chk::k_check2, dim3(1), dim3(1024), 0, stream, (const void*)(ws + fp::WS_O), 1, 1024, hb * 256, hb * 256 + 256, 0, 0, 0, 0, 0, dig, 3, 0.03f, hb, fail);
            hipLaunchKernelGGL(chk::k_check2, dim3(1), dim3(1024), 0, stream, (const void*)(ws + fp::WS_O), 1, 1024, 0, 1024, 0, 0, 6, 1, 0, dig, 3, 0.03f, 4, fail);
            hipLaunchKernelGGL(chk::k_check2, dim3(1), dim3(1024), 0, stream, (const void*)(ws + fp::WS_O), 1, 1024, 0, 1024, 0, 0, 6, 1, 1, dig, 3, 0.03f, 5, fail);
#endif
            break;
        case fp::PH_WO: CHECK(ws + fp::WS_Y, 1, 1024, 1024, 1.f, 4, 0, 0.05f, 6); break;
        case fp::PH_NORMA: CHECK(d_out, 0, 1024, 1024, 1.f, 5, 0, 0.02f, 7); CHECK(ws + fp::WS_H, 1, 1024, 1024, 1.f, 6, 0, 0.03f, 8); break;
        case fp::PH_FGU: CHECK(ws + fp::WS_ACT, 1, fp::F1, fp::F1, 1.f, 7, 0, 0.05f, 9); break;
        case fp::PH_FD: CHECK(ws + fp::WS_Y, 1, 1024, 1024, 1.f, 8, 0, 0.05f, 10); break;
        case fp::PH_NORMB: CHECK(d_out, 0, 1024, 1024, 1.f, 9, 0, 0.02f, 11); CHECK(ws + fp::WS_H, 1, 1024, 1024, 1.f, 10, 0, 0.03f, 12); break;
        case fp::PH_MIN: CHECK(ws + fp::WS_XM, 1, 2048, 2048, 1.f, 11, 0, 0.03f, 13); break;
        case fp::PH_MINZ: CHECK(ws + fp::WS_ZB, 1, 2048, 2048, 1.f, 11, 2048, 0.03f, 22); break;
        case fp::PH_GATES: CHECK(ws + fp::WS_GATE, 0, 8, 8, 1.f, 16, 0, 0.03f, 14); break;
#ifdef CELL_DUMP2
        case fp::PH_CELL: CHECK(ws + fp::WS_HH, 1, 2048, 2048, 1.f, 15, 0, 0.03f, 18); CHECK(ws + fp::WS_Y, 0, 4, 4, 1.f, 0, 0, 0.03f, 19); break;
#elif defined(CELL_DUMP) || defined(CELL_DUMP3)
        case fp::PH_CELL: CHECK(ws + fp::WS_Y, 1, 2048, 2048, 1.f, 13, 0, 0.03f, 18); CHECK(ws + fp::WS_HH, 1, 2048, 2048, 1.f / fp::KSCALE, 14, 0, 0.03f, 19); break;
#else
        case fp::PH_CELL: CHECK(ws + fp::WS_HH, 1, 2048, 2048, 1.f, 17, 0, 0.35f, 15); break;
#endif
        case fp::PH_POST: CHECK(ws + fp::WS_HH, 1, 2048, 2048, 1.f, 18, 0, 0.05f, 16); break;
        case fp::PH_MOUT: CHECK(ws + fp::WS_Y, 1, 1024, 1024, 1.f, 19, 0, 0.05f, 17); break;
#ifdef HAVE_MOE
        case fp::PH_NORMC: CHECK(d_out, 0, 1024, 1024, 1.f, 20, 0, 0.02f, 18); CHECK(ws + fp::WS_H, 1, 1024, 1024, 1.f, 21, 0, 0.03f, 19); CHECK(ws + fp::WS_ROUTE + fp::RT_WTS, 0, 2, 2, 1.f, 22, 0, 0.15f, 20); break;
        case fp::PH_FINAL: CHECK(d_out, 0, 1024, 1024, 1.f, 24, 0, 0.10f, 21); break;
#endif
        default: break;
        }
    }
#ifdef BROKEN_CONTROL
    CHECK(ws + fp::WS_K, 1, 1024, 1024, 1.f, 2, 2048, 0.03f, 23);
#endif
#ifndef REFCHECK_FULL
    ref::forward(in, (float*)d_out, (unsigned char*)d_ws + 2 * fp::MiB, stream, nullptr, nullptr);
#endif
#ifndef NO_SCALE
    hipLaunchKernelGGL(chk::k_scale, dim3(2048), dim3(256), 0, stream, (float*)d_out, (size_t)32768 * 1024, fail);
#endif
#else
    launch_phases(a, 0, fp::PH_COUNT, 0, stream);
#endif
}
```

```cpp
#include <hip/hip_runtime.h>
#include <stdint.h>
#include <stdio.h>
#define HAVE_L0REST
namespace pg8 {
#define PG8_LAS __attribute__((address_space(3)))
typedef unsigned short bf16_t;
typedef short bf16x8 __attribute__((ext_vector_type(8)));
typedef float f32x4 __attribute__((ext_vector_type(4)));
typedef unsigned u32x4 __attribute__((ext_vector_type(4)));
typedef int v8i_t __attribute__((ext_vector_type(8)));
typedef int v4i_t __attribute__((ext_vector_type(4)));
constexpr int BM = 256, BK = 64, HALF = 128, HTB = HALF * BK * 2  , STAGE_BYTES = 8 * HTB, NXCD = 8, WGM = 8;

__host__ __device__ __forceinline__ int lds_byte(int r, int c) { const int st = (r >> 4) * 2 + (c >> 5), rr = r & 15, cc = c & 31, ob = rr * 64 + cc * 2; return st * 1024 + (ob ^ (((ob >> 9) & 1) << 5)); }
__host__ __device__ __forceinline__ void stage_rc(int b, int& R, int& C) { const int st = b / 1024, sb = b % 1024, swz = sb ^ (((sb >> 9) & 1) << 5); R = (st >> 1) * 16 + swz / 64; C = (st & 1) * 32 + (swz % 64) / 2; }
__host__ __device__ __forceinline__ int perm32(int rho) { const int n = rho >> 4, i = rho & 15; return 8 * (i >> 2) + 4 * n + (i & 3); }

struct Unit { int pm, pn, om, on; };
struct Gemm { const bf16_t* A; const bf16_t* Bt; int M, N, K; };

struct StaticOrder {
    int nM, nN, nwg, G, c;
    __host__ __device__ void init(int M, int N, int G_, int c_) { nM = M / BM; nN = N / BM; nwg = nM * nN; G = G_; c = c_; }
    __host__ __device__ bool next(int i, Unit& u) const {
        const long L = (long)i * G + c; if (L >= nwg) return false;
        int wgid = (int)L; { const int q = nwg / NXCD, r = nwg % NXCD, xcd = wgid % NXCD, off = wgid / NXCD; wgid = (xcd < r ? xcd * (q + 1) : r * (q + 1) + (xcd - r) * q) + off; }
        const int nig = WGM * nN, gid = wgid / nig, fm = gid * WGM, gsz = (nM - fm) < WGM ? (nM - fm) : WGM;
        u.pm = fm + ((wgid % nig) % gsz); u.pn = (wgid % nig) / gsz; u.om = u.pm; u.on = u.pn; return true;
    }
};
#ifndef MOE_WGM
#define MOE_WGM 8
#endif
constexpr int MWGM = MOE_WGM;
template <bool ABS_A, bool ABS_O> struct MoeOrder {
    int p_lo, np, nN, nwg, G, c; const int* pexp;
    __device__ void init(int p_lo_, int np_, int nN_, int G_, int c_, const int* pexp_) { p_lo = p_lo_; np = np_ < 0 ? 0 : np_; nN = nN_; nwg = np * nN; G = G_; c = c_; pexp = pexp_; }
    __device__ bool next(int i, Unit& u) const {
        const long L = (long)i * G + c; if (L >= nwg) return false;
        const int wgid = (int)L, nig = MWGM * nN, gid = wgid / nig, fm = gid * MWGM, gsz = (np - fm) < MWGM ? (np - fm) : MWGM;
        const int pr = __builtin_amdgcn_readfirstlane(fm + ((wgid % nig) % gsz)), pnl = __builtin_amdgcn_readfirstlane((wgid % nig) / gsz), e = __builtin_amdgcn_readfirstlane(pexp[p_lo + pr]);
        u.pm = ABS_A ? p_lo + pr : pr; u.om = ABS_O ? p_lo + pr : pr; u.pn = e * nN + pnl; u.on = pnl; return true;
    }
};

__device__ __forceinline__ unsigned cvt_pk_bf16(float lo, float hi) { unsigned r; asm volatile("v_cvt_pk_bf16_f32 %0, %1, %2" : "=v"(r) : "v"(lo), "v"(hi)); return r; }

#ifdef EPI_PLAIN_STORES
__device__ __forceinline__ void store16_wt(void* p, u32x4 w) { *(u32x4*)p = w; }
#else
__device__ __forceinline__ void store16_wt(void* p, u32x4 w) { asm volatile("global_store_dwordx4 %0, %1, off sc1\n\ts_nop 1" : : "v"(p), "v"(w) : "memory"); }
#endif

struct EpiBf16 {
    static constexpr bool PERM = true;
    bf16_t* O; int ldc; int split_cols; size_t split_stride; float scale0;
    __device__ __forceinline__ void operator()(const f32x4 (&acc)[2][2][4][2], const Unit& u, int wr, int wc, int fr, int fq) const {
        const int row0 = u.om * BM + wr * 64 + fr; int colt = u.on * BM; bf16_t* base = O;
        float sc = 1.f; if (split_cols) { const int t = colt / split_cols; base += (size_t)t * split_stride; colt -= t * split_cols; if (t == 0) sc = scale0; } else sc = scale0;
        const int col0 = colt + wc * 32 + 8 * fq;
#pragma unroll
        for (int ai = 0; ai < 2; ++ai)
#pragma unroll
            for (int m = 0; m < 4; ++m) { bf16_t* rowp = base + (size_t)(row0 + ai * HALF + m * 16) * ldc + col0;
#pragma unroll
                for (int bj = 0; bj < 2; ++bj) { const f32x4 v0 = acc[ai][bj][m][0] * sc, v1 = acc[ai][bj][m][1] * sc;
                    u32x4 w; w.x = cvt_pk_bf16(v0[0], v0[1]); w.y = cvt_pk_bf16(v0[2], v0[3]); w.z = cvt_pk_bf16(v1[0], v1[1]); w.w = cvt_pk_bf16(v1[2], v1[3]);
                    store16_wt(rowp + bj * HALF, w); } }
    }
};
__device__ __forceinline__ float silu_mul(float g, float u) { return g * u * __builtin_amdgcn_rcpf(1.0f + __builtin_amdgcn_exp2f(-1.4426950408889634f * g)); }
struct EpiSwiglu {
    static constexpr bool PERM = true;
    bf16_t* O; int ldc;
    __device__ __forceinline__ void operator()(const f32x4 (&acc)[2][2][4][2], const Unit& u, int wr, int wc, int fr, int fq) const {
        const int row0 = u.om * BM + wr * 64 + fr, col0 = u.on * HALF + wc * 32 + 8 * fq;
#pragma unroll
        for (int ai = 0; ai < 2; ++ai)
#pragma unroll
            for (int m = 0; m < 4; ++m) { bf16_t* rowp = O + (size_t)(row0 + ai * HALF + m * 16) * ldc + col0;
                const f32x4 g0 = acc[ai][0][m][0], g1 = acc[ai][0][m][1], u0 = acc[ai][1][m][0], u1 = acc[ai][1][m][1];
                u32x4 w; w.x = cvt_pk_bf16(silu_mul(g0[0], u0[0]), silu_mul(g0[1], u0[1])); w.y = cvt_pk_bf16(silu_mul(g0[2], u0[2]), silu_mul(g0[3], u0[3]));
                w.z = cvt_pk_bf16(silu_mul(g1[0], u1[0]), silu_mul(g1[1], u1[1])); w.w = cvt_pk_bf16(silu_mul(g1[2], u1[2]), silu_mul(g1[3], u1[3]));
                store16_wt(rowp, w); }
    }
};

template <int MODE> struct EpiProbe {
    static constexpr bool PERM = true;
    bf16_t* O; int ldc;
    __device__ __forceinline__ void operator()(const f32x4 (&acc)[2][2][4][2], const Unit& u, int wr, int wc, int fr, int fq) const {
        const int row0 = (MODE == 0 ? ((int)blockIdx.x % 64) : u.om) * BM + wr * 64 + fr; const int col0 = (MODE == 0 ? 0 : (u.on & 3) * BM) + wc * 32 + 8 * fq;
#pragma unroll
        for (int ai = 0; ai < 2; ++ai)
#pragma unroll
            for (int m = 0; m < 4; ++m) { bf16_t* rowp = O + (size_t)(row0 + ai * HALF + m * 16) * ldc + col0;
#pragma unroll
                for (int bj = 0; bj < 2; ++bj) { const f32x4 v0 = acc[ai][bj][m][0], v1 = acc[ai][bj][m][1];
                    u32x4 w; w.x = cvt_pk_bf16(v0[0], v0[1]); w.y = cvt_pk_bf16(v0[2], v0[3]); w.z = cvt_pk_bf16(v1[0], v1[1]); w.w = cvt_pk_bf16(v1[2], v1[3]);
                    if (MODE == 1) __builtin_nontemporal_store(w, (u32x4*)(rowp + bj * HALF)); else *(u32x4*)(rowp + bj * HALF) = w; } }
    }
};
struct EpiNull {
    static constexpr bool PERM = true;
    bf16_t* O;
    __device__ __forceinline__ void operator()(const f32x4 (&acc)[2][2][4][2], const Unit& u, int wr, int wc, int fr, int fq) const {
        float s = 0.f;
#pragma unroll
        for (int ai = 0; ai < 2; ++ai)
#pragma unroll
            for (int bj = 0; bj < 2; ++bj)
#pragma unroll
                for (int m = 0; m < 4; ++m)
#pragma unroll
                    for (int n = 0; n < 2; ++n) s += acc[ai][bj][m][n][0] + acc[ai][bj][m][n][1] + acc[ai][bj][m][n][2] + acc[ai][bj][m][n][3];
        if (s == 12345.6789f) O[(size_t)u.om * 256 + fr] = (bf16_t)1;
    }
};
struct EpiSwigluF8 {
    static constexpr bool PERM = true;
    unsigned char* O; int ldc; float inv_ws;
    __device__ __forceinline__ void operator()(const f32x4 (&acc)[2][2][4][2], const Unit& u, int wr, int wc, int fr, int fq) const {
        const int row0 = u.om * BM + wr * 64 + fr, col0 = u.on * HALF + wc * 32 + 8 * fq;
#pragma unroll
        for (int ai = 0; ai < 2; ++ai)
#pragma unroll
            for (int m = 0; m < 4; ++m) { unsigned char* rowp = O + (size_t)(row0 + ai * HALF + m * 16) * ldc + col0;
                const f32x4 g0 = acc[ai][0][m][0] * inv_ws, g1 = acc[ai][0][m][1] * inv_ws, u0 = acc[ai][1][m][0] * inv_ws, u1 = acc[ai][1][m][1] * inv_ws;
                unsigned w0 = 0u, w1 = 0u;
                w0 = __builtin_amdgcn_cvt_pk_fp8_f32(silu_mul(g0[0], u0[0]), silu_mul(g0[1], u0[1]), w0, false); w0 = __builtin_amdgcn_cvt_pk_fp8_f32(silu_mul(g0[2], u0[2]), silu_mul(g0[3], u0[3]), w0, true);
                w1 = __builtin_amdgcn_cvt_pk_fp8_f32(silu_mul(g1[0], u1[0]), silu_mul(g1[1], u1[1]), w1, false); w1 = __builtin_amdgcn_cvt_pk_fp8_f32(silu_mul(g1[2], u1[2]), silu_mul(g1[3], u1[3]), w1, true);
                typedef unsigned u32x2 __attribute__((ext_vector_type(2)));
                *(u32x2*)rowp = (u32x2){w0, w1}; }
    }
};

template <class Epi, class Sched, bool ALIGN_EPI, bool GATHER, bool F8 = false>
__device__ __forceinline__ void gemm_phase(PG8_LAS unsigned char* lds, const Gemm g, const Sched& S, const Epi& E, const int* rowidx, int wave) {
    const int wid = __builtin_amdgcn_readfirstlane(wave), lane = (int)__builtin_amdgcn_mbcnt_hi(~0u, __builtin_amdgcn_mbcnt_lo(~0u, 0u)), tid = wid * 64 + lane,     wr = wid >> 2, wc = wid & 3, fr = lane & 15, fq = lane >> 4;
    const int K = F8 ? g.K / 2 : g.K, nt = K / BK;
    unsigned voffB[2];
#pragma unroll
    for (int i = 0; i < 2; ++i) { int R, C; stage_rc(tid * 16 + i * 8192, R, C); const int Rb = Epi::PERM ? ((R & ~31) + perm32(R & 31)) : R; voffB[i] = (unsigned)(Rb * K + C) * 2u; }
#define PG8_MKVOFF(dst, U) do { _Pragma("unroll") for (int _h = 0; _h < 2; ++_h) _Pragma("unroll") for (int _i = 0; _i < 2; ++_i) { int R_, C_; stage_rc(tid * 16 + _i * 8192, R_, C_); \
        int row_ = (U).pm * BM + _h * HALF + R_; if (GATHER) row_ = rowidx[row_]; dst[_h][_i] = (unsigned)(row_ * K + C_) * 2u; } } while (0)
    const size_t kstep = (size_t)(BK * 2);
    const size_t hstep = (size_t)HALF * K * 2;
    const size_t tstep = 2 * hstep;
    const unsigned lds0 = (unsigned)__builtin_amdgcn_readfirstlane((int)(unsigned)(size_t)lds);
    const unsigned ldsw = (unsigned)wid * 1024u;
    const unsigned ldsb = lds0 + ldsw;
    const int aoff = lds_byte(wr * 64 + fr, fq * 8), boff = lds_byte(wc * 32 + fr, fq * 8);
#define PG8_SA(b, h) (((b) * 2 + (h)) * HTB)
#define PG8_SB(b, h) ((4 + (b) * 2 + (h)) * HTB)
#define PG8_GLDS(ldsbase, coff, voff32, gptr) do { asm volatile("s_add_u32 m0, %1, %3\n\ts_nop 0\n\tglobal_load_lds_dwordx4 %0, %2" : : "v"(voff32), "s"(ldsbase), "s"(gptr), "i"(coff) : "memory", "m0", "scc"); } while (0)
#define PG8_STAGE(bufoff, gbase, v0, v1) do { const unsigned long long gb_ = (unsigned long long)(gbase); \
        const unsigned long long gp_ = ((unsigned long long)(unsigned)__builtin_amdgcn_readfirstlane((int)(unsigned)(gb_ >> 32)) << 32) | (unsigned long long)(unsigned)__builtin_amdgcn_readfirstlane((int)(unsigned)gb_); PG8_GLDS(ldsb, (bufoff), v0, gp_); PG8_GLDS(ldsb, (bufoff) + 8192, v1, gp_); } while (0)
#define PG8_LD2(p_) __builtin_shufflevector(*(const PG8_LAS v4i_t*)(p_), *(const PG8_LAS v4i_t*)((p_) + 1024), 0, 1, 2, 3, 4, 5, 6, 7)
#define PG8_LDA(dst, b, h) do { _Pragma("unroll") for (int m = 0; m < 4; ++m) dst[m] = PG8_LD2(lds + PG8_SA(b, h) + aoff + m * 2048); } while (0)
#define PG8_LDB(dst, b, h) do { _Pragma("unroll") for (int n = 0; n < 2; ++n) dst[n] = PG8_LD2(lds + PG8_SB(b, h) + boff + n * 2048); } while (0)
#define PG8_LO(v) __builtin_bit_cast(bf16x8, __builtin_shufflevector(v, v, 0, 1, 2, 3))
#define PG8_HI(v) __builtin_bit_cast(bf16x8, __builtin_shufflevector(v, v, 4, 5, 6, 7))
#define PG8_MMA(ai, bj, At, Bt) do { __builtin_amdgcn_s_setprio(1); _Pragma("unroll") for (int m = 0; m < 4; ++m) _Pragma("unroll") for (int n = 0; n < 2; ++n) { \
        if constexpr (F8) { acc[ai][bj][m][n] = __builtin_amdgcn_mfma_scale_f32_16x16x128_f8f6f4(Bt[n], At[m], acc[ai][bj][m][n], 0, 0, 0, 0x7f7f7f7f, 0, 0x7f7f7f7f); } \
        else { acc[ai][bj][m][n] = __builtin_amdgcn_mfma_f32_16x16x32_bf16(PG8_LO(Bt[n]), PG8_LO(At[m]), acc[ai][bj][m][n], 0, 0, 0); acc[ai][bj][m][n] = __builtin_amdgcn_mfma_f32_16x16x32_bf16(PG8_HI(Bt[n]), PG8_HI(At[m]), acc[ai][bj][m][n], 0, 0, 0); } } __builtin_amdgcn_s_setprio(0); } while (0)
#define PG8_WAIT_V(n) asm volatile("s_waitcnt vmcnt(" #n ")" ::: "memory")
#define PG8_WAIT_L(n) asm volatile("s_waitcnt lgkmcnt(" #n ")" ::: "memory")
#define PG8_BAR __builtin_amdgcn_s_barrier()
#define PG8_SCHED __builtin_amdgcn_sched_barrier(0)
    Unit cur, nxt; int ui = 0;
    if (!S.next(0, cur)) return;
    f32x4 acc[2][2][4][2];
#pragma unroll
    for (int a = 0; a < 2; ++a)
#pragma unroll
        for (int b = 0; b < 2; ++b)
#pragma unroll
            for (int m = 0; m < 4; ++m)
#pragma unroll
                for (int n = 0; n < 2; ++n) acc[a][b][m][n] = (f32x4){0.f, 0.f, 0.f, 0.f};
    v8i_t At[4], B0[2], B1[2];
    unsigned voffA[2][2], voffN[2][2], voffA1[2];
    if constexpr (GATHER) { PG8_MKVOFF(voffA, cur); }
    else {
#pragma unroll
        for (int i = 0; i < 2; ++i) { int R, C; stage_rc(tid * 16 + i * 8192, R, C); voffA1[i] = (unsigned)(R * K + C) * 2u; } }
    const char* gA = (const char*)g.A;
    const char* cA = gA + (size_t)cur.pm * tstep; const char* nA = cA;
    const char* cB = (const char*)g.Bt + (size_t)cur.pn * tstep;
#define PG8_STAGE_A(bufoff, h, koff, usenext) do { \
        if constexpr (GATHER) { const unsigned v0_ = (usenext) ? voffN[h][0] : voffA[h][0], v1_ = (usenext) ? voffN[h][1] : voffA[h][1]; PG8_STAGE(bufoff, gA + (koff), v0_, v1_); } \
        else { const char* p_ = ((usenext) ? nA : cA) + (size_t)(h) * hstep + (koff); PG8_STAGE(bufoff, p_, voffA1[0], voffA1[1]); } } while (0)
    PG8_STAGE(PG8_SB(0, 0), cB, voffB[0], voffB[1]); PG8_STAGE(PG8_SB(0, 1), cB + hstep, voffB[0], voffB[1]); PG8_STAGE_A(PG8_SA(0, 0), 0, (size_t)0, false); PG8_STAGE_A(PG8_SA(0, 1), 1, (size_t)0, false);
    if (wr == 1) PG8_BAR;
    PG8_WAIT_V(2); PG8_BAR;
    PG8_STAGE(PG8_SB(1, 0), cB + kstep, voffB[0], voffB[1]); PG8_STAGE_A(PG8_SA(1, 0), 0, kstep, false); PG8_STAGE(PG8_SB(1, 1), cB + hstep + kstep, voffB[0], voffB[1]);
    PG8_WAIT_V(6); PG8_BAR;
    for (;;) {
        const bool has_next = S.next(ui + 1, nxt);
        if constexpr (GATHER) { if (has_next) { PG8_MKVOFF(voffN, nxt); } else {
#pragma unroll
            for (int h = 0; h < 2; ++h) { voffN[h][0] = voffA[h][0]; voffN[h][1] = voffA[h][1]; } } }
        nA = has_next ? gA + (size_t)nxt.pm * tstep : cA;
        const char* nB = has_next ? (const char*)g.Bt + (size_t)nxt.pn * tstep : cB;
        for (int t = 0; t < nt; t += 2) {
            const bool last = (t == nt - 2);
            const size_t k1 = (size_t)(t + 1) * kstep;
            const size_t k2 = last ? (size_t)0 : (size_t)(t + 2) * kstep; const char* b2 = last ? nB : cB + (size_t)(t + 2) * kstep;
            const size_t k3 = k2 + kstep; const char* b3 = b2 + kstep;
            PG8_LDB(B0, 0, 0); PG8_LDB(B1, 0, 1); PG8_SCHED; PG8_LDA(At, 0, 0); PG8_STAGE_A(PG8_SA(1, 1), 1, k1, false);
            PG8_WAIT_V(8); PG8_WAIT_L(0); PG8_BAR; PG8_MMA(0, 0, At, B0); PG8_MMA(0, 1, At, B1); PG8_BAR; PG8_SCHED;
            PG8_LDA(At, 0, 1); PG8_STAGE(PG8_SB(0, 0), b2, voffB[0], voffB[1]); PG8_STAGE(PG8_SB(0, 1), b2 + hstep, voffB[0], voffB[1]); PG8_STAGE_A(PG8_SA(0, 0), 0, k2, last);
            PG8_WAIT_V(8); PG8_WAIT_L(0); PG8_BAR; PG8_MMA(1, 0, At, B0); PG8_MMA(1, 1, At, B1); PG8_BAR; PG8_SCHED;
            PG8_LDB(B0, 1, 0); PG8_LDB(B1, 1, 1); PG8_SCHED; PG8_LDA(At, 1, 0); PG8_STAGE_A(PG8_SA(0, 1), 1, k2, last);
            PG8_WAIT_V(8); PG8_WAIT_L(0); PG8_BAR; PG8_MMA(0, 0, At, B0); PG8_MMA(0, 1, At, B1); PG8_BAR; PG8_SCHED;
            PG8_LDA(At, 1, 1); PG8_STAGE(PG8_SB(1, 0), b3, voffB[0], voffB[1]); PG8_STAGE(PG8_SB(1, 1), b3 + hstep, voffB[0], voffB[1]); PG8_STAGE_A(PG8_SA(1, 0), 0, k3, last);
            PG8_WAIT_V(8); PG8_WAIT_L(0); PG8_BAR; PG8_MMA(1, 0, At, B0); PG8_MMA(1, 1, At, B1); PG8_BAR; PG8_SCHED;
        }
        if constexpr (ALIGN_EPI) { if (wr == 0) PG8_BAR; }
        { int l2_ = (int)__builtin_amdgcn_mbcnt_hi(~0u, __builtin_amdgcn_mbcnt_lo(~0u, 0u)); asm volatile("" : "+v"(l2_)); E(acc, cur, wr, wc, l2_ & 15, l2_ >> 4); }
        if (!has_next) break;
#pragma unroll
        for (int a = 0; a < 2; ++a)
#pragma unroll
            for (int b = 0; b < 2; ++b)
#pragma unroll
                for (int m = 0; m < 4; ++m)
#pragma unroll
                    for (int n = 0; n < 2; ++n) acc[a][b][m][n] = (f32x4){0.f, 0.f, 0.f, 0.f};
        cur = nxt; cB = nB; cA = nA; ++ui;
        if constexpr (GATHER) {
#pragma unroll
            for (int h = 0; h < 2; ++h) { voffA[h][0] = voffN[h][0]; voffA[h][1] = voffN[h][1]; } }
        if constexpr (ALIGN_EPI) { if (wr == 1) PG8_BAR; }
    }
    PG8_WAIT_V(0);
    if constexpr (!ALIGN_EPI) { if (wr == 0) PG8_BAR; }
    PG8_BAR;
#undef PG8_MKVOFF
#undef PG8_STAGE_A
#undef PG8_SA
#undef PG8_SB
#undef PG8_STAGE
#undef PG8_GLDS
#undef PG8_LDA
#undef PG8_LD2
#undef PG8_LO
#undef PG8_HI
#undef PG8_LDB
#undef PG8_MMA
#undef PG8_WAIT_V
#undef PG8_WAIT_L
#undef PG8_BAR
#undef PG8_SCHED
}
}
namespace fp {
constexpr int NWAVES = 8;
constexpr int B = 16, S = 2048, T = B * S, D = 1024, H = 8, F1 = 2816, DI = 2048, NH = 4, DH = 512, NE = 8, F2 = 3584;
constexpr float QSCALE = 0.125f * 1.4426950408889634f;
constexpr float LAMBDA_INIT = 0.2f;
constexpr float EPS = 1e-6f;

constexpr size_t MiB = 1u << 20;
constexpr size_t WS_NEED = 613951040;
constexpr size_t WS_CTL = 0, CTL_ZERO_BYTES = 1 * MiB;
constexpr size_t WS_MOD = 1 * MiB;
constexpr size_t WS_TAB = 2 * MiB;
constexpr size_t WS_GATE = 3 * MiB;
constexpr size_t WS_W_AIN = 4 * MiB, WS_W_AOUT = 10 * MiB, WS_W_FGU = 12 * MiB, WS_W_FD = 23 * MiB, WS_W_MIN = 29 * MiB, WS_W_MOUT = 37 * MiB;
constexpr size_t WS_ROUTE = 41 * MiB;
constexpr size_t WS_ARENA = 43 * MiB;
constexpr size_t A_(size_t mib) { return WS_ARENA + mib * MiB; }
constexpr size_t WS_Y = A_(0);
constexpr size_t WS_H = A_(64);
constexpr size_t WS_Q = A_(64), WS_K = A_(128), WS_V = A_(192), WS_O = A_(256);
constexpr size_t WS_ACT = A_(128);
constexpr size_t WS_XZ = A_(128);
constexpr size_t WS_HH = A_(384);
constexpr size_t WS_WMD = A_(0);
constexpr size_t WS_WMGU = A_(128);
constexpr size_t WS_XB = A_(240);
constexpr int MOE_ROUNDS = 5;
constexpr int MPAD = 2 * T + NE * 256;
constexpr int MAXPANELS = MPAD / 256;
constexpr int PR = 64;
static_assert(PR * MOE_ROUNDS >= MAXPANELS, "MoE rounds cover every panel");
constexpr size_t ACT2_BYTES = (size_t)PR * 256 * F2 * 2;
static_assert(ACT2_BYTES <= (size_t)T * D * 4, "ACT2 fits d_out");
constexpr size_t WS_YM = A_(304);
constexpr size_t WS_END = WS_YM + (size_t)MPAD * 1024 * 2;
constexpr size_t WS_DIG = WS_NEED - 28 * MiB;
#ifdef REFCHECK
static_assert(WS_END <= WS_DIG, "d_ws map (refcheck)");
#else
static_assert(WS_END <= WS_NEED, "d_ws map");
#endif
constexpr int CW_FAIL = 8;
constexpr int CW_BAR = 4096;
constexpr int CW_ECNT = 200000;
constexpr int TAB_NPANELS = 0, TAB_EOFF = 16  , TAB_PEXP = 64  ;

constexpr int RING_BYTES = 131072;
constexpr int LDSCTL_OFF = RING_BYTES, MISC_OFF = LDSCTL_OFF + 320;
constexpr int LDS_BYTES = 147456;

#define GAS __attribute__((address_space(1)))
#define LAS __attribute__((address_space(3)))
typedef unsigned short bf16;
typedef unsigned v4u __attribute__((ext_vector_type(4)));
typedef unsigned v2u __attribute__((ext_vector_type(2)));
typedef float f32x4 __attribute__((ext_vector_type(4)));
typedef float f32x16 __attribute__((ext_vector_type(16)));
typedef short bf16x8 __attribute__((ext_vector_type(8)));
typedef short s16x4 __attribute__((ext_vector_type(4)));
typedef GAS unsigned gu32;
#define RLX_AGENT __ATOMIC_RELAXED, __HIP_MEMORY_SCOPE_AGENT
#define LDS_WAIT() asm volatile("s_waitcnt lgkmcnt(0)" ::: "memory")
#define VM_WAIT() asm volatile("s_waitcnt vmcnt(0)" ::: "memory")
__device__ __forceinline__ unsigned f2bf(float f) { unsigned u = __builtin_bit_cast(unsigned, f); return (u + 0x7fffu + ((u >> 16) & 1u)) >> 16; }
__device__ __forceinline__ unsigned pk2(float lo, float hi) { return f2bf(lo) | (f2bf(hi) << 16); }
__device__ __forceinline__ float bf_lo(unsigned w) { return __builtin_bit_cast(float, w << 16); }
__device__ __forceinline__ float bf_hi(unsigned w) { return __builtin_bit_cast(float, w & 0xffff0000u); }
__device__ __forceinline__ float bf2f(bf16 v) { return __builtin_bit_cast(float, (unsigned)v << 16); }
__device__ __forceinline__ float fsilu(float v) { return v * __builtin_amdgcn_rcpf(1.0f + __builtin_amdgcn_exp2f(-1.4426950408889634f * v)); }
__device__ __forceinline__ float wave_sum(float v) {
#pragma unroll
    for (int o = 1; o < 64; o <<= 1) v += __shfl_xor(v, o);
    return v;
}

#define XB_TMO      128
#define XB_XCNT(j)  (256  + 64 * (j))
#define XB_XSUB(j)  (1280 + 64 * (j))
#define XB_XGEN(j)  (2304 + 64 * (j))
#define XB_TOP      3328
#define XB_TOPGEN   3392
#define XCD_BAR_WORDS 3456
#define XB_SPIN_CAP (1u << 18)
__device__ __forceinline__ unsigned xb_ld(unsigned* p)              { return __hip_atomic_load(p, __ATOMIC_RELAXED, __HIP_MEMORY_SCOPE_AGENT); }
__device__ __forceinline__ unsigned xb_add(unsigned* p, unsigned v) { return __hip_atomic_fetch_add(p, v, __ATOMIC_RELAXED, __HIP_MEMORY_SCOPE_AGENT); }
__device__ __forceinline__ unsigned xb_xcc_id() { return (unsigned)__builtin_amdgcn_s_getreg((3 << 11) | 20) & 0xFu; }
#define XB_SPIN(cond, bar) do { unsigned _sp = 0; while (cond) { __builtin_amdgcn_s_sleep(1); \
    if ((++_sp & 255u) == 0u) { if (xb_ld(&(bar)[XB_TMO])) break; if (_sp > XB_SPIN_CAP) { atomicAdd(&(bar)[XB_TMO], 1u); break; } } } } while (0)
struct XcdBarrier { unsigned* bar; unsigned x; volatile LAS unsigned* st; int wave; };
__device__ __forceinline__ bool xb_first_thread(int wave) { return wave == 0 && __builtin_amdgcn_mbcnt_hi(~0u, __builtin_amdgcn_mbcnt_lo(~0u, 0u)) == 0u; }
__device__ __forceinline__ XcdBarrier xcd_barrier_post(unsigned* bar, volatile LAS unsigned* st, int wave) {
    XcdBarrier b; b.bar = bar; b.x = xb_xcc_id(); b.st = st; b.wave = wave;
    if (xb_first_thread(wave)) (void)xb_add(&bar[XB_XCNT(b.x)], 1u);
    return b;
}
__device__ __forceinline__ void xcd_barrier_complete(unsigned* bar, unsigned x, unsigned& nloc, unsigned& nx) {
    const unsigned G = gridDim.x * gridDim.y * gridDim.z;
    unsigned sum, cnt, mine, sp = 0u;
    for (;;) {
        sum = 0u; cnt = 0u; mine = 0u;
#pragma unroll
        for (unsigned j = 0; j < 16; ++j) { const unsigned c = xb_ld(&bar[XB_XCNT(j)]); sum += c; cnt += (c > 0u) ? 1u : 0u; mine = (j == x) ? c : mine; }
        if (sum == G) break;
        __builtin_amdgcn_s_sleep(1);
        if ((++sp & 255u) == 0u) { if (xb_ld(&bar[XB_TMO])) break; if (sp > XB_SPIN_CAP) { atomicAdd(&bar[XB_TMO], 1u); break; } }
    }
    nloc = mine > 0u ? mine : 1u; nx = cnt > 0u ? cnt : 1u;
}
__device__ __forceinline__ void xcd_barrier(const XcdBarrier& b) {
    asm volatile("s_waitcnt vmcnt(0)" ::: "memory");
    __syncthreads();
    if (xb_first_thread(b.wave)) {
        unsigned* bar = b.bar;
        __builtin_amdgcn_s_waitcnt(0);
        unsigned nloc = b.st[0], nx = b.st[1];
        if (nloc == 0u) { xcd_barrier_complete(bar, b.x, nloc, nx); b.st[0] = nloc; b.st[1] = nx; }
        const unsigned old = xb_add(&bar[XB_XSUB(b.x)], 1u);
        const unsigned gen = old / nloc;
        if (old + 1u == (gen + 1u) * nloc) {
            __builtin_amdgcn_fence(__ATOMIC_RELEASE, "agent");
            asm volatile("s_waitcnt vmcnt(0)" ::: "memory");
            const unsigned og = xb_add(&bar[XB_TOP], 1u);
            const unsigned tg = og / nx;
            if (og + 1u == (tg + 1u) * nx) xb_add(&bar[XB_TOPGEN], 1u);
            else XB_SPIN(xb_ld(&bar[XB_TOPGEN]) == tg, bar);
            __builtin_amdgcn_fence(__ATOMIC_ACQUIRE, "agent");
            xb_add(&bar[XB_XGEN(b.x)], 1u);
            asm volatile("s_waitcnt vmcnt(0)" ::: "memory");
        } else {
            XB_SPIN(xb_ld(&bar[XB_XGEN(b.x)]) == gen, bar);
            __builtin_amdgcn_fence(__ATOMIC_ACQUIRE, "agent");
            asm volatile("s_waitcnt vmcnt(0)" ::: "memory");
        }
    }
    __syncthreads();
}

struct Frame {
    LAS unsigned char* lds;
    volatile LAS unsigned* MISC;
    gu32* ctl;
    unsigned char* ws;
    int tid, lane, wave, G, gw, NGW;
    const float* const* in;
    float* X;
};
enum { I_X = 0, I_C, I_MODW, I_MODB, I_NORMG, I_AWIN, I_AWOUT, I_ALAM, I_ASUBLN, I_FWG, I_FWU, I_FWD, I_MWIN, I_CONVW, I_CONVB, I_WQ, I_WK, I_WV, I_WGATE, I_BGATE, I_SKIP, I_MNORM, I_MWOUT,
       I_WROUTER, I_BROUTER, I_EWG, I_EWU, I_EWD };

__device__ __forceinline__ void transpose_item(const float* W, int K, int N, bf16* WT, int mode, LAS float* scr, int item, int lane) {
    const int nblk = N / 32, kb = item / nblk, nb = item % nblk, k0 = 64 * kb, n0 = 32 * nb;
#pragma unroll
    for (int i = 0; i < 32; ++i) { const int kk = 2 * i + (lane >> 5); scr[kk * 33 + (lane & 31)] = __builtin_nontemporal_load(W + (size_t)(k0 + kk) * N + n0 + (lane & 31)); }
    LDS_WAIT(); asm volatile("" ::: "memory");
    const int c = lane & 7;
#pragma unroll
    for (int j = 0; j < 4; ++j) { const int n = (lane >> 3) + 8 * j; const LAS float* s = scr + (8 * c) * 33 + n;
        v4u o; o.x = pk2(s[0 * 33], s[1 * 33]); o.y = pk2(s[2 * 33], s[3 * 33]); o.z = pk2(s[4 * 33], s[5 * 33]); o.w = pk2(s[6 * 33], s[7 * 33]);
        const int ng = n0 + n; const int row = mode == 0 ? ng : ((ng >> 7) * 256 + (ng & 127) + (mode == 2 ? 128 : 0));
        *(GAS v4u*)(WT + (size_t)row * K + k0 + 8 * c) = o; }
    LDS_WAIT(); asm volatile("" ::: "memory");
}
constexpr float WS8 = 32.f;
__device__ __forceinline__ unsigned pk4_fp8(float a, float b, float c, float d) { unsigned w = 0u; w = __builtin_amdgcn_cvt_pk_fp8_f32(a, b, w, false); w = __builtin_amdgcn_cvt_pk_fp8_f32(c, d, w, true); return w; }
__device__ __forceinline__ void transpose_item_f8(const float* W, int K, int N, unsigned char* WT, int mode, LAS float* scr, int item, int lane) {
    const int nblk = N / 32, kb = item / nblk, nb = item % nblk, k0 = 64 * kb, n0 = 32 * nb;
#pragma unroll 8
    for (int i = 0; i < 32; ++i) { const int kk = 2 * i + (lane >> 5); scr[kk * 33 + (lane & 31)] = W[(size_t)(k0 + kk) * N + n0 + (lane & 31)]; }
    LDS_WAIT(); asm volatile("" ::: "memory");
    const int n = lane >> 1, half = lane & 1; const LAS float* sp = scr + (32 * half) * 33 + n;
    v4u o[2];
#pragma unroll
    for (int u = 0; u < 2; ++u) { const LAS float* s4 = sp + 16 * u * 33;
        o[u].x = pk4_fp8(s4[0 * 33] * WS8, s4[1 * 33] * WS8, s4[2 * 33] * WS8, s4[3 * 33] * WS8); o[u].y = pk4_fp8(s4[4 * 33] * WS8, s4[5 * 33] * WS8, s4[6 * 33] * WS8, s4[7 * 33] * WS8);
        o[u].z = pk4_fp8(s4[8 * 33] * WS8, s4[9 * 33] * WS8, s4[10 * 33] * WS8, s4[11 * 33] * WS8); o[u].w = pk4_fp8(s4[12 * 33] * WS8, s4[13 * 33] * WS8, s4[14 * 33] * WS8, s4[15 * 33] * WS8); }
    const int ng = n0 + n; const int row = mode == 0 ? ng : ((ng >> 7) * 256 + (ng & 127) + (mode == 2 ? 128 : 0));
    GAS v4u* dst = (GAS v4u*)(WT + (size_t)row * K + k0 + 32 * half); dst[0] = o[0]; dst[1] = o[1];
    LDS_WAIT(); asm volatile("" ::: "memory");
}
__device__ __forceinline__ void convert_matrix_f8(Frame& F, const float* W, int K, int N, unsigned char* WT, int mode) {
    LAS float* scr = (LAS float*)(F.lds + F.wave * 16384);
    const int nitems = (K / 64) * (N / 32);
    for (int it = F.gw; it < nitems; it += F.NGW) transpose_item_f8(W, K, N, WT, mode, scr, it, F.lane);
}
__device__ __forceinline__ void convert_matrix(Frame& F, const float* W, int K, int N, bf16* WT, int mode) {
    LAS float* scr = (LAS float*)(F.lds + F.wave * 16384);
    const int nitems = (K / 64) * (N / 32);
    for (int it = F.gw; it < nitems; it += F.NGW) transpose_item(W, K, N, WT, mode, scr, it, F.lane);
}

__device__ __forceinline__ void p_mlprep(Frame& F);
__device__ __forceinline__ void p_mlprep2(Frame& F);
template <int PARTS = 7>
__device__ __forceinline__ void p_prologue(Frame& F) {
    if (PARTS & 1) {
        LAS float* sc = (LAS float*)(F.lds);
        LAS float* red = (LAS float*)(F.lds + 65536);
        const float* c = F.in[I_C];
        for (int e = F.tid; e < 16 * 1024; e += 512) sc[e] = fsilu(c[e]);
        __syncthreads();
        float* mod = (float*)(F.ws + WS_MOD);
        for (int cb = blockIdx.x; cb < 12288 / 64; cb += F.G) {
            const int col = cb * 64 + F.lane, i = col / 6144, n = col % 6144;
            const float* w = F.in[I_MODW] + (size_t)i * 1024 * 6144 + n;
            float acc[16];
#pragma unroll
            for (int b = 0; b < 16; ++b) acc[b] = 0.f;
#pragma unroll 4
            for (int k = F.wave * 128; k < F.wave * 128 + 128; k += 4) {
                const float w0 = w[(size_t)k * 6144], w1 = w[(size_t)(k + 1) * 6144], w2 = w[(size_t)(k + 2) * 6144], w3 = w[(size_t)(k + 3) * 6144];
#pragma unroll
                for (int b = 0; b < 16; ++b) { const f32x4 s4 = *(LAS const f32x4*)(sc + b * 1024 + k); acc[b] += s4.x * w0 + s4.y * w1 + s4.z * w2 + s4.w * w3; } }
#pragma unroll
            for (int b = 0; b < 16; ++b) red[(F.wave * 16 + b) * 64 + F.lane] = acc[b];
            __syncthreads();
            for (int e = F.tid; e < 16 * 64; e += 512) { const int b = e >> 6, l = e & 63; float s = 0.f;
#pragma unroll
                for (int w8 = 0; w8 < 8; ++w8) s += red[(w8 * 16 + b) * 64 + l];
                const int col2 = cb * 64 + l, i2 = col2 / 6144, n2 = col2 % 6144;
                mod[(size_t)(i2 * 16 + b) * 6144 + n2] = s + F.in[I_MODB][i2 * 6144 + n2]; }
            __syncthreads();
        }
        __syncthreads();
    }
    if (PARTS & 2) p_mlprep(F);
    if (PARTS & 4) {
    convert_matrix(F, F.in[I_AWIN], 1024, 3072, (bf16*)(F.ws + WS_W_AIN), 0);
    convert_matrix(F, F.in[I_AWOUT], 1024, 1024, (bf16*)(F.ws + WS_W_AOUT), 0);
    convert_matrix(F, F.in[I_FWG], 1024, F1, (bf16*)(F.ws + WS_W_FGU), 1);
    convert_matrix(F, F.in[I_FWU], 1024, F1, (bf16*)(F.ws + WS_W_FGU), 2);
    convert_matrix(F, F.in[I_FWD], F1, 1024, (bf16*)(F.ws + WS_W_FD), 0);
    convert_matrix(F, F.in[I_MWIN], 1024, 4096, (bf16*)(F.ws + WS_W_MIN), 0);
    convert_matrix(F, F.in[I_MWOUT], 2048, 1024, (bf16*)(F.ws + WS_W_MOUT), 0);
    }
}

struct Row16 { f32x4 v[4]; };
__device__ __forceinline__ Row16 load_row_f32(const float* p, int lane) { Row16 r; const GAS f32x4* q = (const GAS f32x4*)p + lane;
#pragma unroll
    for (int j = 0; j < 4; ++j) r.v[j] = q[64 * j]; return r; }
__device__ __forceinline__ Row16 load_row_f32_nt(const float* p, int lane) { Row16 r; const f32x4* q = (const f32x4*)p + lane;
#pragma unroll
    for (int j = 0; j < 4; ++j) r.v[j] = __builtin_nontemporal_load(q + 64 * j); return r; }
__device__ __forceinline__ Row16 load_row_bf16(const bf16* p, int lane) { Row16 r; const GAS v2u* q = (const GAS v2u*)p + lane;
#pragma unroll
    for (int j = 0; j < 4; ++j) { const v2u w = q[64 * j]; r.v[j] = (f32x4){bf_lo(w.x), bf_hi(w.x), bf_lo(w.y), bf_hi(w.y)}; } return r; }
__device__ __forceinline__ Row16 load_row_bf16_nt(const bf16* p, int lane) { Row16 r; const v2u* q = (const v2u*)p + lane;
#pragma unroll
    for (int j = 0; j < 4; ++j) { const v2u w = __builtin_nontemporal_load(q + 64 * j); r.v[j] = (f32x4){bf_lo(w.x), bf_hi(w.x), bf_lo(w.y), bf_hi(w.y)}; } return r; }
__device__ __forceinline__ float row_ss(const Row16& r) { float s = 0.f;
#pragma unroll
    for (int j = 0; j < 4; ++j) s += (r.v[j].x * r.v[j].x + r.v[j].y * r.v[j].y) + (r.v[j].z * r.v[j].z + r.v[j].w * r.v[j].w);
    return wave_sum(s); }
__device__ __forceinline__ void store_row_bf16(bf16* p, int lane, const Row16& r) { v2u* q = (v2u*)p + lane;
#pragma unroll
    for (int j = 0; j < 4; ++j) { v2u w; w.x = pk2(r.v[j].x, r.v[j].y); w.y = pk2(r.v[j].z, r.v[j].w); __builtin_nontemporal_store(w, q + 64 * j); } }
__device__ __forceinline__ void store_row_fp8(unsigned char* p, int lane, const Row16& r) { GAS unsigned* q = (GAS unsigned*)p + lane;
#pragma unroll
    for (int j = 0; j < 4; ++j) q[64 * j] = pk4_fp8(r.v[j].x, r.v[j].y, r.v[j].z, r.v[j].w); }
__device__ __forceinline__ void store_row_f32(float* p, int lane, const Row16& r) { f32x4* q = (f32x4*)p + lane;
#pragma unroll
    for (int j = 0; j < 4; ++j) __builtin_nontemporal_store(r.v[j], q + 64 * j); }
__device__ __forceinline__ Row16 round_row_bf16(const Row16& r) { Row16 o;
#pragma unroll
    for (int j = 0; j < 4; ++j) { const unsigned a = pk2(r.v[j].x, r.v[j].y), b2 = pk2(r.v[j].z, r.v[j].w); o.v[j] = (f32x4){bf_lo(a), bf_hi(a), bf_lo(b2), bf_hi(b2)}; } return o; }
__device__ __forceinline__ void norm_mod_row(const Row16& x, float rstd, const float* g, const float* scale, const float* shift, bf16* out, int lane) {
    const Row16 gg = load_row_f32(g, lane), sc = load_row_f32(scale, lane), sh = load_row_f32(shift, lane); Row16 h;
#pragma unroll
    for (int j = 0; j < 4; ++j) h.v[j] = x.v[j] * rstd * gg.v[j] * (sc.v[j] + 1.0f) + sh.v[j];
    store_row_bf16(out, lane, h);
}
#define ROWBLOCK(m0, m1) const int per_ = (T + F.NGW - 1) / F.NGW; const int m0 = F.gw * per_; const int m1 = (m0 + per_ < T) ? m0 + per_ : T
__device__ __forceinline__ void p_h0(Frame& F, bf16* Hout) {
    const float* mod = (const float*)(F.ws + WS_MOD); const float* g = F.in[I_NORMG];
    ROWBLOCK(m0, m1); int bc = -1; Row16 gg = load_row_f32(g, F.lane), sc, sh;
    Row16 xnx = load_row_f32_nt(F.in[I_X] + (size_t)m0 * D, F.lane);
    for (int m = m0; m < m1; ++m) { const int b = m >> 11;
        if (b != bc) { bc = b; const float* mb = mod + (size_t)b * 6144; sc = load_row_f32(mb + 1024, F.lane); sh = load_row_f32(mb, F.lane); }
        const Row16 x = xnx; if (m + 1 < m1) xnx = load_row_f32_nt(F.in[I_X] + (size_t)(m + 1) * D, F.lane);
        const float rstd = rsqrtf(row_ss(x) * (1.f / D) + EPS); Row16 h;
#pragma unroll
        for (int j = 0; j < 4; ++j) h.v[j] = x.v[j] * rstd * gg.v[j] * (sc.v[j] + 1.0f) + sh.v[j];
        store_row_bf16(Hout + (size_t)m * D, F.lane, h); }
}
__device__ __forceinline__ void p_norm(Frame& F, const float* xold, const bf16* Y, const float* gpost, const float* modg, int gi, const float* gn, const float* modn, int si, bf16* Hout) {
    ROWBLOCK(m0, m1); int bc = -1; const Row16 gp = load_row_f32(gpost, F.lane), gg = load_row_f32(gn, F.lane); Row16 gt, sc, sh;
    Row16 ynx = load_row_bf16_nt(Y + (size_t)m0 * D, F.lane), xnx = load_row_f32_nt(xold + (size_t)m0 * D, F.lane);
    for (int m = m0; m < m1; ++m) { const int b = m >> 11;
        if (b != bc) { bc = b; gt = load_row_f32(modg + (size_t)b * 6144 + gi * 1024, F.lane); const float* mb = modn + (size_t)b * 6144; sc = load_row_f32(mb + (si + 1) * 1024, F.lane); sh = load_row_f32(mb + si * 1024, F.lane); }
        const Row16 y = ynx, xo = xnx; if (m + 1 < m1) { ynx = load_row_bf16_nt(Y + (size_t)(m + 1) * D, F.lane); xnx = load_row_f32_nt(xold + (size_t)(m + 1) * D, F.lane); }
        const float r1 = rsqrtf(row_ss(y) * (1.f / D) + EPS);
        Row16 xn;
#pragma unroll
        for (int j = 0; j < 4; ++j) xn.v[j] = xo.v[j] + gt.v[j] * (y.v[j] * r1 * gp.v[j]);
        store_row_bf16((bf16*)F.X + (size_t)m * D, F.lane, xn);
        const float r2 = rsqrtf(row_ss(xn) * (1.f / D) + EPS); Row16 h;
#pragma unroll
        for (int j = 0; j < 4; ++j) h.v[j] = xn.v[j] * r2 * gg.v[j] * (sc.v[j] + 1.0f) + sh.v[j];
        store_row_bf16(Hout + (size_t)m * D, F.lane, h); }
}
#define HAVE_ATTN 1
__device__ __forceinline__ int crow(int r, int hi) { return (r & 3) + 8 * (r >> 2) + 4 * hi; }
__device__ __forceinline__ void swap32(unsigned& a, unsigned& b) { asm volatile("s_nop 1\n\tv_permlane32_swap_b32 %0, %1\n\ts_nop 1" : "+v"(a), "+v"(b)); }
__device__ __forceinline__ float xhalf_max(float v) { unsigned a = __builtin_bit_cast(unsigned, v), b2 = a; swap32(a, b2); return fmaxf(__builtin_bit_cast(float, a), __builtin_bit_cast(float, b2)); }
__device__ __forceinline__ float xhalf_sum(float v) { unsigned a = __builtin_bit_cast(unsigned, v), b2 = a; swap32(a, b2); return __builtin_bit_cast(float, a) + __builtin_bit_cast(float, b2); }
typedef short v4i16_t __attribute__((ext_vector_type(4)));
__device__ __forceinline__ s16x4 tr16(LAS const char* p) { return __builtin_bit_cast(s16x4, __builtin_amdgcn_ds_read_tr16_b64_v4i16((LAS v4i16_t*)p)); }
typedef float f32x2_t __attribute__((ext_vector_type(2))); typedef __bf16 bf16x2_t __attribute__((ext_vector_type(2)));
__device__ __forceinline__ unsigned cvtpk(float lo, float hi) { f32x2_t v = {lo, hi}; bf16x2_t b = __builtin_convertvector(v, bf16x2_t); return __builtin_bit_cast(unsigned, b); }
__device__ __forceinline__ float max3f(float a, float b, float c) { float r; asm("v_max3_f32 %0, %1, %2, %3" : "=v"(r) : "v"(a), "v"(b), "v"(c)); return r; }
#define MFMA32(a, b, c) __builtin_amdgcn_mfma_f32_32x32x16_bf16((a), (b), (c), 0, 0, 0)

constexpr size_t WS_KN = WS_TAB + 512 * 1024;
constexpr int CW_ATTQ = 1024;
__device__ __forceinline__ void p_attn_kn(Frame& F) {
    const bf16* Kb = (const bf16*)(F.ws + WS_K); float* KNG = (float*)(F.ws + WS_KN);
    const int lane = F.lane, w = F.wave, tid = F.tid;
    LAS float* KNW = (LAS float*)F.lds;
    for (int bh = F.gw >> 3; bh < B * H; bh += F.G) { const int b = bh >> 3, h = bh & 7; const size_t rowb = (size_t)b * S;
        float mk0 = 0.f, mk1 = 0.f;
        for (int r = tid; r < S; r += 512) { const bf16* kr = Kb + (rowb + r) * 1024 + h * 128; float s0 = 0.f, s1 = 0.f;
#pragma unroll
            for (int i = 0; i < 8; ++i) { const v4u a = *(const GAS v4u*)(kr + 8 * i), bq = *(const GAS v4u*)(kr + 64 + 8 * i);
                s0 += bf_lo(a.x) * bf_lo(a.x) + bf_hi(a.x) * bf_hi(a.x) + bf_lo(a.y) * bf_lo(a.y) + bf_hi(a.y) * bf_hi(a.y) + bf_lo(a.z) * bf_lo(a.z) + bf_hi(a.z) * bf_hi(a.z) + bf_lo(a.w) * bf_lo(a.w) + bf_hi(a.w) * bf_hi(a.w);
                s1 += bf_lo(bq.x) * bf_lo(bq.x) + bf_hi(bq.x) * bf_hi(bq.x) + bf_lo(bq.y) * bf_lo(bq.y) + bf_hi(bq.y) * bf_hi(bq.y) + bf_lo(bq.z) * bf_lo(bq.z) + bf_hi(bq.z) * bf_hi(bq.z) + bf_lo(bq.w) * bf_lo(bq.w) + bf_hi(bq.w) * bf_hi(bq.w); }
            mk0 = fmaxf(mk0, s0); mk1 = fmaxf(mk1, s1); }
#pragma unroll
        for (int o = 1; o < 64; o <<= 1) { mk0 = fmaxf(mk0, __shfl_xor(mk0, o)); mk1 = fmaxf(mk1, __shfl_xor(mk1, o)); }
        __syncthreads();
        if (lane == 0) { KNW[w * 2] = mk0; KNW[w * 2 + 1] = mk1; }
        __syncthreads();
        if (tid < 2) { float mm = 0.f; for (int w8 = 0; w8 < 8; ++w8) mm = fmaxf(mm, KNW[w8 * 2 + tid]); KNG[bh * 2 + tid] = sqrtf(mm); }
    }
    __syncthreads();
}
template <int VAR>
__device__ __forceinline__ void p_attn(Frame& F) {
    const bf16* Qb = (const bf16*)(F.ws + WS_Q); const bf16* Kb = (const bf16*)(F.ws + WS_K); const bf16* Vb = (const bf16*)(F.ws + WS_V); bf16* Ob = (bf16*)(F.ws + WS_O);
    const int lane = F.lane, r32 = lane & 31, hi = lane >> 5, w = F.wave, g = w >> 1, c = w & 1, tid = F.tid;
    float l01 = 0.f, l23 = 0.f; { const float* lam = F.in[I_ALAM]; for (int i = 0; i < 64; ++i) { l01 += lam[i] * lam[64 + i]; l23 += lam[128 + i] * lam[192 + i]; } }
#ifdef LAM0
    const float lam_full = 0.f;
#else
    const float lam_full = __expf(l01) - __expf(l23) + LAMBDA_INIT;
#endif
    const int krow_ = tid >> 3, kpc = tid & 7, vrow_ = tid >> 4, vpc = tid & 15;
    const int i16 = lane & 15, q4 = i16 >> 2, p4 = i16 & 3, blk = (lane >> 4) & 1;
    LAS char* L = (LAS char*)F.lds;
    constexpr int KP = 144, VP = 320, STG = 2 * 64 * KP + 64 * VP;
    LAS float* XCH = (LAS float*)F.lds;
    LAS float* KNW = (LAS float*)(L + 2 * STG);
    const float* KNG = (const float*)(F.ws + WS_KN);
    {
    for (;;) {
        __syncthreads();
        if (tid == 0) ((LAS int*)(KNW + 48))[0] = (int)__hip_atomic_fetch_add((unsigned*)(F.ctl + CW_ATTQ), 1u, __ATOMIC_RELAXED, __HIP_MEMORY_SCOPE_AGENT);
        __syncthreads();
        const int ui = __builtin_amdgcn_readfirstlane(((LAS const int*)(KNW + 48))[0]);
        if (ui >= B * H * 16) break;
        const int b = ui & 15, h = 7 - ((ui >> 4) & 7), u = 15 - (ui >> 7);
        const float slope2 = exp2f(-(float)(h + 1)) * 1.4426950408889634f;
        const size_t rowb = (size_t)b * S;
        const float kn = KNG[(b * 8 + h) * 2 + c];
        const int ntu = 2 * u + 2, cq = 2 * u + (g >> 1);
        const int qpos = 128 * u + 32 * g + r32;
        bf16x8 qf[4];
        { int lq = lane; asm volatile("" : "+v"(lq));
          const bf16* qp = Qb + (rowb + 128 * u + 32 * g + (lq & 31)) * 1024 + h * 128 + c * 64 + 8 * (lq >> 5);
#pragma unroll
            for (int ks = 0; ks < 4; ++ks) qf[ks] = *(const GAS bf16x8*)(qp + 16 * ks); }
        float bc;
        { float qs = 0.f;
#pragma unroll
            for (int ks = 0; ks < 4; ++ks) { const v4u qw = __builtin_bit_cast(v4u, qf[ks]);
                qs += bf_lo(qw.x) * bf_lo(qw.x) + bf_hi(qw.x) * bf_hi(qw.x) + bf_lo(qw.y) * bf_lo(qw.y) + bf_hi(qw.y) * bf_hi(qw.y) + bf_lo(qw.z) * bf_lo(qw.z) + bf_hi(qw.z) * bf_hi(qw.z) + bf_lo(qw.w) * bf_lo(qw.w) + bf_hi(qw.w) * bf_hi(qw.w); }
            qs = xhalf_sum(qs);
#pragma unroll
            for (int o2 = 1; o2 < 32; o2 <<= 1) qs = fmaxf(qs, __shfl_xor(qs, o2));
            bc = sqrtf(qs) * kn * 1.001f + 0.01f; }
        v4u pk0, pk1, pv0, pv1;
#define ATT_LOADT(kt) do { const bf16* kr = Kb + (rowb + (size_t)(kt) * 64 + krow_) * 1024 + h * 128 + kpc * 8; pk0 = *(const GAS v4u*)kr; pk1 = *(const GAS v4u*)(kr + 64); \
            const bf16* vr = Vb + (rowb + (size_t)(kt) * 64 + vrow_) * 1024 + h * 128 + vpc * 8; pv0 = *(const GAS v4u*)vr; pv1 = *(const GAS v4u*)(vr + 32 * 1024); } while (0)
#define ATT_STORET(st) do { LAS char* sb = L + (st) * STG; *(LAS v4u*)(sb + krow_ * KP + kpc * 16) = pk0; *(LAS v4u*)(sb + 64 * KP + krow_ * KP + kpc * 16) = pk1; \
            *(LAS v4u*)(sb + 128 * KP + vrow_ * VP + vpc * 16) = pv0; *(LAS v4u*)(sb + 128 * KP + (vrow_ + 32) * VP + vpc * 16) = pv1; } while (0)
        ATT_LOADT(ntu - 1);
        __syncthreads();
        ATT_STORET(0);
        __syncthreads();
        float m = -1e30f, l = 0.f;
        f32x16 o[4];
#pragma unroll
        for (int et = 0; et < 4; ++et)
#pragma unroll
            for (int r = 0; r < 16; ++r) o[et][r] = 0.f;
        int nj = ntu;
        for (int j = 0; j < nj; ++j) {
            const int kt = ntu - 1 - j;
            const bool more = j + 1 < nj;
            if (more) ATT_LOADT(kt - 1);
            if (VAR != 1 && kt <= cq) {
                LAS const char* Kc = L + (j & 1) * STG + c * 64 * KP;
                LAS const char* Vs = L + (j & 1) * STG + 128 * KP;
                f32x16 sacc[2];
                const bool started = m > -1e29f; const float mref = started ? m : 0.f;
#pragma unroll
                for (int half = 0; half < 2; ++half) {
                    f32x16 acc;
                    if (kt < cq) { const float base = slope2 * (float)(kt * 64 + 32 * half + 4 * hi) - mref;
#pragma unroll
                        for (int r = 0; r < 16; ++r) acc[r] = fmaf(slope2, (float)((r & 3) + 8 * (r >> 2)), base);
                    } else { const float q2 = 2.f * (float)qpos;
#pragma unroll
                        for (int r = 0; r < 16; ++r) { const float kpos = (float)(kt * 64 + 32 * half + crow(r, hi)); acc[r] = fmaf(slope2, fminf(kpos, q2 - kpos), -mref); } }
#pragma unroll
                    for (int ks = 0; ks < 4; ++ks) { const bf16x8 kf = *(LAS const bf16x8*)(Kc + (32 * half + r32) * KP + (16 * ks + 8 * hi) * 2); acc = MFMA32(kf, qf[ks], acc); }
                    sacc[half] = acc;
                }
                if (VAR != 2) {
                float mx = fmaxf(sacc[0][0], sacc[1][0]);
#pragma unroll
                for (int r = 1; r < 16; ++r) mx = max3f(mx, sacc[0][r], sacc[1][r]);
                mx = xhalf_max(mx);
                if (!__all(started && mx <= 8.f)) {
                    const float d = fmaxf(mx, started ? 0.f : -1e30f);
                    const float alpha = started ? __builtin_amdgcn_exp2f(-d) : 0.f;
                    m = mref + d; l *= alpha;
#pragma unroll
                    for (int half = 0; half < 2; ++half)
#pragma unroll
                        for (int r = 0; r < 16; ++r) sacc[half][r] -= d;
#pragma unroll
                    for (int et = 0; et < 4; ++et)
#pragma unroll
                        for (int r = 0; r < 16; ++r) o[et][r] *= alpha;
                }
                float lsum = 0.f;
#pragma unroll
                for (int half = 0; half < 2; ++half)
#pragma unroll
                    for (int r = 0; r < 16; ++r) { const float p = __builtin_amdgcn_exp2f(sacc[half][r]); sacc[half][r] = p; lsum += p; }
                l += lsum;
                }
                bf16x8 pf[4];
#pragma unroll
                for (int ks = 0; ks < 4; ++ks) { const int half = ks >> 1, s8 = 8 * (ks & 1); v4u pw;
                    pw.x = cvtpk(sacc[half][s8 + 0], sacc[half][s8 + 1]); pw.y = cvtpk(sacc[half][s8 + 2], sacc[half][s8 + 3]); pw.z = cvtpk(sacc[half][s8 + 4], sacc[half][s8 + 5]); pw.w = cvtpk(sacc[half][s8 + 6], sacc[half][s8 + 7]);
                    pf[ks] = __builtin_bit_cast(bf16x8, pw); }
                if (VAR != 3) { bf16x8 vf[2][4];
                    LAS const char* vp0 = Vs + (4 * hi + q4) * VP + (16 * blk) * 2 + 8 * p4;
#define ATT_VLOAD(dst, et) do { _Pragma("unroll") for (int ks_ = 0; ks_ < 4; ++ks_) { const s16x4 lo_ = tr16(vp0 + 16 * ks_ * VP + (et) * 64), hi_ = tr16(vp0 + (16 * ks_ + 8) * VP + (et) * 64); dst[ks_] = __builtin_shufflevector(lo_, hi_, 0, 1, 2, 3, 4, 5, 6, 7); } } while (0)
                    ATT_VLOAD(vf[0], 0);
#pragma unroll
                    for (int et = 0; et < 4; ++et) {
                        if (et < 3) ATT_VLOAD(vf[(et + 1) & 1], et + 1);
                        __builtin_amdgcn_sched_barrier(0);
#pragma unroll
                        for (int ks = 0; ks < 4; ++ks) o[et] = MFMA32(vf[et & 1][ks], pf[ks], o[et]);
                        __builtin_amdgcn_sched_barrier(0); }
#undef ATT_VLOAD
                }
            }
            if (more) ATT_STORET((j + 1) & 1);
            if (j == 1 && ntu > 2) {
                float mmin = m;
#pragma unroll
                for (int o2 = 1; o2 < 32; o2 <<= 1) mmin = fminf(mmin, __shfl_xor(mmin, o2));
                const float x = (mmin - 50.f - bc - 63.f * slope2) / (64.f * slope2);
                int ktlo = x > 0.f ? (int)ceilf(x) : 0; if (ktlo > ntu - 2) ktlo = ntu - 2;
                if (lane == 0) ((LAS int*)(KNW + 32))[w] = ktlo; }
            __syncthreads();
            if (j == 1 && ntu > 2) { int lo8 = ntu; for (int w8 = 0; w8 < 8; ++w8) { const int v8 = ((LAS const int*)(KNW + 32))[w8]; lo8 = v8 < lo8 ? v8 : lo8; } nj = ntu - lo8; }
        }
#undef ATT_LOADT
#undef ATT_STORET
        l = xhalf_sum(l);
        const float inv = 1.0f / l;
#ifdef LSE_DIAG
        if (c == 0 && hi == 0) ((float*)(F.ws + WS_GATE))[(rowb + qpos) * 8 + h] = (m + log2f(l) - slope2 * (float)qpos) * 0.6931471805599453f;
#endif
        if (c == 1) {
#pragma unroll
            for (int et = 0; et < 4; ++et)
#pragma unroll
                for (int r = 0; r < 16; ++r) XCH[((g * 64 + et * 16 + r) * 2 + hi) * 32 + r32] = o[et][r] * inv;
        }
        __syncthreads();
        if (c == 0) {
            float ss = 0.f;
#pragma unroll
            for (int et = 0; et < 4; ++et)
#pragma unroll
                for (int r = 0; r < 16; ++r) { const float v = o[et][r] * inv - lam_full * XCH[((g * 64 + et * 16 + r) * 2 + hi) * 32 + r32]; o[et][r] = v; ss += v * v; }
            ss = xhalf_sum(ss);
            const float rn = rsqrtf(ss * (1.f / 128.f) + EPS) * (1.f - LAMBDA_INIT);
            const float* sg = F.in[I_ASUBLN];
            bf16* orow = Ob + (rowb + qpos) * 1024 + h * 128;
#pragma unroll
            for (int et = 0; et < 4; ++et)
#pragma unroll
                for (int r4 = 0; r4 < 4; ++r4) { const int e0 = et * 32 + 8 * r4 + 4 * hi; const f32x4 gv = *(const GAS f32x4*)(sg + e0);
                    v2u wv; wv.x = pk2(o[et][4 * r4 + 0] * rn * gv.x, o[et][4 * r4 + 1] * rn * gv.y); wv.y = pk2(o[et][4 * r4 + 2] * rn * gv.z, o[et][4 * r4 + 3] * rn * gv.w);
                    *(GAS v2u*)(orow + e0) = wv; }
        }
    }
    }
    __syncthreads();
}
#define HAVE_ML 1
#define MFMA16(a, b, c) __builtin_amdgcn_mfma_f32_16x16x32_bf16((a), (b), (c), 0, 0, 0)
constexpr float KSCALE = 0.04419417382415922f;
constexpr size_t WS_XM = A_(128), WS_QB = A_(0), WS_KB = A_(256), WS_ZB = A_(256), WS_H2B = A_(0);
constexpr size_t WS_WC = WS_TAB + 64 * 1024;
constexpr size_t WS_WPP = WS_TAB + 128 * 1024;
constexpr size_t WS_WVF = WS_TAB + 192 * 1024;
__device__ __forceinline__ f32x4 bf4_to_f32(v2u w) { return (f32x4){bf_lo(w.x), bf_hi(w.x), bf_lo(w.y), bf_hi(w.y)}; }
__device__ __forceinline__ v2u f32_to_bf4(f32x4 v) { v2u w; w.x = pk2(v.x, v.y); w.y = pk2(v.z, v.w); return w; }
__device__ __forceinline__ f32x4 conv_silu(const f32x4 (&xm)[4], const f32x4 (&cw)[4], f32x4 cb) {
    f32x4 a = cb + xm[0] * cw[0] + xm[1] * cw[1] + xm[2] * cw[2] + xm[3] * cw[3];
    return (f32x4){fsilu(a.x), fsilu(a.y), fsilu(a.z), fsilu(a.w)};
}
__device__ __forceinline__ f32x4 hw4(f32x4 x, const f32x4 (&w)[4]) { return w[0] * x.x + w[1] * x.y + w[2] * x.z + w[3] * x.w; }

__device__ __forceinline__ void p_mlprep(Frame& F) {
    const float* wg = F.in[I_WGATE];
    for (int e = (int)blockIdx.x * 512 + F.tid; e < 2048 * 8; e += F.G * 512) { const int f = e >> 3, o = e & 7, g = f >> 2, i = f & 3; float s = 0.f, c = 0.f;
#pragma unroll
        for (int o2 = 0; o2 < 4; ++o2) { s += F.in[I_WV][g * 16 + i * 4 + o2] * wg[(size_t)(4096 + 4 * g + o2) * 8 + o];
            c += F.in[I_WQ][g * 16 + i * 4 + o2] * wg[(size_t)(4 * g + o2) * 8 + o] + F.in[I_WK][g * 16 + i * 4 + o2] * wg[(size_t)(2048 + 4 * g + o2) * 8 + o]; }
        ((float*)(F.ws + WS_WVF))[e] = s; ((float*)(F.ws + WS_WC))[e] = c; }
}
__device__ __forceinline__ void p_mlprep2(Frame& F) {
    LAS float* red = (LAS float*)F.lds;
    const float* wvf = (const float*)(F.ws + WS_WVF);
    f32x4 wv[8];
#pragma unroll
    for (int i = 0; i < 8; ++i) wv[i] = *(const GAS f32x4*)(wvf + (size_t)F.tid * 32 + 4 * i);
    for (int d0 = 4 * (int)blockIdx.x; d0 < 1024; d0 += 4 * F.G) {
        f32x4 wi[4];
#pragma unroll
        for (int dl = 0; dl < 4; ++dl) wi[dl] = *(const GAS f32x4*)(F.in[I_MWIN] + (size_t)(d0 + dl) * 4096 + 4 * F.tid);
#pragma unroll
        for (int dl = 0; dl < 4; ++dl) { f32x4 a0 = wv[0] * wi[dl].x + wv[2] * wi[dl].y + wv[4] * wi[dl].z + wv[6] * wi[dl].w, a1 = wv[1] * wi[dl].x + wv[3] * wi[dl].y + wv[5] * wi[dl].z + wv[7] * wi[dl].w;
            a0.x = wave_sum(a0.x); a0.y = wave_sum(a0.y); a0.z = wave_sum(a0.z); a0.w = wave_sum(a0.w); a1.x = wave_sum(a1.x); a1.y = wave_sum(a1.y); a1.z = wave_sum(a1.z); a1.w = wave_sum(a1.w);
            if (F.lane == 0) { *(LAS f32x4*)(red + (dl * 8 + F.wave) * 8) = a0; *(LAS f32x4*)(red + (dl * 8 + F.wave) * 8 + 4) = a1; } }
        __syncthreads();
        if (F.tid < 32) { const int dl = F.tid >> 3, o = F.tid & 7; float s2 = 0.f;
#pragma unroll
            for (int w8 = 0; w8 < 8; ++w8) s2 += red[(dl * 8 + w8) * 8 + o];
            ((float*)(F.ws + WS_WPP))[(d0 + dl) * 8 + o] = s2; }
        __syncthreads();
    }
}

__device__ __forceinline__ void p_normb(Frame& F, const bf16* Y, const float* gpost, const float* modg, const float* gn, const float* modn, bf16* Hout) {
    LAS float* wr = (LAS float*)F.lds;
    for (int e = F.tid; e < 8192 / 4; e += 512) ((LAS f32x4*)wr)[e] = ((const GAS f32x4*)(F.ws + WS_WPP))[e];
    __syncthreads();
    float* G = (float*)(F.ws + WS_GATE); const int lane = F.lane;
    ROWBLOCK(m0, m1);
    const bf16* Xb = (const bf16*)F.X;
    Row16 ynx = load_row_bf16_nt(Y + (size_t)m0 * D, lane), xnx = load_row_bf16_nt(Xb + (size_t)m0 * D, lane);
    for (int m = m0; m < m1; ++m) { const int b = m >> 11; const float* mb = modn + (size_t)b * 6144;
        const Row16 gp = load_row_f32(gpost, lane), gt = load_row_f32(modg + (size_t)b * 6144 + 5 * 1024, lane);
        const Row16 y = ynx, xo = xnx; if (m + 1 < m1) { ynx = load_row_bf16_nt(Y + (size_t)(m + 1) * D, lane); xnx = load_row_bf16_nt(Xb + (size_t)(m + 1) * D, lane); }
        const float r1 = rsqrtf(row_ss(y) * (1.f / D) + EPS);
        Row16 xn;
#pragma unroll
        for (int j = 0; j < 4; ++j) xn.v[j] = xo.v[j] + gt.v[j] * (y.v[j] * r1 * gp.v[j]);
        xn = round_row_bf16(xn);
        store_row_bf16((bf16*)F.X + (size_t)m * D, lane, xn);
        const float r2 = rsqrtf(row_ss(xn) * (1.f / D) + EPS);
        const Row16 gg = load_row_f32(gn, lane), sc = load_row_f32(mb + 1024, lane), sh = load_row_f32(mb, lane); Row16 h;
#pragma unroll
        for (int j = 0; j < 4; ++j) h.v[j] = xn.v[j] * r2 * gg.v[j] * (sc.v[j] + 1.0f) + sh.v[j];
        store_row_bf16(Hout + (size_t)m * D, lane, h);
        store_row_bf16((bf16*)F.X + (size_t)T * D + (size_t)m * D, lane, h);
        f32x4 a0 = {0.f, 0.f, 0.f, 0.f}, a1 = {0.f, 0.f, 0.f, 0.f};
#pragma unroll
        for (int j = 0; j < 4; ++j)
#pragma unroll
            for (int c = 0; c < 4; ++c) { const int f = 4 * lane + 256 * j + c; const float hv = h.v[j][c];
                a0 += *(LAS const f32x4*)(wr + f * 8) * hv; a1 += *(LAS const f32x4*)(wr + f * 8 + 4) * hv; }
#pragma unroll
        for (int o = 1; o < 64; o <<= 1) { a0.x += __shfl_xor(a0.x, o); a0.y += __shfl_xor(a0.y, o); a0.z += __shfl_xor(a0.z, o); a0.w += __shfl_xor(a0.w, o);
            a1.x += __shfl_xor(a1.x, o); a1.y += __shfl_xor(a1.y, o); a1.z += __shfl_xor(a1.z, o); a1.w += __shfl_xor(a1.w, o); }
        if (lane == 0) { const f32x4 b0 = *(const GAS f32x4*)F.in[I_BGATE], b1 = *(const GAS f32x4*)(F.in[I_BGATE] + 4); *(GAS f32x4*)(G + (size_t)m * 8) = a0 + b0; *(GAS f32x4*)(G + (size_t)m * 8 + 4) = a1 + b1; }
    }
    __syncthreads();
}
__device__ __forceinline__ void p_h2b(Frame& F, const float* gn, const float* modn, bf16* Hout) {
    ROWBLOCK(m0, m1); int bc = -1; const Row16 gg = load_row_f32(gn, F.lane); Row16 sc, sh;
    const bf16* Xb = (const bf16*)F.X;
    Row16 xnx = load_row_bf16(Xb + (size_t)m0 * D, F.lane);
    for (int m = m0; m < m1; ++m) { const int b = m >> 11;
        if (b != bc) { bc = b; const float* mb = modn + (size_t)b * 6144; sc = load_row_f32(mb + 1024, F.lane); sh = load_row_f32(mb, F.lane); }
        const Row16 x = xnx; if (m + 1 < m1) xnx = load_row_bf16(Xb + (size_t)(m + 1) * D, F.lane);
        const float rstd = rsqrtf(row_ss(x) * (1.f / D) + EPS); Row16 h;
#pragma unroll
        for (int j = 0; j < 4; ++j) h.v[j] = x.v[j] * rstd * gg.v[j] * (sc.v[j] + 1.0f) + sh.v[j];
        store_row_bf16(Hout + (size_t)m * D, F.lane, h); }
}

__device__ __forceinline__ void p_gates2(Frame& F) {
    const bf16* XM = (const bf16*)(F.ws + WS_XM); float* G = (float*)(F.ws + WS_GATE); bf16* QB = (bf16*)(F.ws + WS_QB); bf16* KB = (bf16*)(F.ws + WS_KB);
    const int tid = F.tid, fg = tid, f0 = 4 * fg, lane = F.lane, l15 = lane & 15, q4 = lane >> 4, w = F.wave;
    constexpr int AP = 4112;
    LAS unsigned char* At = F.lds; LAS float* Pt = (LAS float*)(F.lds + 16 * AP);
    f32x4 cw[4], cb, wq[4], wk[4];
#pragma unroll
    for (int j = 0; j < 4; ++j) cw[j] = *(const GAS f32x4*)(F.in[I_CONVW] + j * 2048 + f0);
    cb = *(const GAS f32x4*)(F.in[I_CONVB] + f0);
#pragma unroll
    for (int i = 0; i < 4; ++i) { wq[i] = *(const GAS f32x4*)(F.in[I_WQ] + fg * 16 + i * 4); wk[i] = *(const GAS f32x4*)(F.in[I_WK] + fg * 16 + i * 4) * KSCALE; }
    bf16x8 bfr[8];
    { const float* wc = (const float*)(F.ws + WS_WC);
#pragma unroll
        for (int ks = 0; ks < 8; ++ks) { float v[8];
#pragma unroll
            for (int j = 0; j < 8; ++j) v[j] = l15 < 8 ? wc[(size_t)(256 * w + 32 * ks + 8 * q4 + j) * 8 + l15] : 0.f;
            v4u pw; pw.x = pk2(v[0], v[1]); pw.y = pk2(v[2], v[3]); pw.z = pk2(v[4], v[5]); pw.w = pk2(v[6], v[7]); bfr[ks] = __builtin_bit_cast(bf16x8, pw); } }
    const int vcu = F.gw >> 3;
    for (int run = vcu; run < T / 128; run += F.G) {
        const int t0 = run * 128, tb = t0 & (S - 1);
        f32x4 xm[4];
#pragma unroll
        for (int j = 0; j < 3; ++j) { const int tt = tb - 3 + j; xm[j + 1] = tt >= 0 ? bf4_to_f32(*(const GAS v2u*)(XM + (size_t)(t0 - 3 + j) * 2048 + f0)) : (f32x4){0.f, 0.f, 0.f, 0.f}; }
        for (int sb = 0; sb < 8; ++sb) {
            v2u xin[16];
#pragma unroll
            for (int tt = 0; tt < 16; ++tt) xin[tt] = __builtin_nontemporal_load((const v2u*)(XM + ((size_t)t0 + 16 * sb + tt) * 2048 + f0));
#pragma unroll
            for (int tt = 0; tt < 16; ++tt) { const size_t t = (size_t)t0 + 16 * sb + tt;
                xm[0] = xm[1]; xm[1] = xm[2]; xm[2] = xm[3];
                xm[3] = bf4_to_f32(xin[tt]);
                const f32x4 xc = conv_silu(xm, cw, cb);
                __builtin_nontemporal_store(f32_to_bf4(hw4(xc, wq)), (v2u*)(QB + t * 2048 + f0));
                __builtin_nontemporal_store(f32_to_bf4(hw4(xc, wk)), (v2u*)(KB + t * 2048 + f0));
                *(LAS v2u*)(At + tt * AP + fg * 8) = f32_to_bf4(xc); }
            __syncthreads();
            f32x4 acc = {0.f, 0.f, 0.f, 0.f};
#pragma unroll
            for (int ks = 0; ks < 8; ++ks) { const bf16x8 af = *(LAS const bf16x8*)(At + l15 * AP + (256 * w + 32 * ks + 8 * q4) * 2); acc = MFMA16(af, bfr[ks], acc); }
            if (l15 < 8) {
#pragma unroll
                for (int r = 0; r < 4; ++r) Pt[(w * 16 + 4 * q4 + r) * 8 + l15] = acc[r]; }
            __syncthreads();
            if (tid < 128) { const int tt = tid >> 3, o = tid & 7; float s = 0.f;
#pragma unroll
                for (int w8 = 0; w8 < 8; ++w8) s += Pt[(w8 * 16 + tt) * 8 + o];
                G[((size_t)t0 + 16 * sb + tt) * 8 + o] += s; }
        }
        __syncthreads();
    }
}

struct CellLds { static constexpr int QP = 528, VP = 288, WP = 144;
    static constexpr int QH = 0, KH = 64 * QP, VV = 2 * 64 * QP, WW = VV + 64 * VP, SC = WW + 64 * WP, NQP = SC + 2048  , PB = NQP + 2048  , END = PB + 3 * 8192 + 256; };
static_assert(CellLds::END <= RING_BYTES, "cell LDS map");
constexpr int SC_E1 = 0, SC_A = 64, SC_INTER = 128, SC_WS = 192, SC_EMT = 256, SC_HDEN = 320, SC_DECAY = 384, SC_MPREV = 385;

__device__ __forceinline__ bf16x8 cell_vfrag(LAS unsigned char* lds, int ks, int w, int q, int qq, int pp) {
    LAS const char* vp = (LAS const char*)(lds + CellLds::VV + (32 * ks + 8 * q + qq) * CellLds::VP + (16 * w + 4 * pp) * 2);
    const s16x4 lo = tr16(vp), hi4 = tr16(vp + 4 * CellLds::VP);
    return __builtin_shufflevector(lo, hi4, 0, 1, 2, 3, 4, 5, 6, 7);
}
__device__ __forceinline__ void cell_issue(v4u (&qk)[8], const bf16* QB, const bf16* KB, size_t row0, int h, int P, int tid) {
    const size_t off = (row0 + (tid >> 3)) * 2048 + h * 512 + 256 * P + (tid & 7) * 8;
#pragma unroll
    for (int i = 0; i < 4; ++i) { qk[i] = *(const GAS v4u*)(QB + off + 64 * i); qk[4 + i] = *(const GAS v4u*)(KB + off + 64 * i); }
}
__device__ __forceinline__ void cell_commit(const v4u (&qk)[8], LAS unsigned char* lds, int tid) {
    LAS unsigned char* p = lds + (tid >> 3) * CellLds::QP + (tid & 7) * 16;
#pragma unroll
    for (int i = 0; i < 4; ++i) { *(LAS v4u*)(p + CellLds::QH + 128 * i) = qk[i]; *(LAS v4u*)(p + CellLds::KH + 128 * i) = qk[4 + i]; }
}

template <int P>
__device__ __forceinline__ void cell_half_a(LAS unsigned char* lds, v2u (&ct)[32], f32x4 (&nt)[4], f32x4 (&zt)[4], f32x4 (&sacc)[2], int w, int lane) {
    using CL = CellLds;
    const int l15 = lane & 15, q = lane >> 4, qq = l15 >> 2, pp = l15 & 3;
    LAS const float* sc = (LAS const float*)(lds + CL::SC);
    { const int tt = w >> 1, st0 = 2 * (w & 1);
#pragma unroll
        for (int ks = 0; ks < 8; ++ks) { const bf16x8 af = *(LAS const bf16x8*)(lds + CL::QH + (16 * tt + l15) * CL::QP + (32 * ks + 8 * q) * 2);
#pragma unroll
            for (int j = 0; j < 2; ++j) { const bf16x8 bfr = *(LAS const bf16x8*)(lds + CL::KH + (16 * (st0 + j) + l15) * CL::QP + (32 * ks + 8 * q) * 2); sacc[j] = MFMA16(af, bfr, sacc[j]); } } }
#pragma unroll
    for (int kk = 0; kk < 8; ++kk) { const v2u c0 = ct[16 * P + 2 * kk], c1 = ct[16 * P + 2 * kk + 1];
        v4u aw; aw.x = c0.x; aw.y = c0.y; aw.z = c1.x; aw.w = c1.y;
        const bf16x8 af = __builtin_bit_cast(bf16x8, aw);
#pragma unroll
        for (int tt = 0; tt < 4; ++tt) { LAS const unsigned char* qp = lds + CL::QH + (16 * tt + l15) * CL::QP + (32 * kk + 4 * q) * 2;
            const v2u lo = *(LAS const v2u*)qp, hi2 = *(LAS const v2u*)(qp + 32);
            v4u bw; bw.x = lo.x; bw.y = lo.y; bw.z = hi2.x; bw.w = hi2.y;
            zt[tt] = MFMA16(af, __builtin_bit_cast(bf16x8, bw), zt[tt]); } }
    const bool mine = (w >> 2) == P;
    const int dl0 = 4 * (w & 3);
    if (mine) {
#pragma unroll
        for (int tt = 0; tt < 4; ++tt) { f32x4 nz = {0.f, 0.f, 0.f, 0.f};
#pragma unroll
            for (int k2 = 0; k2 < 2; ++k2) { v4u aw; aw.x = cvtpk(nt[2 * k2].x, nt[2 * k2].y); aw.y = cvtpk(nt[2 * k2].z, nt[2 * k2].w); aw.z = cvtpk(nt[2 * k2 + 1].x, nt[2 * k2 + 1].y); aw.w = cvtpk(nt[2 * k2 + 1].z, nt[2 * k2 + 1].w);
                LAS const unsigned char* qp = lds + CL::QH + (16 * tt + l15) * CL::QP + (32 * ((dl0 >> 1) + k2) + 4 * q) * 2;
                const v2u lo = *(LAS const v2u*)qp, hi2 = *(LAS const v2u*)(qp + 32);
                v4u bw; bw.x = lo.x; bw.y = lo.y; bw.z = hi2.x; bw.w = hi2.y;
                nz = MFMA16(__builtin_bit_cast(bf16x8, aw), __builtin_bit_cast(bf16x8, bw), nz); }
            if (q == 0) ((LAS float*)(lds + CL::NQP))[w * 64 + 16 * tt + l15] = nz.x; } }
}
template <int P>
__device__ __forceinline__ void cell_half_b(LAS unsigned char* lds, v2u (&ct)[32], f32x4 (&nt)[4], int w, int lane, float decay, float wsoff, LAS const float* pa) {
    using CL = CellLds;
    const int l15 = lane & 15, q = lane >> 4, qq = l15 >> 2, pp = l15 & 3;
    LAS const float* sc = (LAS const float*)(lds + CL::SC);
    const bool mine = (w >> 2) == P;
    {
        bf16x8 vpf[2], wsf[2];
#pragma unroll
        for (int ks = 0; ks < 2; ++ks) { const bf16x8 vfr = cell_vfrag(lds, ks, w, q, qq, pp);
            f32x4 w0 = *(LAS const f32x4*)(pa + 32 * ks + 8 * q) + wsoff, w1 = *(LAS const f32x4*)(pa + 32 * ks + 8 * q + 4) + wsoff;
            w0 = (f32x4){__expf(w0.x), __expf(w0.y), __expf(w0.z), __expf(w0.w)}; w1 = (f32x4){__expf(w1.x), __expf(w1.y), __expf(w1.z), __expf(w1.w)};
            const v4u vw = __builtin_bit_cast(v4u, vfr); v4u ow;
            ow.x = cvtpk(bf_lo(vw.x) * w0.x, bf_hi(vw.x) * w0.y); ow.y = cvtpk(bf_lo(vw.y) * w0.z, bf_hi(vw.y) * w0.w); ow.z = cvtpk(bf_lo(vw.z) * w1.x, bf_hi(vw.z) * w1.y); ow.w = cvtpk(bf_lo(vw.w) * w1.z, bf_hi(vw.w) * w1.w);
            vpf[ks] = __builtin_bit_cast(bf16x8, ow);
            v4u sw; if (l15 == 0) { sw.x = cvtpk(w0.x, w0.y); sw.y = cvtpk(w0.z, w0.w); sw.z = cvtpk(w1.x, w1.y); sw.w = cvtpk(w1.z, w1.w); } else { sw = (v4u){0u, 0u, 0u, 0u}; }
            wsf[ks] = __builtin_bit_cast(bf16x8, sw); }
#pragma unroll
        for (int dt = 0; dt < 16; ++dt) { f32x4 acc = bf4_to_f32(ct[16 * P + dt]) * decay;
            f32x4 nacc = {0.f, 0.f, 0.f, 0.f}; const bool nmine = mine && (dt >> 2) == (w & 3);
            if (nmine) nacc = nt[dt & 3] * decay;
#pragma unroll
            for (int ks = 0; ks < 2; ++ks) { LAS const char* kp = (LAS const char*)(lds + CL::KH + (32 * ks + 8 * q + qq) * CL::QP + (16 * dt + 4 * pp) * 2);
                const s16x4 lo = tr16(kp), hi4 = tr16(kp + 4 * CL::QP);
                const bf16x8 kf = __builtin_shufflevector(lo, hi4, 0, 1, 2, 3, 4, 5, 6, 7);
                acc = MFMA16(kf, vpf[ks], acc);
                if (nmine) nacc = MFMA16(kf, wsf[ks], nacc); }
            v2u cw2; cw2.x = cvtpk(acc.x, acc.y); cw2.y = cvtpk(acc.z, acc.w); ct[16 * P + dt] = cw2;
            if (nmine) nt[dt & 3] = nacc; } }
}

__device__ __forceinline__ void p_cell2(Frame& F) {
    using CL = CellLds;
    const bf16* XM = (const bf16*)(F.ws + WS_XM); const bf16* QB = (const bf16*)(F.ws + WS_QB); const bf16* KB = (const bf16*)(F.ws + WS_KB);
    const float* G = (const float*)(F.ws + WS_GATE); bf16* HH = (bf16*)(F.ws + WS_HH);
    LAS unsigned char* lds = F.lds;
    LAS float* sc = (LAS float*)(lds + CL::SC);
    LAS float* PB = (LAS float*)(lds + CL::PB); LAS float* PA = PB + 2048; LAS float* PM = PA + 2048; LAS float* BL = PM + 2048; LAS float* AM = BL + 32;
    const int w = F.wave;
#define CELL_LANE() ({ int l_ = (int)__builtin_amdgcn_mbcnt_hi(~0u, __builtin_amdgcn_mbcnt_lo(~0u, 0u)); asm volatile("" : "+v"(l_)); l_; })
    const int vcu = F.gw >> 3;
    for (int wi = vcu; wi < B * NH * 4; wi += F.G) {
        const int vs = wi & 3, h = (wi >> 2) & 3, b = wi >> 4;
        v2u ct[32]; f32x4 nt[4];
#pragma unroll
        for (int i = 0; i < 32; ++i) ct[i] = (v2u){0u, 0u};
#pragma unroll
        for (int i = 0; i < 4; ++i) nt[i] = (f32x4){0.f, 0.f, 0.f, 0.f};
        __syncthreads();
        { const int lane0 = CELL_LANE();
#pragma unroll 1
            for (int cc = 0; cc < 4; ++cc) { const int ch = 4 * w + cc; const size_t r = (size_t)b * S + 64 * ch + lane0;
                const float ip = G[r * 8 + h], fp_ = G[r * 8 + 4 + h];
                float bcum = fminf(fp_, 0.f) - __logf(1.f + __expf(-fabsf(fp_)));
#pragma unroll
                for (int o = 1; o < 64; o <<= 1) { const float t2 = __shfl_up(bcum, o); if (lane0 >= o) bcum += t2; }
                const float a = ip - bcum; float pm = a;
#pragma unroll
                for (int o = 1; o < 64; o <<= 1) { const float t2 = __shfl_up(pm, o); if (lane0 >= o) pm = fmaxf(pm, t2); }
                PB[64 * ch + lane0] = bcum; PA[64 * ch + lane0] = a; PM[64 * ch + lane0] = pm;
                if (lane0 == 63) { BL[ch] = bcum; AM[ch] = pm; } } }
        __syncthreads();
        float mprev = 0.f;
#define CELL_DMA0(rowp, lane_) do { if ((lane_) < 32) { _Pragma("unroll") for (int r_ = 0; r_ < 8; ++r_) { const int row_ = 8 * w + r_; const size_t go_ = ((rowp) + row_) * 2048 + h * 512 + (lane_) * 8; \
            __builtin_amdgcn_global_load_lds((const GAS unsigned*)(QB + go_), (LAS unsigned*)(lds + CL::QH + row_ * CL::QP), 16, 0, 0); \
            __builtin_amdgcn_global_load_lds((const GAS unsigned*)(KB + go_), (LAS unsigned*)(lds + CL::KH + row_ * CL::QP), 16, 0, 0); } } } while (0)
        { const int l0_ = CELL_LANE(); CELL_DMA0((size_t)b * S, l0_); }
#define CELL_VLOAD(xv, rowp, tid_) do { const int vg_ = (tid_) & 31, t4_ = 4 * ((tid_) >> 5), fv_ = h * 512 + vs * 128 + 4 * vg_; \
            _Pragma("unroll") for (int t_ = 0; t_ < 4; ++t_) xv[t_] = *(const GAS v2u*)(XM + ((rowp) + t4_ + t_) * 2048 + fv_); } while (0)
#define CELL_VCOMMIT(xv, tid_) do { const int vg_ = (tid_) & 31, t4_ = 4 * ((tid_) >> 5), fv_ = h * 512 + vs * 128 + 4 * vg_; f32x4 wv_[4]; \
            _Pragma("unroll") for (int i_ = 0; i_ < 4; ++i_) wv_[i_] = *(const GAS f32x4*)(F.in[I_WV] + (size_t)(fv_ >> 2) * 16 + i_ * 4); \
            _Pragma("unroll") for (int t_ = 0; t_ < 4; ++t_) *(LAS v2u*)(lds + CL::VV + (t4_ + t_) * CL::VP + vg_ * 8) = f32_to_bf4(hw4(bf4_to_f32(xv[t_]), wv_)); } while (0)
        { const int t0_ = w * 64 + CELL_LANE(); v2u x0[4]; CELL_VLOAD(x0, (size_t)b * S, t0_); CELL_VCOMMIT(x0, t0_); }
        for (int c = 0; c < S / 64; ++c) {
            const int tid = w * 64 + CELL_LANE();
            const int lane = tid & 63, l15 = lane & 15, q = lane >> 4, qq = l15 >> 2, pp = l15 & 3;
            const size_t row0 = (size_t)b * S + 64 * c;
            const float blast = BL[c], mnew = fmaxf(blast + mprev, blast + AM[c]), decay = __expf(blast + mprev - mnew);
            asm volatile("s_waitcnt vmcnt(0)" ::: "memory");
            __syncthreads();
            f32x4 zt[4], sacc[2];
#pragma unroll
            for (int i = 0; i < 4; ++i) zt[i] = (f32x4){0.f, 0.f, 0.f, 0.f};
            sacc[0] = (f32x4){0.f, 0.f, 0.f, 0.f}; sacc[1] = sacc[0];
            cell_half_a<0>(lds, ct, nt, zt, sacc, w, lane);
            v4u qk[8]; cell_issue(qk, QB, KB, row0, h, 1, tid);
            cell_half_b<0>(lds, ct, nt, w, lane, decay, blast - mnew, PA + 64 * c);
            __syncthreads();
            cell_commit(qk, lds, tid);
            __syncthreads();
            { int l3 = lane; asm volatile("" : "+v"(l3)); cell_half_a<1>(lds, ct, nt, zt, sacc, w, l3);
              cell_half_b<1>(lds, ct, nt, w, l3, decay, blast - mnew, PA + 64 * c); }
            { const int tt = w >> 1, st0 = 2 * (w & 1);
#pragma unroll
                for (int j = 0; j < 2; ++j) { const int s = 16 * (st0 + j) + l15; const float as = PA[64 * c + s];
#pragma unroll
                    for (int r = 0; r < 4; ++r) { const int t = 16 * tt + 4 * q + r; const float wv2 = s <= t ? __expf(as - fmaxf(mprev, PM[64 * c + t])) * sacc[j][r] : 0.f;
                        *(LAS bf16*)(lds + CL::WW + t * CL::WP + s * 2) = (bf16)f2bf(wv2); } } }
            __syncthreads();
            if (c + 1 < S / 64) CELL_DMA0(row0 + 64, lane);
            { const int t = tid >> 3, part = tid & 7; const v4u ww = *(LAS const v4u*)(lds + CL::WW + t * CL::WP + part * 16);
                float ds = (bf_lo(ww.x) + bf_hi(ww.x)) + (bf_lo(ww.y) + bf_hi(ww.y)) + (bf_lo(ww.z) + bf_hi(ww.z)) + (bf_lo(ww.w) + bf_hi(ww.w));
                float nqv = ((LAS const float*)(lds + CL::NQP))[part * 64 + t];
                ds += __shfl_xor(ds, 1); ds += __shfl_xor(ds, 2); ds += __shfl_xor(ds, 4);
                nqv += __shfl_xor(nqv, 1); nqv += __shfl_xor(nqv, 2); nqv += __shfl_xor(nqv, 4);
                if (part == 0) { const float mxp = fmaxf(mprev, PM[64 * c + t]); const float den = ds + __expf(mprev - mxp) * nqv; sc[SC_HDEN + t] = 1.0f / fmaxf(fabsf(den), __expf(-(PB[64 * c + t] + mxp))); } }
#pragma unroll
            for (int tt = 0; tt < 4; ++tt) { zt[tt] = zt[tt] * __expf(mprev - fmaxf(mprev, PM[64 * c + 16 * tt + l15]));
#pragma unroll
                for (int ks = 0; ks < 2; ++ks) { const bf16x8 wf = *(LAS const bf16x8*)(lds + CL::WW + (16 * tt + l15) * CL::WP + (32 * ks + 8 * q) * 2); zt[tt] = MFMA16(cell_vfrag(lds, ks, w, q, qq, pp), wf, zt[tt]); } }
            v2u xn[4]; const int tid6 = w * 64 + CELL_LANE();
            if (c + 1 < S / 64) CELL_VLOAD(xn, row0 + 64, tid6);
            __syncthreads();
#pragma unroll
            for (int tt = 0; tt < 4; ++tt) { const int t = 16 * tt + l15; const f32x4 o = zt[tt] * sc[SC_HDEN + t];
                *(GAS v2u*)(HH + (row0 + t) * 2048 + h * 512 + vs * 128 + 16 * w + 4 * q) = f32_to_bf4(o); }
            if (c + 1 < S / 64) CELL_VCOMMIT(xn, tid6);
            mprev = mnew;
        }
#undef CELL_DMA0
#undef CELL_VLOAD
#undef CELL_VCOMMIT
#undef CELL_LANE
    }
    __syncthreads();
}

__device__ __forceinline__ void p_post(Frame& F) {
    const bf16* XM = (const bf16*)(F.ws + WS_XM); const bf16* ZB = (const bf16*)(F.ws + WS_ZB); bf16* HH = (bf16*)(F.ws + WS_HH);
    const int lane = F.lane;
    const int per = (T + F.NGW - 1) / F.NGW;
    for (int hd = 0; hd < NH; ++hd) {
        const int f0 = hd * 512 + 8 * lane;
        f32x4 cw[4][2], cb[2], sk[2], gn[2];
#pragma unroll
        for (int u = 0; u < 2; ++u) {
#pragma unroll
            for (int j = 0; j < 4; ++j) cw[j][u] = *(const GAS f32x4*)(F.in[I_CONVW] + j * 2048 + f0 + 4 * u);
            cb[u] = *(const GAS f32x4*)(F.in[I_CONVB] + f0 + 4 * u); sk[u] = *(const GAS f32x4*)(F.in[I_SKIP] + f0 + 4 * u); gn[u] = *(const GAS f32x4*)(F.in[I_MNORM] + f0 + 4 * u); }
        const int t0 = F.gw * per, t1 = (t0 + per < T) ? t0 + per : T;
        v4u xr[4];
#pragma unroll
        for (int j = 0; j < 3; ++j) { const int tt = t0 - 3 + j; xr[j + 1] = (tt >= 0 && (tt >> 11) == (t0 >> 11)) ? *(const GAS v4u*)(XM + (size_t)tt * 2048 + f0) : (v4u){0u, 0u, 0u, 0u}; }
        v4u xnx = __builtin_nontemporal_load((const v4u*)(XM + (size_t)t0 * 2048 + f0)), hnx = __builtin_nontemporal_load((const v4u*)(HH + (size_t)t0 * 2048 + f0)), znx = __builtin_nontemporal_load((const v4u*)(ZB + (size_t)t0 * 2048 + f0));
        for (int t = t0; t < t1; ++t) {
            xr[0] = xr[1]; xr[1] = xr[2]; xr[2] = xr[3]; xr[3] = xnx;
            if ((t & (S - 1)) == 0) { xr[0] = (v4u){0u, 0u, 0u, 0u}; xr[1] = xr[0]; xr[2] = xr[0]; }
            const v4u hw = hnx, zw = znx;
            if (t + 1 < t1) { xnx = __builtin_nontemporal_load((const v4u*)(XM + (size_t)(t + 1) * 2048 + f0)); hnx = __builtin_nontemporal_load((const v4u*)(HH + (size_t)(t + 1) * 2048 + f0)); znx = __builtin_nontemporal_load((const v4u*)(ZB + (size_t)(t + 1) * 2048 + f0)); }
            f32x4 hv[2] = {(f32x4){bf_lo(hw.x), bf_hi(hw.x), bf_lo(hw.y), bf_hi(hw.y)}, (f32x4){bf_lo(hw.z), bf_hi(hw.z), bf_lo(hw.w), bf_hi(hw.w)}};
            float s1 = (hv[0].x + hv[0].y) + (hv[0].z + hv[0].w) + (hv[1].x + hv[1].y) + (hv[1].z + hv[1].w);
            const float mu = wave_sum(s1) * (1.f / 512.f);
            hv[0] = hv[0] - mu; hv[1] = hv[1] - mu;
            float s2 = (hv[0].x * hv[0].x + hv[0].y * hv[0].y) + (hv[0].z * hv[0].z + hv[0].w * hv[0].w) + (hv[1].x * hv[1].x + hv[1].y * hv[1].y) + (hv[1].z * hv[1].z + hv[1].w * hv[1].w);
            const float rstd = rsqrtf(wave_sum(s2) * (1.f / 512.f) + EPS);
            f32x4 acc[2] = {cb[0], cb[1]};
#pragma unroll
            for (int j = 0; j < 4; ++j) { const v4u xw = xr[j];
                acc[0] += (f32x4){bf_lo(xw.x), bf_hi(xw.x), bf_lo(xw.y), bf_hi(xw.y)} * cw[j][0]; acc[1] += (f32x4){bf_lo(xw.z), bf_hi(xw.z), bf_lo(xw.w), bf_hi(xw.w)} * cw[j][1]; }
            const f32x4 z0 = (f32x4){bf_lo(zw.x), bf_hi(zw.x), bf_lo(zw.y), bf_hi(zw.y)}, z1 = (f32x4){bf_lo(zw.z), bf_hi(zw.z), bf_lo(zw.w), bf_hi(zw.w)};
            f32x4 o0 = hv[0] * rstd * gn[0] + sk[0] * (f32x4){fsilu(acc[0].x), fsilu(acc[0].y), fsilu(acc[0].z), fsilu(acc[0].w)};
            f32x4 o1 = hv[1] * rstd * gn[1] + sk[1] * (f32x4){fsilu(acc[1].x), fsilu(acc[1].y), fsilu(acc[1].z), fsilu(acc[1].w)};
            o0 = o0 * (f32x4){fsilu(z0.x), fsilu(z0.y), fsilu(z0.z), fsilu(z0.w)}; o1 = o1 * (f32x4){fsilu(z1.x), fsilu(z1.y), fsilu(z1.z), fsilu(z1.w)};
            v4u ow; ow.x = pk2(o0.x, o0.y); ow.y = pk2(o0.z, o0.w); ow.z = pk2(o1.x, o1.y); ow.w = pk2(o1.z, o1.w);
            __builtin_nontemporal_store(ow, (v4u*)(HH + (size_t)t * 2048 + f0));
        }
    }
}
#define HAVE_MOE 1
constexpr size_t RT_IDS = 0, RT_WTS = 256 * 1024, RT_POS = 512 * 1024, RT_STOK = 768 * 1024;
static_assert(RT_STOK + (size_t)MPAD * 4 <= 2 * MiB, "route tables");
constexpr int CW_WCNT = 150000;

__device__ __forceinline__ void p_normc(Frame& F, const bf16* Y, const float* gpost, const float* mod1, const float* gn, bf16* Hout) {
    LAS float* wr = (LAS float*)F.lds;
    for (int e = F.tid; e < 8192 / 4; e += 512) ((LAS f32x4*)wr)[e] = ((const GAS f32x4*)F.in[I_WROUTER])[e];
    __syncthreads();
    int* ids = (int*)(F.ws + WS_ROUTE + RT_IDS); float* wts = (float*)(F.ws + WS_ROUTE + RT_WTS);
    int cnt[8];
#pragma unroll
    for (int e = 0; e < 8; ++e) cnt[e] = 0;
    const int lane = F.lane;
    ROWBLOCK(m0, m1);
    for (int m = m0; m < m1; ++m) { const int b = m >> 11; const float* mb = mod1 + (size_t)b * 6144;
        const Row16 gp = load_row_f32(gpost, lane), gt = load_row_f32(mb + 2 * 1024, lane);
        const Row16 y = load_row_bf16_nt(Y + (size_t)m * D, lane), xo = load_row_bf16_nt((const bf16*)F.X + (size_t)m * D, lane);
        const float r1 = rsqrtf(row_ss(y) * (1.f / D) + EPS);
        Row16 xn;
#pragma unroll
        for (int j = 0; j < 4; ++j) xn.v[j] = xo.v[j] + gt.v[j] * (y.v[j] * r1 * gp.v[j]);
        xn = round_row_bf16(xn);
        store_row_bf16((bf16*)(F.ws + WS_XB) + (size_t)m * D, lane, xn);
        const float r2 = rsqrtf(row_ss(xn) * (1.f / D) + EPS);
        const Row16 gg = load_row_f32(gn, lane), sc = load_row_f32(mb + 4 * 1024, lane), sh = load_row_f32(mb + 3 * 1024, lane); Row16 h;
#pragma unroll
        for (int j = 0; j < 4; ++j) h.v[j] = xn.v[j] * r2 * gg.v[j] * (sc.v[j] + 1.0f) + sh.v[j];
        f32x4 a0 = {0.f, 0.f, 0.f, 0.f}, a1 = {0.f, 0.f, 0.f, 0.f};
#pragma unroll
        for (int j = 0; j < 4; ++j)
#pragma unroll
            for (int c = 0; c < 4; ++c) { const int f = 4 * lane + 256 * j + c; const float hv = h.v[j][c];
                a0 += *(LAS const f32x4*)(wr + f * 8) * hv; a1 += *(LAS const f32x4*)(wr + f * 8 + 4) * hv; }
#pragma unroll
        for (int o = 1; o < 64; o <<= 1) { a0.x += __shfl_xor(a0.x, o); a0.y += __shfl_xor(a0.y, o); a0.z += __shfl_xor(a0.z, o); a0.w += __shfl_xor(a0.w, o);
            a1.x += __shfl_xor(a1.x, o); a1.y += __shfl_xor(a1.y, o); a1.z += __shfl_xor(a1.z, o); a1.w += __shfl_xor(a1.w, o); }
        float lg[8] = {a0.x, a0.y, a0.z, a0.w, a1.x, a1.y, a1.z, a1.w};
        const float* br = F.in[I_BROUTER];
        float mx = -1e30f;
#pragma unroll
        for (int e = 0; e < 8; ++e) { lg[e] += br[e]; mx = fmaxf(mx, lg[e]); }
        int i0 = 0; float p0 = -1.f, p1 = -1.f; int i1 = 0;
#pragma unroll
        for (int e = 0; e < 8; ++e) { const float p = __expf(lg[e] - mx); if (p > p0) { p1 = p0; i1 = i0; p0 = p; i0 = e; } else if (p > p1) { p1 = p; i1 = e; } }
        const float inv = 1.0f / (p0 + p1);
        if (lane == 0) { ids[2 * m] = i0; ids[2 * m + 1] = i1; wts[2 * m] = p0 * inv; wts[2 * m + 1] = p1 * inv; }
#pragma unroll
        for (int e = 0; e < 8; ++e) cnt[e] += (i0 == e) + (i1 == e);
    }
    if (lane == 0) { unsigned* wc = (unsigned*)(F.ctl + CW_WCNT) + (size_t)F.gw * 8;
#pragma unroll
        for (int e = 0; e < 8; ++e) wc[e] = (unsigned)cnt[e]; }
    __syncthreads();
    for (int e = 0; e < NE; ++e) {
        convert_matrix(F, F.in[I_EWG] + (size_t)e * 1024 * F2, 1024, F2, (bf16*)(F.ws + WS_WMGU) + (size_t)e * 2 * F2 * 1024, 1);
        convert_matrix(F, F.in[I_EWU] + (size_t)e * 1024 * F2, 1024, F2, (bf16*)(F.ws + WS_WMGU) + (size_t)e * 2 * F2 * 1024, 2);
    }
}

__device__ __forceinline__ void p_sort(Frame& F, const float* gn, const float* mod1) {
    LAS int* sh = (LAS int*)F.lds;
    const unsigned* wc = (const unsigned*)(F.ctl + CW_WCNT);
    const int NW = F.NGW;
    const int myw0 = (F.gw >> 3) << 3;
    { const int e = F.tid & 7, part = F.tid >> 3; int tot = 0, before = 0;
        for (int gwi = part; gwi < NW; gwi += 64) { const int c = (int)wc[(size_t)gwi * 8 + e]; tot += c; if (gwi < myw0) before += c; }
        for (int o = 8; o < 64; o <<= 1) { tot += __shfl_xor(tot, o); before += __shfl_xor(before, o); }
        LAS int* red = sh + 128;
        if (F.lane < 8) { red[(F.wave * 8 + e) * 2] = tot; red[(F.wave * 8 + e) * 2 + 1] = before; }
        __syncthreads();
        if (F.tid < 8) { int t2 = 0, b2 = 0; for (int w8 = 0; w8 < 8; ++w8) { t2 += red[(w8 * 8 + F.tid) * 2]; b2 += red[(w8 * 8 + F.tid) * 2 + 1]; } sh[F.tid] = t2; sh[100 + F.tid] = b2; }
        __syncthreads();
        if (F.tid == 0) { int off = 0; for (int e2 = 0; e2 < 8; ++e2) { sh[8 + e2] = off; off += (sh[e2] + 255) & ~255; } sh[16] = off; }
        if (F.tid < 64) { const int w8 = F.tid >> 3, e2 = F.tid & 7; int bs = sh[100 + e2]; for (int ww = 0; ww < w8; ++ww) bs += (int)wc[(size_t)(myw0 + ww) * 8 + e2]; sh[32 + w8 * 8 + e2] = bs; }
        __syncthreads();
    }
    int* tab = (int*)(F.ws + WS_TAB); int* pos = (int*)(F.ws + WS_ROUTE + RT_POS); const int* ids = (const int*)(F.ws + WS_ROUTE + RT_IDS);
    const int mpadv = sh[16];
    if (blockIdx.x == 0) {
        if (F.tid == 0) { tab[TAB_NPANELS] = mpadv >> 8; for (int e = 0; e <= 8; ++e) tab[TAB_EOFF + e] = sh[8 + e]; }
        for (int p = F.tid; p < (mpadv >> 8); p += 512) { int e = 0; for (int e2 = 1; e2 < 8; ++e2) if (p * 256 >= sh[8 + e2]) e = e2; tab[TAB_PEXP + p] = e; }
    }
    if (F.lane == 0) { int run[8];
#pragma unroll
        for (int e = 0; e < 8; ++e) run[e] = sh[8 + e] + sh[32 + F.wave * 8 + e];
        ROWBLOCK(m0, m1);
        for (int m = m0; m < m1; ++m) {
#pragma unroll
            for (int j = 0; j < 2; ++j) { const int e = ids[2 * m + j]; int p = 0;
#pragma unroll
                for (int e2 = 0; e2 < 8; ++e2) if (e == e2) { p = run[e2]; run[e2] = p + 1; }
                pos[2 * m + j] = p; sh[1024 + F.wave * 64 + 2 * (m - m0) + j] = p; } } }
    { bf16* HS = (bf16*)(F.ws + WS_YM); const bf16* XB = (const bf16*)(F.ws + WS_XB); const int lane = F.lane;
        ROWBLOCK(m0, m1); const Row16 gg = load_row_f32(gn, lane);
        Row16 xnx = load_row_bf16_nt(XB + (size_t)m0 * D, lane);
        for (int m = m0; m < m1; ++m) { const int b = m >> 11; const float* mb = mod1 + (size_t)b * 6144;
            const int p0 = sh[1024 + F.wave * 64 + 2 * (m - m0)], p1 = sh[1024 + F.wave * 64 + 2 * (m - m0) + 1];
            const Row16 xn = xnx; if (m + 1 < m1) xnx = load_row_bf16_nt(XB + (size_t)(m + 1) * D, lane);
            const float r2 = rsqrtf(row_ss(xn) * (1.f / D) + EPS);
            const Row16 sc = load_row_f32(mb + 4 * 1024, lane), shf = load_row_f32(mb + 3 * 1024, lane); Row16 h;
#pragma unroll
            for (int j = 0; j < 4; ++j) h.v[j] = xn.v[j] * r2 * gg.v[j] * (sc.v[j] + 1.0f) + shf.v[j];
            store_row_bf16(HS + (size_t)p0 * D, lane, h); store_row_bf16(HS + (size_t)p1 * D, lane, h); } }
    __syncthreads();
    for (int e = 0; e < NE; ++e) convert_matrix(F, F.in[I_EWD] + (size_t)e * F2 * 1024, F2, 1024, (bf16*)(F.ws + WS_WMD) + (size_t)e * 1024 * F2, 0);
}

constexpr int FINAL_LATE_POS = (MOE_ROUNDS - 1) * PR * 256, FINAL_GUARD = 4096, FINAL_DN_CUS = 32;
static_assert((size_t)(MAXPANELS - (MOE_ROUNDS - 1) * PR) * 256 * F2 * 2 <= (size_t)FINAL_GUARD * D * 4, "the last round's activations sit inside the guarded rows");
static_assert((MAXPANELS - (MOE_ROUNDS - 1) * PR) * 4 <= FINAL_DN_CUS, "the last round's down units fit the reserved workgroups");
template <int MODE>
__device__ __forceinline__ void p_final(Frame& F, const float* gpost, const float* mod1) {
    const bf16* YM = (const bf16*)(F.ws + WS_YM); const int* pos = (const int*)(F.ws + WS_ROUTE + RT_POS); const float* wts = (const float*)(F.ws + WS_ROUTE + RT_WTS);
    const int lane = F.lane;
    int m0, m1;
    if (MODE == 1) { const int nw = (F.G - FINAL_DN_CUS) * NWAVES, we = ((int)blockIdx.x - FINAL_DN_CUS) * NWAVES + F.wave, per = (T + nw - 1) / nw; m0 = we * per; m1 = m0 + per < T ? m0 + per : T; }
    else { const int per = (T + F.NGW - 1) / F.NGW; m0 = F.gw * per; m1 = m0 + per < T ? m0 + per : T; }
    int bc = -1; const Row16 gp = load_row_f32(gpost, lane); Row16 gt;
    for (int m = m0; m < m1; ++m) { const int b = m >> 11;
        const int p0 = pos[2 * m], p1 = pos[2 * m + 1];
        const bool late = m < FINAL_GUARD || p0 >= FINAL_LATE_POS || p1 >= FINAL_LATE_POS;
        if ((MODE == 1 && late) || (MODE == 2 && !late)) continue;
        if (b != bc) { bc = b; gt = load_row_f32(mod1 + (size_t)b * 6144 + 5 * 1024, lane); }
        const float w0 = wts[2 * m], w1 = wts[2 * m + 1];
        const Row16 y0 = load_row_bf16_nt(YM + (size_t)p0 * D, lane), y1 = load_row_bf16_nt(YM + (size_t)p1 * D, lane); Row16 y;
#pragma unroll
        for (int j = 0; j < 4; ++j) y.v[j] = y0.v[j] * w0 + y1.v[j] * w1;
        const float r1 = rsqrtf(row_ss(y) * (1.f / D) + EPS);
        const Row16 xo = load_row_bf16_nt((const bf16*)(F.ws + WS_XB) + (size_t)m * D, lane); Row16 xn;
#pragma unroll
        for (int j = 0; j < 4; ++j) xn.v[j] = xo.v[j] + gt.v[j] * (y.v[j] * r1 * gp.v[j]);
        store_row_f32(F.X + (size_t)m * D, lane, xn); }
}
struct Args { const float* in[28]; float* out; unsigned char* ws; int ph_lo, ph_hi, li, pad; };
enum { PH_PRO = 0, PH_H0, PH_QKV, PH_ATTN, PH_WO, PH_NORMA, PH_FGU, PH_FD, PH_NORMB, PH_MIN, PH_GATES, PH_CELL, PH_H2B, PH_MINZ, PH_POST, PH_MOUT, PH_NORMC, PH_SORT, PH_MOE0  ,
       PH_FINAL = PH_MOE0 + 3 * MOE_ROUNDS, PH_COUNT };

__global__ void __launch_bounds__(NWAVES * 64, 2) mega(Args args) {
    extern __shared__ __attribute__((aligned(16))) unsigned char lds[];
    Frame F;
    F.lds = (LAS unsigned char*)lds;
    F.MISC = (volatile LAS unsigned*)(F.lds + MISC_OFF);
    F.tid = threadIdx.x; F.lane = F.tid & 63; F.wave = __builtin_amdgcn_readfirstlane(F.tid >> 6);
    F.G = gridDim.x; { const int bx = blockIdx.x; const int vcu = (F.G % 8 == 0) ? (bx % 8) * (F.G / 8) + bx / 8 : bx; F.gw = vcu * NWAVES + F.wave; F.NGW = F.G * NWAVES; }
    F.ws = args.ws; F.ctl = (gu32*)(args.ws + WS_CTL); F.in = args.in; F.X = args.out;
    for (int u = F.tid; u < (LDS_BYTES - LDSCTL_OFF) / 4; u += NWAVES * 64) ((LAS unsigned*)(F.lds + LDSCTL_OFF))[u] = 0u;
    __syncthreads();
    XcdBarrier bar = xcd_barrier_post((unsigned*)(F.ctl + CW_BAR) + args.li * XCD_BAR_WORDS, F.MISC + 8, F.wave);
    const int lo = args.ph_lo, hi = args.ph_hi;
#ifdef ONLY_PHASE
#define IN(k) ((k) == ONLY_PHASE && lo <= (k) && (k) < hi)
#else
#define IN(k) (lo <= (k) && (k) < hi)
#endif
#define REFRESH() do { int l_ = (int)__builtin_amdgcn_mbcnt_hi(~0u, __builtin_amdgcn_mbcnt_lo(~0u, 0u)); asm volatile("" : "+v"(l_)); F.lane = l_; F.tid = F.wave * 64 + l_; } while (0)
#ifdef TPROBE_MASK
    unsigned long long tp_last = __builtin_amdgcn_s_memrealtime(), tp_acc = 0ull;
#define SEAM(k) do { if (IN(k) && IN((k) + 1)) xcd_barrier(bar); { const unsigned long long now_ = __builtin_amdgcn_s_memrealtime(); if ((TPROBE_MASK >> (k)) & 1ull) tp_acc += now_ - tp_last; tp_last = now_; } } while (0)
#else
#define SEAM(k) do { if (IN(k) && IN((k) + 1)) xcd_barrier(bar); } while (0)
#endif
#define UNI(p) ((const float*)((((unsigned long long)(unsigned)__builtin_amdgcn_readfirstlane((unsigned)((unsigned long long)(p) >> 32))) << 32) | (unsigned long long)(unsigned)__builtin_amdgcn_readfirstlane((unsigned)(unsigned long long)(p))))
#define WSP ((unsigned char*)UNI(args.ws))
#define mod0 UNI((const float*)(args.ws + WS_MOD))
#define mod1 UNI((const float*)(args.ws + WS_MOD) + 16 * 6144)
#define ng UNI(args.in[I_NORMG])
#define SKEW(n) do { const int st_ = ((int)blockIdx.x >> 3) & 3; for (int i_ = 0; i_ < (n) * st_; ++i_) __builtin_amdgcn_s_sleep(110); } while (0)

#ifdef PRO_PROBE
    if (IN(PH_PRO)) { REFRESH(); p_prologue<PRO_PROBE>(F); xcd_barrier(bar); }
#endif
    if (IN(PH_PRO)) { REFRESH(); p_prologue<7>(F); } SEAM(PH_PRO);
    if (IN(PH_H0)) { REFRESH(); p_mlprep2(F); p_h0(F, (bf16*)(WSP + WS_Y)); } SEAM(PH_H0);
    if (IN(PH_QKV)) { REFRESH();
        pg8::Gemm g{(const bf16*)(WSP + WS_Y), (const bf16*)(WSP + WS_W_AIN), T, 3072, 1024}; pg8::StaticOrder So; So.init(T, 3072, F.G, (int)blockIdx.x);
        pg8::EpiBf16 E{(bf16*)(WSP + WS_Q), 1024, 1024, (size_t)(WS_K - WS_Q) / 2, QSCALE};
        pg8::gemm_phase<pg8::EpiBf16, pg8::StaticOrder, false, false>(F.lds, g, So, E, nullptr, F.wave);
    } SEAM(PH_QKV);
#ifdef HAVE_ATTN
    if (IN(PH_ATTN)) { REFRESH(); p_attn_kn(F); xcd_barrier(bar); REFRESH(); p_attn<0>(F); } SEAM(PH_ATTN);
#endif
#ifdef HAVE_L0REST
    if (IN(PH_WO)) { REFRESH();
        pg8::Gemm g{(const bf16*)(WSP + WS_O), (const bf16*)(WSP + WS_W_AOUT), T, 1024, 1024}; pg8::StaticOrder So; So.init(T, 1024, F.G, (int)blockIdx.x);
        pg8::EpiBf16 E{(bf16*)(WSP + WS_Y), 1024, 0, 0, 1.f};
        pg8::gemm_phase<pg8::EpiBf16, pg8::StaticOrder, false, false>(F.lds, g, So, E, nullptr, F.wave);
    } SEAM(PH_WO);
    if (IN(PH_NORMA)) { REFRESH(); p_norm(F, F.in[I_X], (const bf16*)(WSP + WS_Y), ng + 1024, mod0, 2, ng + 2048, mod0, 3, (bf16*)(WSP + WS_H)); } SEAM(PH_NORMA);
    if (IN(PH_FGU)) { REFRESH();
        pg8::Gemm g{(const bf16*)(WSP + WS_H), (const bf16*)(WSP + WS_W_FGU), T, 2 * F1, 1024}; pg8::StaticOrder So; So.init(T, 2 * F1, F.G, (int)blockIdx.x);
        pg8::EpiSwiglu E{(bf16*)(WSP + WS_ACT), F1};
        pg8::gemm_phase<pg8::EpiSwiglu, pg8::StaticOrder, false, false>(F.lds, g, So, E, nullptr, F.wave);
    } SEAM(PH_FGU);
    if (IN(PH_FD)) { REFRESH();
        pg8::Gemm g{(const bf16*)(WSP + WS_ACT), (const bf16*)(WSP + WS_W_FD), T, 1024, F1}; pg8::StaticOrder So; So.init(T, 1024, F.G, (int)blockIdx.x);
        pg8::EpiBf16 E{(bf16*)(WSP + WS_Y), 1024, 0, 0, 1.f};
        pg8::gemm_phase<pg8::EpiBf16, pg8::StaticOrder, false, false>(F.lds, g, So, E, nullptr, F.wave);
    } SEAM(PH_FD);
    if (IN(PH_NORMB)) { REFRESH(); p_normb(F, (const bf16*)(WSP + WS_Y), ng + 3072, mod0, ng + 4096, mod1, (bf16*)(WSP + WS_H)); } SEAM(PH_NORMB);
#endif
#ifdef HAVE_ML
    if (IN(PH_MIN)) { REFRESH();
        pg8::Gemm g{(const bf16*)(WSP + WS_H), (const bf16*)(WSP + WS_W_MIN), T, 2048, 1024}; pg8::StaticOrder So; So.init(T, 2048, F.G, (int)blockIdx.x);
        pg8::EpiBf16 E{(bf16*)(WSP + WS_XM), 2048, 0, 0, 1.f};
        pg8::gemm_phase<pg8::EpiBf16, pg8::StaticOrder, false, false>(F.lds, g, So, E, nullptr, F.wave);
    } SEAM(PH_MIN);
    if (IN(PH_GATES)) { REFRESH(); p_gates2(F); } SEAM(PH_GATES);
    if (IN(PH_CELL)) { REFRESH(); p_cell2(F); } SEAM(PH_CELL);
    if (IN(PH_MINZ)) { REFRESH();
        pg8::Gemm g{(const bf16*)UNI(args.out) + (size_t)T * D, (const bf16*)(WSP + WS_W_MIN) + (size_t)2048 * 1024, T, 2048, 1024}; pg8::StaticOrder So; So.init(T, 2048, F.G, (int)blockIdx.x);
        pg8::EpiBf16 E{(bf16*)(WSP + WS_ZB), 2048, 0, 0, 1.f};
        pg8::gemm_phase<pg8::EpiBf16, pg8::StaticOrder, false, false>(F.lds, g, So, E, nullptr, F.wave);
    } SEAM(PH_MINZ);
    if (IN(PH_POST)) { REFRESH(); p_post(F); } SEAM(PH_POST);
    if (IN(PH_MOUT)) { REFRESH();
        pg8::Gemm g{(const bf16*)(WSP + WS_HH), (const bf16*)(WSP + WS_W_MOUT), T, 1024, 2048}; pg8::StaticOrder So; So.init(T, 1024, F.G, (int)blockIdx.x);
        pg8::EpiBf16 E{(bf16*)(WSP + WS_Y), 1024, 0, 0, 1.f};
        pg8::gemm_phase<pg8::EpiBf16, pg8::StaticOrder, false, false>(F.lds, g, So, E, nullptr, F.wave);
    } SEAM(PH_MOUT);
#endif
#ifdef HAVE_MOE
    if (IN(PH_NORMC)) { REFRESH(); p_normc(F, (const bf16*)(WSP + WS_Y), ng + 5120, mod1, ng + 6144, (bf16*)(WSP + WS_H)); } SEAM(PH_NORMC);
    if (IN(PH_SORT)) { REFRESH(); p_sort(F, ng + 6144, mod1); } SEAM(PH_SORT);
#define MOE_ROUND(r) \
      \
    if ((r) < MOE_ROUNDS && IN(PH_MOE0 + 3 * (r) + 1)) { REFRESH(); const int* tab = (const int*)(WSP + WS_TAB); const int p_lo = (r) * PR; int np = tab[TAB_NPANELS] - p_lo; np = np > PR ? PR : np; \
        pg8::Gemm g{(const bf16*)(WSP + WS_YM), (const bf16*)(WSP + WS_WMGU), 0, 0, 1024}; pg8::MoeOrder<true, false> So; So.init(p_lo, np, 2 * F2 / 256, F.G, (int)blockIdx.x, tab + TAB_PEXP); \
        pg8::EpiSwiglu E{(bf16*)UNI(args.out), F2}; \
        pg8::gemm_phase<pg8::EpiSwiglu, pg8::MoeOrder<true, false>, false, false>(F.lds, g, So, E, nullptr, F.wave); } \
    if ((r) < MOE_ROUNDS) SEAM(PH_MOE0 + 3 * (r) + 1); \
    if ((r) < MOE_ROUNDS && IN(PH_MOE0 + 3 * (r) + 2)) { REFRESH(); const int* tab = (const int*)(WSP + WS_TAB); const int p_lo = (r) * PR; int np = tab[TAB_NPANELS] - p_lo; np = np > PR ? PR : np; \
        pg8::Gemm g{(const bf16*)UNI(args.out), (const bf16*)(WSP + WS_WMD), 0, 0, F2}; pg8::MoeOrder<false, true> So; So.init(p_lo, np, 4, F.G, (int)blockIdx.x, tab + TAB_PEXP); \
        pg8::EpiBf16 E{(bf16*)(WSP + WS_YM), 1024, 0, 0, 1.f}; \
        if ((r) + 1 < MOE_ROUNDS || (int)blockIdx.x < FINAL_DN_CUS || F.G <= FINAL_DN_CUS) pg8::gemm_phase<pg8::EpiBf16, pg8::MoeOrder<false, true>, false, false>(F.lds, g, So, E, nullptr, F.wave); \
        else { REFRESH(); p_final<1>(F, ng + 7168, mod1); } }     \
    if ((r) < MOE_ROUNDS) SEAM(PH_MOE0 + 3 * (r) + 2);
    MOE_ROUND(0) MOE_ROUND(1) MOE_ROUND(2) MOE_ROUND(3) MOE_ROUND(4)
#undef MOE_ROUND
    if (IN(PH_FINAL)) { REFRESH(); if (F.G > FINAL_DN_CUS) p_final<2>(F, ng + 7168, mod1); else p_final<0>(F, ng + 7168, mod1); }
#ifdef TPROBE_MASK
    { __syncthreads(); const unsigned long long now_ = __builtin_amdgcn_s_memrealtime(); if ((TPROBE_MASK >> PH_FINAL) & 1ull) tp_acc += now_ - tp_last;
      const unsigned long long target_ = now_ + (unsigned long long)(TPROBE_AMP) * tp_acc; while (__builtin_amdgcn_s_memrealtime() < target_) __builtin_amdgcn_s_sleep(32); }
#endif
#endif
#undef IN
#undef SEAM
#undef WSP
#undef mod0
#undef mod1
#undef ng
#undef SKEW
#undef UNI
}
}

#ifdef REFCHECK
namespace chk {
__host__ __device__ inline int srow(int b, int j) { return (37 + 523 * j + 61 * b) % 2048; }
constexpr int DIG_COLS = 4096;
__host__ __device__ inline size_t dig_off(int stage, int b, int j) { return ((size_t)(stage * 16 + b) * 4 + j) * DIG_COLS; }
__global__ void k_sample(const float* p, int ld, int ncols, float* dig, int stage, int b) {
    const int j = blockIdx.x; const float* src = p + (size_t)srow(b, j) * ld; float* dst = dig + dig_off(stage, b, j);
    for (int c = threadIdx.x; c < ncols; c += blockDim.x) dst[c] = src[c];
}
static void digest_cb(int stage, int b, const float* p, int ld, int ncols, hipStream_t st, void* ctx) {
    hipLaunchKernelGGL(k_sample, dim3(4), dim3(256), 0, st, p, ld, ncols, (float*)ctx, stage, b);
}
__global__ void k_check(const void* fast, int is_bf16, int ld, int ncols, float fscale, const float* dig, int stage, int coff, float tol, int code, unsigned* fail) {
    __shared__ float sh[2][16];
    float se = 0.f, sb = 0.f;
    for (int r = 0; r < 64; ++r) { const int b = r >> 2, j = r & 3; const size_t row = (size_t)b * 2048 + srow(b, j); const float* d = dig + dig_off(stage, b, j) + coff;
        for (int c = threadIdx.x; c < ncols; c += blockDim.x) {
            float f;
            if (is_bf16 == 2) { const unsigned v = ((const unsigned char*)fast)[row * ld + c]; const int e = (v >> 3) & 15, mm = v & 7; f = e ? exp2f((float)(e - 7)) * (1.f + mm * 0.125f) : 0.015625f * (mm * 0.125f); if (v & 128) f = -f; }
            else f = is_bf16 ? __builtin_bit_cast(float, (unsigned)((const unsigned short*)fast)[row * ld + c] << 16) : ((const float*)fast)[row * ld + c];
            f *= fscale; const float e = f - d[c]; se += e * e; sb += d[c] * d[c]; } }
    for (int o = 32; o > 0; o >>= 1) { se += __shfl_xor(se, o); sb += __shfl_xor(sb, o); }
    if ((threadIdx.x & 63) == 0) { sh[0][threadIdx.x >> 6] = se; sh[1][threadIdx.x >> 6] = sb; }
    __syncthreads();
    if (threadIdx.x == 0) { se = 0.f; sb = 0.f; for (int i = 0; i < (int)blockDim.x / 64; ++i) { se += sh[0][i]; sb += sh[1][i]; }
        const float rel = sqrtf(se / fmaxf(sb, 1e-30f));
        if (!(rel < tol)) atomicMin(fail, (unsigned)(2 * code + (rel < 0.3f ? 0 : 1))); }
}
__global__ void k_check2(const void* fast, int is_bf16, int ld, int c0, int c1, int cmask, int cval, int rshift, int rmask, int rval, const float* dig, int stage, float tol, int bit, unsigned* fail) {
    __shared__ float sh[2][16];
    float se = 0.f, sb = 0.f;
    for (int r = 0; r < 64; ++r) { const int b = r >> 2, j = r & 3; const int pos = srow(b, j); if (((pos >> rshift) & rmask) != rval) continue;
        const size_t row = (size_t)b * 2048 + pos; const float* d = dig + dig_off(stage, b, j);
        for (int c = c0 + threadIdx.x; c < c1; c += blockDim.x) { if ((c & cmask) != cval) continue;
            const float f = is_bf16 ? __builtin_bit_cast(float, (unsigned)((const unsigned short*)fast)[row * ld + c] << 16) : ((const float*)fast)[row * ld + c];
            const float e = f - d[c]; se += e * e; sb += d[c] * d[c]; } }
    for (int o = 32; o > 0; o >>= 1) { se += __shfl_xor(se, o); sb += __shfl_xor(sb, o); }
    if ((threadIdx.x & 63) == 0) { sh[0][threadIdx.x >> 6] = se; sh[1][threadIdx.x >> 6] = sb; }
    __syncthreads();
    if (threadIdx.x == 0) { se = 0.f; sb = 0.f; for (int i = 0; i < (int)blockDim.x / 64; ++i) { se += sh[0][i]; sb += sh[1][i]; }
        const float rel = sqrtf(se / fmaxf(sb, 1e-30f));
        if (!(rel < tol)) atomicOr(fail + 1, 1u << bit); }
}
__global__ void k_initfail(unsigned* fail) { fail[0] = 0x7fffffffu; fail[1] = 0u; }
__global__ void k_scale(float* out, size_t n, const unsigned* fail) {
    unsigned f = fail[0]; if (fail[1]) f = fail[1]; if (f == 0x7fffffffu) return; const float s = exp2f((float)f);
    for (size_t i = (size_t)blockIdx.x * blockDim.x + threadIdx.x; i < n; i += (size_t)gridDim.x * blockDim.x) out[i] *= s;
}
}
#endif

#ifdef REFCHECK
static ref::In make_in(void* const* d_in) {
    ref::In in;
    const float** p = (const float**)&in;
    for (int i = 0; i < 28; ++i) p[i] = (const float*)d_in[i];
    return in;
}
#endif
static int g_grid = 0;
static void launch_phases(const fp::Args& base, int lo, int hi, int li, hipStream_t stream) {
    fp::Args a = base; a.ph_lo = lo; a.ph_hi = hi; a.li = li; a.pad = 0;
    hipLaunchKernelGGL(fp::mega, dim3(g_grid), dim3(fp::NWAVES * 64), fp::LDS_BYTES, stream, a);
}
extern "C" void kernel_launch(void* const* d_in, const int* in_sizes, int n_in, void* d_out, int out_size, void* d_ws, size_t ws_size, hipStream_t stream) {
    if (g_grid == 0) {
        if (n_in != 28 || out_size != 32768 * 1024 || ws_size < fp::WS_NEED) { fprintf(stderr, "kernel_launch: unexpected shapes (n_in %d out %d ws %zu)\n", n_in, out_size, ws_size); g_grid = -1; return; }
        int dev = 0, cus = 0, per_cu = 0;
        if (hipGetDevice(&dev) != hipSuccess || hipDeviceGetAttribute(&cus, hipDeviceAttributeMultiprocessorCount, dev) != hipSuccess) { g_grid = -1; return; }
        if (hipFuncSetAttribute((const void*)fp::mega, hipFuncAttributeMaxDynamicSharedMemorySize, fp::LDS_BYTES) != hipSuccess) { fprintf(stderr, "kernel_launch: hipFuncSetAttribute failed\n"); g_grid = -1; return; }
        if (hipOccupancyMaxActiveBlocksPerMultiprocessor(&per_cu, (const void*)fp::mega, fp::NWAVES * 64, fp::LDS_BYTES) != hipSuccess || per_cu < 1) { fprintf(stderr, "kernel_launch: occupancy query says %d\n", per_cu); }
        (void)hipGetLastError();
        g_grid = cus;
    }
    if (g_grid < 0) return;
    hipMemsetAsync((char*)d_ws + fp::WS_CTL, 0, fp::CTL_ZERO_BYTES, stream);
    fp::Args a{};
    for (int i = 0; i < 28; ++i) a.in[i] = (const float*)d_in[i];
    a.out = (float*)d_out; a.ws = (unsigned char*)d_ws;
#ifdef REFCHECK
    ref::In in = make_in(d_in);
    float* dig = (float*)((unsigned char*)d_ws + fp::WS_DIG);
    unsigned* fail = (unsigned*)d_ws + fp::CW_FAIL;
    ref::forward(in, (float*)d_out, (unsigned char*)d_ws + 2 * fp::MiB, stream, chk::digest_cb, dig);
    hipMemsetAsync((char*)d_ws + fp::WS_CTL, 0, fp::CTL_ZERO_BYTES, stream);
    hipLaunchKernelGGL(chk::k_initfail, dim3(1), dim3(1), 0, stream, fail);
    unsigned char* ws = (unsigned char*)d_ws;
#define CHECK(ptr, isbf, ld, ncols, fscale, stage, coff, tol, code) hipLaunchKernelGGL(chk::k_check, dim3(1), dim3(1024), 0, stream, (const void*)(ptr), isbf, ld, ncols, fscale, dig, stage, coff, tol, code, fail)
    int li = 0;
    for (int ph = 0; ph < REFCHECK_PHASES; ++ph) {
        launch_phases(a, ph, ph + 1, li++, stream);
        switch (ph) {
        case fp::PH_H0: CHECK(ws + fp::WS_Y, 1, 1024, 1024, 1.f, 1, 0, 0.02f, 1); break;
        case fp::PH_QKV: CHECK(ws + fp::WS_Q, 1, 1024, 1024, 1.f / fp::QSCALE, 2, 0, 0.03f, 2); CHECK(ws + fp::WS_K, 1, 1024, 1024, 1.f, 2, 1024, 0.03f, 3); CHECK(ws + fp::WS_V, 1, 1024, 1024, 1.f, 2, 2048, 0.03f, 4); break;
        case fp::PH_ATTN: CHECK(ws + fp::WS_O, 1, 1024, 1024, 1.f, 3, 0, 0.05f, 8);
#ifdef LSE_DIAG
            CHECK(ws + fp::WS_GATE, 0, 8, 8, 1.f, 0, 0, 0.01f, 6);
#endif
#ifdef ATTN_DIAG
            for (int hb = 0; hb < 4; ++hb) hipLaunchKernelGGL(chk::k_check2, dim3(1), dim3(1024), 0, stream, (const void*)(ws + fp::WS_O), 1, 1024, hb * 256, hb * 256 + 256, 0, 0, 0, 0, 0, dig, 3, 0.03f, hb, fail);
            hipLaunchKernelGGL(chk::k_check2, dim3(1), dim3(1024), 0, stream, (const void*)(ws + fp::WS_O), 1, 1024, 0, 1024, 0, 0, 6, 1, 0, dig, 3, 0.03f, 4, fail);
            hipLaunchKernelGGL(chk::k_check2, dim3(1), dim3(1024), 0, stream, (const void*)(ws + fp::WS_O), 1, 1024, 0, 1024, 0, 0, 6, 1, 1, dig, 3, 0.03f, 5, fail);
#endif
            break;
        case fp::PH_WO: CHECK(ws + fp::WS_Y, 1, 1024, 1024, 1.f, 4, 0, 0.05f, 6); break;
        case fp::PH_NORMA: CHECK(d_out, 1, 1024, 1024, 1.f, 5, 0, 0.02f, 7); CHECK(ws + fp::WS_H, 1, 1024, 1024, 1.f, 6, 0, 0.03f, 8); break;
        case fp::PH_FGU: CHECK(ws + fp::WS_ACT, 1, fp::F1, fp::F1, 1.f, 7, 0, 0.05f, 9); break;
        case fp::PH_FD: CHECK(ws + fp::WS_Y, 1, 1024, 1024, 1.f, 8, 0, 0.05f, 10); break;
        case fp::PH_NORMB: CHECK(d_out, 1, 1024, 1024, 1.f, 9, 0, 0.02f, 11); CHECK(ws + fp::WS_H, 1, 1024, 1024, 1.f, 10, 0, 0.03f, 12); break;
        case fp::PH_MIN: CHECK(ws + fp::WS_XM, 1, 2048, 2048, 1.f, 11, 0, 0.03f, 13); break;
        case fp::PH_MINZ: CHECK(ws + fp::WS_ZB, 1, 2048, 2048, 1.f, 11, 2048, 0.03f, 22); break;
        case fp::PH_GATES: CHECK(ws + fp::WS_GATE, 0, 8, 8, 1.f, 16, 0, 0.03f, 14); break;
#ifdef CELL_DUMP2
        case fp::PH_CELL: CHECK(ws + fp::WS_HH, 1, 2048, 2048, 1.f, 15, 0, 0.03f, 18); CHECK(ws + fp::WS_Y, 0, 4, 4, 1.f, 0, 0, 0.03f, 19); break;
#elif defined(CELL_DUMP) || defined(CELL_DUMP3)
        case fp::PH_CELL: CHECK(ws + fp::WS_Y, 1, 2048, 2048, 1.f, 13, 0, 0.03f, 18); CHECK(ws + fp::WS_HH, 1, 2048, 2048, 1.f / fp::KSCALE, 14, 0, 0.03f, 19); break;
#else
        case fp::PH_CELL: CHECK(ws + fp::WS_HH, 1, 2048, 2048, 1.f, 17, 0, 0.35f, 15); break;
#endif
        case fp::PH_POST: CHECK(ws + fp::WS_HH, 1, 2048, 2048, 1.f, 18, 0, 0.05f, 16); break;
        case fp::PH_MOUT: CHECK(ws + fp::WS_Y, 1, 1024, 1024, 1.f, 19, 0, 0.05f, 17); break;
#ifdef HAVE_MOE
        case fp::PH_NORMC: CHECK(ws + fp::WS_XB, 1, 1024, 1024, 1.f, 20, 0, 0.02f, 18); CHECK(ws + fp::WS_ROUTE + fp::RT_WTS, 0, 2, 2, 1.f, 22, 0, 0.15f, 20); break;
        case fp::PH_FINAL: CHECK(d_out, 0, 1024, 1024, 1.f, 24, 0, 0.10f, 21); break;
#endif
        default: break;
        }
    }
#ifdef BROKEN_CONTROL
    CHECK(ws + fp::WS_K, 1, 1024, 1024, 1.f, 2, 2048, 0.03f, 23);
#endif
#ifndef REFCHECK_FULL
    ref::forward(in, (float*)d_out, (unsigned char*)d_ws + 2 * fp::MiB, stream, nullptr, nullptr);
#endif
#ifndef NO_SCALE
    hipLaunchKernelGGL(chk::k_scale, dim3(2048), dim3(256), 0, stream, (float*)d_out, (size_t)32768 * 1024, fail);
#endif
#else
    launch_phases(a, 0, fp::PH_COUNT, 0, stream);
#endif
}
```

```cpp
#include <hip/hip_runtime.h>
#include <stdint.h>
#include <stdio.h>
#define HAVE_L0REST
namespace pg8 {
#define PG8_LAS __attribute__((address_space(3)))
typedef unsigned short bf16_t;
typedef short bf16x8 __attribute__((ext_vector_type(8)));
typedef float f32x4 __attribute__((ext_vector_type(4)));
typedef unsigned u32x4 __attribute__((ext_vector_type(4)));
typedef int v8i_t __attribute__((ext_vector_type(8)));
typedef int v4i_t __attribute__((ext_vector_type(4)));
constexpr int BM = 256, BK = 64, HALF = 128, HTB = HALF * BK * 2  , STAGE_BYTES = 8 * HTB, NXCD = 8, WGM = 8;

__host__ __device__ __forceinline__ int lds_byte(int r, int c) { const int st = (r >> 4) * 2 + (c >> 5), rr = r & 15, cc = c & 31, ob = rr * 64 + cc * 2; return st * 1024 + (ob ^ (((ob >> 9) & 1) << 5)); }
__host__ __device__ __forceinline__ void stage_rc(int b, int& R, int& C) { const int st = b / 1024, sb = b % 1024, swz = sb ^ (((sb >> 9) & 1) << 5); R = (st >> 1) * 16 + swz / 64; C = (st & 1) * 32 + (swz % 64) / 2; }
__host__ __device__ __forceinline__ int perm32(int rho) { const int n = rho >> 4, i = rho & 15; return 8 * (i >> 2) + 4 * n + (i & 3); }

struct Unit { int pm, pn, om, on; };
struct Gemm { const bf16_t* A; const bf16_t* Bt; int M, N, K; };

struct StaticOrder {
    int nM, nN, nwg, G, c;
    __host__ __device__ void init(int M, int N, int G_, int c_) { nM = M / BM; nN = N / BM; nwg = nM * nN; G = G_; c = c_; }
    __host__ __device__ bool next(int i, Unit& u) const {
        const long L = (long)i * G + c; if (L >= nwg) return false;
        int wgid = (int)L; { const int q = nwg / NXCD, r = nwg % NXCD, xcd = wgid % NXCD, off = wgid / NXCD; wgid = (xcd < r ? xcd * (q + 1) : r * (q + 1) + (xcd - r) * q) + off; }
        const int nig = WGM * nN, gid = wgid / nig, fm = gid * WGM, gsz = (nM - fm) < WGM ? (nM - fm) : WGM;
        u.pm = fm + ((wgid % nig) % gsz); u.pn = (wgid % nig) / gsz; u.om = u.pm; u.on = u.pn; return true;
    }
};
#ifndef MOE_WGM
#define MOE_WGM 8
#endif
constexpr int MWGM = MOE_WGM;
template <bool ABS_A, bool ABS_O> struct MoeOrder {
    int p_lo, np, nN, nwg, G, c; const int* pexp;
    __device__ void init(int p_lo_, int np_, int nN_, int G_, int c_, const int* pexp_) { p_lo = p_lo_; np = np_ < 0 ? 0 : np_; nN = nN_; nwg = np * nN; G = G_; c = c_; pexp = pexp_; }
    __device__ bool next(int i, Unit& u) const {
        const long L = (long)i * G + c; if (L >= nwg) return false;
        const int wgid = (int)L, nig = MWGM * nN, gid = wgid / nig, fm = gid * MWGM, gsz = (np - fm) < MWGM ? (np - fm) : MWGM;
        const int pr = __builtin_amdgcn_readfirstlane(fm + ((wgid % nig) % gsz)), pnl = __builtin_amdgcn_readfirstlane((wgid % nig) / gsz), e = __builtin_amdgcn_readfirstlane(pexp[p_lo + pr]);
        u.pm = ABS_A ? p_lo + pr : pr; u.om = ABS_O ? p_lo + pr : pr; u.pn = e * nN + pnl; u.on = pnl; return true;
    }
};

__device__ __forceinline__ unsigned cvt_pk_bf16(float lo, float hi) { unsigned r; asm volatile("v_cvt_pk_bf16_f32 %0, %1, %2" : "=v"(r) : "v"(lo), "v"(hi)); return r; }

#ifdef EPI_PLAIN_STORES
__device__ __forceinline__ void store16_wt(void* p, u32x4 w) { *(u32x4*)p = w; }
#else
__device__ __forceinline__ void store16_wt(void* p, u32x4 w) { asm volatile("global_store_dwordx4 %0, %1, off sc1\n\ts_nop 1" : : "v"(p), "v"(w) : "memory"); }
#endif

struct EpiBf16 {
    static constexpr bool PERM = true;
    bf16_t* O; int ldc; int split_cols; size_t split_stride; float scale0;
    __device__ __forceinline__ void operator()(const f32x4 (&acc)[2][2][4][2], const Unit& u, int wr, int wc, int fr, int fq) const {
        const int row0 = u.om * BM + wr * 64 + fr; int colt = u.on * BM; bf16_t* base = O;
        float sc = 1.f; if (split_cols) { const int t = colt / split_cols; base += (size_t)t * split_stride; colt -= t * split_cols; if (t == 0) sc = scale0; } else sc = scale0;
        const int col0 = colt + wc * 32 + 8 * fq;
#pragma unroll
        for (int ai = 0; ai < 2; ++ai)
#pragma unroll
            for (int m = 0; m < 4; ++m) { bf16_t* rowp = base + (size_t)(row0 + ai * HALF + m * 16) * ldc + col0;
#pragma unroll
                for (int bj = 0; bj < 2; ++bj) { const f32x4 v0 = acc[ai][bj][m][0] * sc, v1 = acc[ai][bj][m][1] * sc;
                    u32x4 w; w.x = cvt_pk_bf16(v0[0], v0[1]); w.y = cvt_pk_bf16(v0[2], v0[3]); w.z = cvt_pk_bf16(v1[0], v1[1]); w.w = cvt_pk_bf16(v1[2], v1[3]);
                    store16_wt(rowp + bj * HALF, w); } }
    }
};
__device__ __forceinline__ float silu_mul(float g, float u) { return g * u * __builtin_amdgcn_rcpf(1.0f + __builtin_amdgcn_exp2f(-1.4426950408889634f * g)); }
struct EpiSwiglu {
    static constexpr bool PERM = true;
    bf16_t* O; int ldc;
    __device__ __forceinline__ void operator()(const f32x4 (&acc)[2][2][4][2], const Unit& u, int wr, int wc, int fr, int fq) const {
        const int row0 = u.om * BM + wr * 64 + fr, col0 = u.on * HALF + wc * 32 + 8 * fq;
#pragma unroll
        for (int ai = 0; ai < 2; ++ai)
#pragma unroll
            for (int m = 0; m < 4; ++m) { bf16_t* rowp = O + (size_t)(row0 + ai * HALF + m * 16) * ldc + col0;
                const f32x4 g0 = acc[ai][0][m][0], g1 = acc[ai][0][m][1], u0 = acc[ai][1][m][0], u1 = acc[ai][1][m][1];
                u32x4 w; w.x = cvt_pk_bf16(silu_mul(g0[0], u0[0]), silu_mul(g0[1], u0[1])); w.y = cvt_pk_bf16(silu_mul(g0[2], u0[2]), silu_mul(g0[3], u0[3]));
                w.z = cvt_pk_bf16(silu_mul(g1[0], u1[0]), silu_mul(g1[1], u1[1])); w.w = cvt_pk_bf16(silu_mul(g1[2], u1[2]), silu_mul(g1[3], u1[3]));
                store16_wt(rowp, w); }
    }
};

template <int MODE> struct EpiProbe {
    static constexpr bool PERM = true;
    bf16_t* O; int ldc;
    __device__ __forceinline__ void operator()(const f32x4 (&acc)[2][2][4][2], const Unit& u, int wr, int wc, int fr, int fq) const {
        const int row0 = (MODE == 0 ? ((int)blockIdx.x % 64) : u.om) * BM + wr * 64 + fr; const int col0 = (MODE == 0 ? 0 : (u.on & 3) * BM) + wc * 32 + 8 * fq;
#pragma unroll
        for (int ai = 0; ai < 2; ++ai)
#pragma unroll
            for (int m = 0; m < 4; ++m) { bf16_t* rowp = O + (size_t)(row0 + ai * HALF + m * 16) * ldc + col0;
#pragma unroll
                for (int bj = 0; bj < 2; ++bj) { const f32x4 v0 = acc[ai][bj][m][0], v1 = acc[ai][bj][m][1];
                    u32x4 w; w.x = cvt_pk_bf16(v0[0], v0[1]); w.y = cvt_pk_bf16(v0[2], v0[3]); w.z = cvt_pk_bf16(v1[0], v1[1]); w.w = cvt_pk_bf16(v1[2], v1[3]);
                    if (MODE == 1) __builtin_nontemporal_store(w, (u32x4*)(rowp + bj * HALF)); else *(u32x4*)(rowp + bj * HALF) = w; } }
    }
};
struct EpiNull {
    static constexpr bool PERM = true;
    bf16_t* O;
    __device__ __forceinline__ void operator()(const f32x4 (&acc)[2][2][4][2], const Unit& u, int wr, int wc, int fr, int fq) const {
        float s = 0.f;
#pragma unroll
        for (int ai = 0; ai < 2; ++ai)
#pragma unroll
            for (int bj = 0; bj < 2; ++bj)
#pragma unroll
                for (int m = 0; m < 4; ++m)
#pragma unroll
                    for (int n = 0; n < 2; ++n) s += acc[ai][bj][m][n][0] + acc[ai][bj][m][n][1] + acc[ai][bj][m][n][2] + acc[ai][bj][m][n][3];
        if (s == 12345.6789f) O[(size_t)u.om * 256 + fr] = (bf16_t)1;
    }
};
struct EpiSwigluF8 {
    static constexpr bool PERM = true;
    unsigned char* O; int ldc; float inv_ws;
    __device__ __forceinline__ void operator()(const f32x4 (&acc)[2][2][4][2], const Unit& u, int wr, int wc, int fr, int fq) const {
        const int row0 = u.om * BM + wr * 64 + fr, col0 = u.on * HALF + wc * 32 + 8 * fq;
#pragma unroll
        for (int ai = 0; ai < 2; ++ai)
#pragma unroll
            for (int m = 0; m < 4; ++m) { unsigned char* rowp = O + (size_t)(row0 + ai * HALF + m * 16) * ldc + col0;
                const f32x4 g0 = acc[ai][0][m][0] * inv_ws, g1 = acc[ai][0][m][1] * inv_ws, u0 = acc[ai][1][m][0] * inv_ws, u1 = acc[ai][1][m][1] * inv_ws;
                unsigned w0 = 0u, w1 = 0u;
                w0 = __builtin_amdgcn_cvt_pk_fp8_f32(silu_mul(g0[0], u0[0]), silu_mul(g0[1], u0[1]), w0, false); w0 = __builtin_amdgcn_cvt_pk_fp8_f32(silu_mul(g0[2], u0[2]), silu_mul(g0[3], u0[3]), w0, true);
                w1 = __builtin_amdgcn_cvt_pk_fp8_f32(silu_mul(g1[0], u1[0]), silu_mul(g1[1], u1[1]), w1, false); w1 = __builtin_amdgcn_cvt_pk_fp8_f32(silu_mul(g1[2], u1[2]), silu_mul(g1[3], u1[3]), w1, true);
                typedef unsigned u32x2 __attribute__((ext_vector_type(2)));
                *(u32x2*)rowp = (u32x2){w0, w1}; }
    }
};

template <class Epi, class Sched, bool ALIGN_EPI, bool GATHER, bool F8 = false>
__device__ __forceinline__ void gemm_phase(PG8_LAS unsigned char* lds, const Gemm g, const Sched& S, const Epi& E, const int* rowidx, int wave) {
    const int wid = __builtin_amdgcn_readfirstlane(wave), lane = (int)__builtin_amdgcn_mbcnt_hi(~0u, __builtin_amdgcn_mbcnt_lo(~0u, 0u)), tid = wid * 64 + lane,     wr = wid >> 2, wc = wid & 3, fr = lane & 15, fq = lane >> 4;
    const int K = F8 ? g.K / 2 : g.K, nt = K / BK;
    unsigned voffB[2];
#pragma unroll
    for (int i = 0; i < 2; ++i) { int R, C; stage_rc(tid * 16 + i * 8192, R, C); const int Rb = Epi::PERM ? ((R & ~31) + perm32(R & 31)) : R; voffB[i] = (unsigned)(Rb * K + C) * 2u; }
#define PG8_MKVOFF(dst, U) do { _Pragma("unroll") for (int _h = 0; _h < 2; ++_h) _Pragma("unroll") for (int _i = 0; _i < 2; ++_i) { int R_, C_; stage_rc(tid * 16 + _i * 8192, R_, C_); \
        int row_ = (U).pm * BM + _h * HALF + R_; if (GATHER) row_ = rowidx[row_]; dst[_h][_i] = (unsigned)(row_ * K + C_) * 2u; } } while (0)
    const size_t kstep = (size_t)(BK * 2);
    const size_t hstep = (size_t)HALF * K * 2;
    const size_t tstep = 2 * hstep;
    const unsigned lds0 = (unsigned)__builtin_amdgcn_readfirstlane((int)(unsigned)(size_t)lds);
    const unsigned ldsw = (unsigned)wid * 1024u;
    const unsigned ldsb = lds0 + ldsw;
    const int aoff = lds_byte(wr * 64 + fr, fq * 8), boff = lds_byte(wc * 32 + fr, fq * 8);
#define PG8_SA(b, h) (((b) * 2 + (h)) * HTB)
#define PG8_SB(b, h) ((4 + (b) * 2 + (h)) * HTB)
#define PG8_GLDS(ldsbase, coff, voff32, gptr) do { asm volatile("s_add_u32 m0, %1, %3\n\ts_nop 0\n\tglobal_load_lds_dwordx4 %0, %2" : : "v"(voff32), "s"(ldsbase), "s"(gptr), "i"(coff) : "memory", "m0", "scc"); } while (0)
#define PG8_STAGE(bufoff, gbase, v0, v1) do { const unsigned long long gb_ = (unsigned long long)(gbase); \
        const unsigned long long gp_ = ((unsigned long long)(unsigned)__builtin_amdgcn_readfirstlane((int)(unsigned)(gb_ >> 32)) << 32) | (unsigned long long)(unsigned)__builtin_amdgcn_readfirstlane((int)(unsigned)gb_); PG8_GLDS(ldsb, (bufoff), v0, gp_); PG8_GLDS(ldsb, (bufoff) + 8192, v1, gp_); } while (0)
#define PG8_LD2(p_) __builtin_shufflevector(*(const PG8_LAS v4i_t*)(p_), *(const PG8_LAS v4i_t*)((p_) + 1024), 0, 1, 2, 3, 4, 5, 6, 7)
#define PG8_LDA(dst, b, h) do { _Pragma("unroll") for (int m = 0; m < 4; ++m) dst[m] = PG8_LD2(lds + PG8_SA(b, h) + aoff + m * 2048); } while (0)
#define PG8_LDB(dst, b, h) do { _Pragma("unroll") for (int n = 0; n < 2; ++n) dst[n] = PG8_LD2(lds + PG8_SB(b, h) + boff + n * 2048); } while (0)
#define PG8_LO(v) __builtin_bit_cast(bf16x8, __builtin_shufflevector(v, v, 0, 1, 2, 3))
#define PG8_HI(v) __builtin_bit_cast(bf16x8, __builtin_shufflevector(v, v, 4, 5, 6, 7))
#define PG8_MMA(ai, bj, At, Bt) do { __builtin_amdgcn_s_setprio(1); _Pragma("unroll") for (int m = 0; m < 4; ++m) _Pragma("unroll") for (int n = 0; n < 2; ++n) { \
        if constexpr (F8) { acc[ai][bj][m][n] = __builtin_amdgcn_mfma_scale_f32_16x16x128_f8f6f4(Bt[n], At[m], acc[ai][bj][m][n], 0, 0, 0, 0x7f7f7f7f, 0, 0x7f7f7f7f); } \
        else { acc[ai][bj][m][n] = __builtin_amdgcn_mfma_f32_16x16x32_bf16(PG8_LO(Bt[n]), PG8_LO(At[m]), acc[ai][bj][m][n], 0, 0, 0); acc[ai][bj][m][n] = __builtin_amdgcn_mfma_f32_16x16x32_bf16(PG8_HI(Bt[n]), PG8_HI(At[m]), acc[ai][bj][m][n], 0, 0, 0); } } __builtin_amdgcn_s_setprio(0); } while (0)
#define PG8_WAIT_V(n) asm volatile("s_waitcnt vmcnt(" #n ")" ::: "memory")
#define PG8_WAIT_L(n) asm volatile("s_waitcnt lgkmcnt(" #n ")" ::: "memory")
#define PG8_BAR __builtin_amdgcn_s_barrier()
#define PG8_SCHED __builtin_amdgcn_sched_barrier(0)
    Unit cur, nxt; int ui = 0;
    if (!S.next(0, cur)) return;
    f32x4 acc[2][2][4][2];
#pragma unroll
    for (int a = 0; a < 2; ++a)
#pragma unroll
        for (int b = 0; b < 2; ++b)
#pragma unroll
            for (int m = 0; m < 4; ++m)
#pragma unroll
                for (int n = 0; n < 2; ++n) acc[a][b][m][n] = (f32x4){0.f, 0.f, 0.f, 0.f};
    v8i_t At[4], B0[2], B1[2];
    unsigned voffA[2][2], voffN[2][2], voffA1[2];
    if constexpr (GATHER) { PG8_MKVOFF(voffA, cur); }
    else {
#pragma unroll
        for (int i = 0; i < 2; ++i) { int R, C; stage_rc(tid * 16 + i * 8192, R, C); voffA1[i] = (unsigned)(R * K + C) * 2u; } }
    const char* gA = (const char*)g.A;
    const char* cA = gA + (size_t)cur.pm * tstep; const char* nA = cA;
    const char* cB = (const char*)g.Bt + (size_t)cur.pn * tstep;
#define PG8_STAGE_A(bufoff, h, koff, usenext) do { \
        if constexpr (GATHER) { const unsigned v0_ = (usenext) ? voffN[h][0] : voffA[h][0], v1_ = (usenext) ? voffN[h][1] : voffA[h][1]; PG8_STAGE(bufoff, gA + (koff), v0_, v1_); } \
        else { const char* p_ = ((usenext) ? nA : cA) + (size_t)(h) * hstep + (koff); PG8_STAGE(bufoff, p_, voffA1[0], voffA1[1]); } } while (0)
    PG8_STAGE(PG8_SB(0, 0), cB, voffB[0], voffB[1]); PG8_STAGE(PG8_SB(0, 1), cB + hstep, voffB[0], voffB[1]); PG8_STAGE_A(PG8_SA(0, 0), 0, (size_t)0, false); PG8_STAGE_A(PG8_SA(0, 1), 1, (size_t)0, false);
    if (wr == 1) PG8_BAR;
    PG8_WAIT_V(2); PG8_BAR;
    PG8_STAGE(PG8_SB(1, 0), cB + kstep, voffB[0], voffB[1]); PG8_STAGE_A(PG8_SA(1, 0), 0, kstep, false); PG8_STAGE(PG8_SB(1, 1), cB + hstep + kstep, voffB[0], voffB[1]);
    PG8_WAIT_V(6); PG8_BAR;
    for (;;) {
        const bool has_next = S.next(ui + 1, nxt);
        if constexpr (GATHER) { if (has_next) { PG8_MKVOFF(voffN, nxt); } else {
#pragma unroll
            for (int h = 0; h < 2; ++h) { voffN[h][0] = voffA[h][0]; voffN[h][1] = voffA[h][1]; } } }
        nA = has_next ? gA + (size_t)nxt.pm * tstep : cA;
        const char* nB = has_next ? (const char*)g.Bt + (size_t)nxt.pn * tstep : cB;
        for (int t = 0; t < nt; t += 2) {
            const bool last = (t == nt - 2);
            const size_t k1 = (size_t)(t + 1) * kstep;
            const size_t k2 = last ? (size_t)0 : (size_t)(t + 2) * kstep; const char* b2 = last ? nB : cB + (size_t)(t + 2) * kstep;
            const size_t k3 = k2 + kstep; const char* b3 = b2 + kstep;
            PG8_LDB(B0, 0, 0); PG8_LDB(B1, 0, 1); PG8_SCHED; PG8_LDA(At, 0, 0); PG8_STAGE_A(PG8_SA(1, 1), 1, k1, false);
            PG8_WAIT_V(8); PG8_WAIT_L(0); PG8_BAR; PG8_MMA(0, 0, At, B0); PG8_MMA(0, 1, At, B1); PG8_BAR; PG8_SCHED;
            PG8_LDA(At, 0, 1); PG8_STAGE(PG8_SB(0, 0), b2, voffB[0], voffB[1]); PG8_STAGE(PG8_SB(0, 1), b2 + hstep, voffB[0], voffB[1]); PG8_STAGE_A(PG8_SA(0, 0), 0, k2, last);
            PG8_WAIT_V(8); PG8_WAIT_L(0); PG8_BAR; PG8_MMA(1, 0, At, B0); PG8_MMA(1, 1, At, B1); PG8_BAR; PG8_SCHED;
            PG8_LDB(B0, 1, 0); PG8_LDB(B1, 1, 1); PG8_SCHED; PG8_LDA(At, 1, 0); PG8_STAGE_A(PG8_SA(0, 1), 1, k2, last);
            PG8_WAIT_V(8); PG8_WAIT_L(0); PG8_BAR; PG8_MMA(0, 0, At, B0); PG8_MMA(0, 1, At, B1); PG8_BAR; PG8_SCHED;
            PG8_LDA(At, 1, 1); PG8_STAGE(PG8_SB(1, 0), b3, voffB[0], voffB[1]); PG8_STAGE(PG8_SB(1, 1), b3 + hstep, voffB[0], voffB[1]); PG8_STAGE_A(PG8_SA(1, 0), 0, k3, last);
            PG8_WAIT_V(8); PG8_WAIT_L(0); PG8_BAR; PG8_MMA(1, 0, At, B0); PG8_MMA(1, 1, At, B1); PG8_BAR; PG8_SCHED;
        }
        if constexpr (ALIGN_EPI) { if (wr == 0) PG8_BAR; }
        { int l2_ = (int)__builtin_amdgcn_mbcnt_hi(~0u, __builtin_amdgcn_mbcnt_lo(~0u, 0u)); asm volatile("" : "+v"(l2_)); E(acc, cur, wr, wc, l2_ & 15, l2_ >> 4); }
        if (!has_next) break;
#pragma unroll
        for (int a = 0; a < 2; ++a)
#pragma unroll
            for (int b = 0; b < 2; ++b)
#pragma unroll
                for (int m = 0; m < 4; ++m)
#pragma unroll
                    for (int n = 0; n < 2; ++n) acc[a][b][m][n] = (f32x4){0.f, 0.f, 0.f, 0.f};
        cur = nxt; cB = nB; cA = nA; ++ui;
        if constexpr (GATHER) {
#pragma unroll
            for (int h = 0; h < 2; ++h) { voffA[h][0] = voffN[h][0]; voffA[h][1] = voffN[h][1]; } }
        if constexpr (ALIGN_EPI) { if (wr == 1) PG8_BAR; }
    }
    PG8_WAIT_V(0);
    if constexpr (!ALIGN_EPI) { if (wr == 0) PG8_BAR; }
    PG8_BAR;
#undef PG8_MKVOFF
#undef PG8_STAGE_A
#undef PG8_SA
#undef PG8_SB
#undef PG8_STAGE
#undef PG8_GLDS
#undef PG8_LDA
#undef PG8_LD2
#undef PG8_LO
#undef PG8_HI
#undef PG8_LDB
#undef PG8_MMA
#undef PG8_WAIT_V
#undef PG8_WAIT_L
#undef PG8_BAR
#undef PG8_SCHED
}
}
namespace fp {
constexpr int NWAVES = 8;
constexpr int B = 16, S = 2048, T = B * S, D = 1024, H = 8, F1 = 2816, DI = 2048, NH = 4, DH = 512, NE = 8, F2 = 3584;
constexpr float QSCALE = 0.125f * 1.4426950408889634f;
constexpr float LAMBDA_INIT = 0.2f;
constexpr float EPS = 1e-6f;

constexpr size_t MiB = 1u << 20;
constexpr size_t WS_NEED = 613951040;
constexpr size_t WS_CTL = 0, CTL_ZERO_BYTES = 1 * MiB;
constexpr size_t WS_MOD = 1 * MiB;
constexpr size_t WS_TAB = 2 * MiB;
constexpr size_t WS_GATE = 3 * MiB;
constexpr size_t WS_W_AIN = 4 * MiB, WS_W_AOUT = 10 * MiB, WS_W_FGU = 12 * MiB, WS_W_FD = 23 * MiB, WS_W_MIN = 29 * MiB, WS_W_MOUT = 37 * MiB;
constexpr size_t WS_ROUTE = 41 * MiB;
constexpr size_t WS_ARENA = 43 * MiB;
constexpr size_t A_(size_t mib) { return WS_ARENA + mib * MiB; }
constexpr size_t WS_Y = A_(0);
constexpr size_t WS_H = A_(64);
constexpr size_t WS_Q = A_(64), WS_K = A_(128), WS_V = A_(192), WS_O = A_(256);
constexpr size_t WS_ACT = A_(128);
constexpr size_t WS_XZ = A_(128);
constexpr size_t WS_HH = A_(384);
constexpr size_t WS_WMD = A_(0);
constexpr size_t WS_WMGU = A_(128);
constexpr size_t WS_XB = A_(240);
constexpr int MOE_ROUNDS = 5;
constexpr int MPAD = 2 * T + NE * 256;
constexpr int MAXPANELS = MPAD / 256;
constexpr int PR = 64;
static_assert(PR * MOE_ROUNDS >= MAXPANELS, "MoE rounds cover every panel");
constexpr size_t ACT2_BYTES = (size_t)PR * 256 * F2 * 2;
static_assert(ACT2_BYTES <= (size_t)T * D * 4, "ACT2 fits d_out");
constexpr size_t WS_YM = A_(304);
constexpr size_t WS_END = WS_YM + (size_t)MPAD * 1024 * 2;
constexpr size_t WS_DIG = WS_NEED - 28 * MiB;
#ifdef REFCHECK
static_assert(WS_END <= WS_DIG, "d_ws map (refcheck)");
#else
static_assert(WS_END <= WS_NEED, "d_ws map");
#endif
constexpr int CW_FAIL = 8;
constexpr int CW_BAR = 4096;
constexpr int CW_ECNT = 200000;
constexpr int TAB_NPANELS = 0, TAB_EOFF = 16  , TAB_PEXP = 64  ;

constexpr int RING_BYTES = 131072;
constexpr int LDSCTL_OFF = RING_BYTES, MISC_OFF = LDSCTL_OFF + 320;
constexpr int LDS_BYTES = 147456;

#define GAS __attribute__((address_space(1)))
#define LAS __attribute__((address_space(3)))
typedef unsigned short bf16;
typedef unsigned v4u __attribute__((ext_vector_type(4)));
typedef unsigned v2u __attribute__((ext_vector_type(2)));
typedef float f32x4 __attribute__((ext_vector_type(4)));
typedef float f32x16 __attribute__((ext_vector_type(16)));
typedef short bf16x8 __attribute__((ext_vector_type(8)));
typedef short s16x4 __attribute__((ext_vector_type(4)));
typedef GAS unsigned gu32;
#define RLX_AGENT __ATOMIC_RELAXED, __HIP_MEMORY_SCOPE_AGENT
#define LDS_WAIT() asm volatile("s_waitcnt lgkmcnt(0)" ::: "memory")
#define VM_WAIT() asm volatile("s_waitcnt vmcnt(0)" ::: "memory")
__device__ __forceinline__ unsigned f2bf(float f) { unsigned u = __builtin_bit_cast(unsigned, f); return (u + 0x7fffu + ((u >> 16) & 1u)) >> 16; }
__device__ __forceinline__ unsigned pk2(float lo, float hi) { return f2bf(lo) | (f2bf(hi) << 16); }
__device__ __forceinline__ float bf_lo(unsigned w) { return __builtin_bit_cast(float, w << 16); }
__device__ __forceinline__ float bf_hi(unsigned w) { return __builtin_bit_cast(float, w & 0xffff0000u); }
__device__ __forceinline__ float bf2f(bf16 v) { return __builtin_bit_cast(float, (unsigned)v << 16); }
__device__ __forceinline__ float fsilu(float v) { return v * __builtin_amdgcn_rcpf(1.0f + __builtin_amdgcn_exp2f(-1.4426950408889634f * v)); }
__device__ __forceinline__ float wave_sum(float v) {
#pragma unroll
    for (int o = 1; o < 64; o <<= 1) v += __shfl_xor(v, o);
    return v;
}

#define XB_TMO      128
#define XB_XCNT(j)  (256  + 64 * (j))
#define XB_XSUB(j)  (1280 + 64 * (j))
#define XB_XGEN(j)  (2304 + 64 * (j))
#define XB_TOP      3328
#define XB_TOPGEN   3392
#define XCD_BAR_WORDS 3456
#define XB_SPIN_CAP (1u << 18)
__device__ __forceinline__ unsigned xb_ld(unsigned* p)              { return __hip_atomic_load(p, __ATOMIC_RELAXED, __HIP_MEMORY_SCOPE_AGENT); }
__device__ __forceinline__ unsigned xb_add(unsigned* p, unsigned v) { return __hip_atomic_fetch_add(p, v, __ATOMIC_RELAXED, __HIP_MEMORY_SCOPE_AGENT); }
__device__ __forceinline__ unsigned xb_xcc_id() { return (unsigned)__builtin_amdgcn_s_getreg((3 << 11) | 20) & 0xFu; }
#define XB_SPIN(cond, bar) do { unsigned _sp = 0; while (cond) { __builtin_amdgcn_s_sleep(1); \
    if ((++_sp & 255u) == 0u) { if (xb_ld(&(bar)[XB_TMO])) break; if (_sp > XB_SPIN_CAP) { atomicAdd(&(bar)[XB_TMO], 1u); break; } } } } while (0)
struct XcdBarrier { unsigned* bar; unsigned x; volatile LAS unsigned* st; int wave; };
__device__ __forceinline__ bool xb_first_thread(int wave) { return wave == 0 && __builtin_amdgcn_mbcnt_hi(~0u, __builtin_amdgcn_mbcnt_lo(~0u, 0u)) == 0u; }
__device__ __forceinline__ XcdBarrier xcd_barrier_post(unsigned* bar, volatile LAS unsigned* st, int wave) {
    XcdBarrier b; b.bar = bar; b.x = xb_xcc_id(); b.st = st; b.wave = wave;
    if (xb_first_thread(wave)) (void)xb_add(&bar[XB_XCNT(b.x)], 1u);
    return b;
}
__device__ __forceinline__ void xcd_barrier_complete(unsigned* bar, unsigned x, unsigned& nloc, unsigned& nx) {
    const unsigned G = gridDim.x * gridDim.y * gridDim.z;
    unsigned sum, cnt, mine, sp = 0u;
    for (;;) {
        sum = 0u; cnt = 0u; mine = 0u;
#pragma unroll
        for (unsigned j = 0; j < 16; ++j) { const unsigned c = xb_ld(&bar[XB_XCNT(j)]); sum += c; cnt += (c > 0u) ? 1u : 0u; mine = (j == x) ? c : mine; }
        if (sum == G) break;
        __builtin_amdgcn_s_sleep(1);
        if ((++sp & 255u) == 0u) { if (xb_ld(&bar[XB_TMO])) break; if (sp > XB_SPIN_CAP) { atomicAdd(&bar[XB_TMO], 1u); break; } }
    }
    nloc = mine > 0u ? mine : 1u; nx = cnt > 0u ? cnt : 1u;
}
__device__ __forceinline__ void xcd_barrier(const XcdBarrier& b) {
    asm volatile("s_waitcnt vmcnt(0)" ::: "memory");
    __syncthreads();
    if (xb_first_thread(b.wave)) {
        unsigned* bar = b.bar;
        __builtin_amdgcn_s_waitcnt(0);
        unsigned nloc = b.st[0], nx = b.st[1];
        if (nloc == 0u) { xcd_barrier_complete(bar, b.x, nloc, nx); b.st[0] = nloc; b.st[1] = nx; }
        const unsigned old = xb_add(&bar[XB_XSUB(b.x)], 1u);
        const unsigned gen = old / nloc;
        if (old + 1u == (gen + 1u) * nloc) {
            __builtin_amdgcn_fence(__ATOMIC_RELEASE, "agent");
            asm volatile("s_waitcnt vmcnt(0)" ::: "memory");
            const unsigned og = xb_add(&bar[XB_TOP], 1u);
            const unsigned tg = og / nx;
            if (og + 1u == (tg + 1u) * nx) xb_add(&bar[XB_TOPGEN], 1u);
            else XB_SPIN(xb_ld(&bar[XB_TOPGEN]) == tg, bar);
            __builtin_amdgcn_fence(__ATOMIC_ACQUIRE, "agent");
            xb_add(&bar[XB_XGEN(b.x)], 1u);
            asm volatile("s_waitcnt vmcnt(0)" ::: "memory");
        } else {
            XB_SPIN(xb_ld(&bar[XB_XGEN(b.x)]) == gen, bar);
            __builtin_amdgcn_fence(__ATOMIC_ACQUIRE, "agent");
            asm volatile("s_waitcnt vmcnt(0)" ::: "memory");
        }
    }
    __syncthreads();
}

struct Frame {
    LAS unsigned char* lds;
    volatile LAS unsigned* MISC;
    gu32* ctl;
    unsigned char* ws;
    int tid, lane, wave, G, gw, NGW;
    const float* const* in;
    float* X;
};
enum { I_X = 0, I_C, I_MODW, I_MODB, I_NORMG, I_AWIN, I_AWOUT, I_ALAM, I_ASUBLN, I_FWG, I_FWU, I_FWD, I_MWIN, I_CONVW, I_CONVB, I_WQ, I_WK, I_WV, I_WGATE, I_BGATE, I_SKIP, I_MNORM, I_MWOUT,
       I_WROUTER, I_BROUTER, I_EWG, I_EWU, I_EWD };

__device__ __forceinline__ void transpose_item(const float* W, int K, int N, bf16* WT, int mode, LAS float* scr, int item, int lane) {
    const int nblk = N / 32, kb = item / nblk, nb = item % nblk, k0 = 64 * kb, n0 = 32 * nb;
#pragma unroll
    for (int i = 0; i < 32; ++i) { const int kk = 2 * i + (lane >> 5); scr[kk * 33 + (lane & 31)] = __builtin_nontemporal_load(W + (size_t)(k0 + kk) * N + n0 + (lane & 31)); }
    LDS_WAIT(); asm volatile("" ::: "memory");
    const int c = lane & 7;
#pragma unroll
    for (int j = 0; j < 4; ++j) { const int n = (lane >> 3) + 8 * j; const LAS float* s = scr + (8 * c) * 33 + n;
        v4u o; o.x = pk2(s[0 * 33], s[1 * 33]); o.y = pk2(s[2 * 33], s[3 * 33]); o.z = pk2(s[4 * 33], s[5 * 33]); o.w = pk2(s[6 * 33], s[7 * 33]);
        const int ng = n0 + n; const int row = mode == 0 ? ng : ((ng >> 7) * 256 + (ng & 127) + (mode == 2 ? 128 : 0));
        *(GAS v4u*)(WT + (size_t)row * K + k0 + 8 * c) = o; }
    LDS_WAIT(); asm volatile("" ::: "memory");
}
constexpr float WS8 = 32.f;
__device__ __forceinline__ unsigned pk4_fp8(float a, float b, float c, float d) { unsigned w = 0u; w = __builtin_amdgcn_cvt_pk_fp8_f32(a, b, w, false); w = __builtin_amdgcn_cvt_pk_fp8_f32(c, d, w, true); return w; }
__device__ __forceinline__ void transpose_item_f8(const float* W, int K, int N, unsigned char* WT, int mode, LAS float* scr, int item, int lane) {
    const int nblk = N / 32, kb = item / nblk, nb = item % nblk, k0 = 64 * kb, n0 = 32 * nb;
#pragma unroll 8
    for (int i = 0; i < 32; ++i) { const int kk = 2 * i + (lane >> 5); scr[kk * 33 + (lane & 31)] = W[(size_t)(k0 + kk) * N + n0 + (lane & 31)]; }
    LDS_WAIT(); asm volatile("" ::: "memory");
    const int n = lane >> 1, half = lane & 1; const LAS float* sp = scr + (32 * half) * 33 + n;
    v4u o[2];
#pragma unroll
    for (int u = 0; u < 2; ++u) { const LAS float* s4 = sp + 16 * u * 33;
        o[u].x = pk4_fp8(s4[0 * 33] * WS8, s4[1 * 33] * WS8, s4[2 * 33] * WS8, s4[3 * 33] * WS8); o[u].y = pk4_fp8(s4[4 * 33] * WS8, s4[5 * 33] * WS8, s4[6 * 33] * WS8, s4[7 * 33] * WS8);
        o[u].z = pk4_fp8(s4[8 * 33] * WS8, s4[9 * 33] * WS8, s4[10 * 33] * WS8, s4[11 * 33] * WS8); o[u].w = pk4_fp8(s4[12 * 33] * WS8, s4[13 * 33] * WS8, s4[14 * 33] * WS8, s4[15 * 33] * WS8); }
    const int ng = n0 + n; const int row = mode == 0 ? ng : ((ng >> 7) * 256 + (ng & 127) + (mode == 2 ? 128 : 0));
    GAS v4u* dst = (GAS v4u*)(WT + (size_t)row * K + k0 + 32 * half); dst[0] = o[0]; dst[1] = o[1];
    LDS_WAIT(); asm volatile("" ::: "memory");
}
__device__ __forceinline__ void convert_matrix_f8(Frame& F, const float* W, int K, int N, unsigned char* WT, int mode) {
    LAS float* scr = (LAS float*)(F.lds + F.wave * 16384);
    const int nitems = (K / 64) * (N / 32);
    for (int it = F.gw; it < nitems; it += F.NGW) transpose_item_f8(W, K, N, WT, mode, scr, it, F.lane);
}
__device__ __forceinline__ void convert_matrix(Frame& F, const float* W, int K, int N, bf16* WT, int mode) {
    LAS float* scr = (LAS float*)(F.lds + F.wave * 16384);
    const int nitems = (K / 64) * (N / 32);
    for (int it = F.gw; it < nitems; it += F.NGW) transpose_item(W, K, N, WT, mode, scr, it, F.lane);
}

__device__ __forceinline__ void p_mlprep(Frame& F);
__device__ __forceinline__ void p_mlprep2(Frame& F);
template <int PARTS = 7>
__device__ __forceinline__ void p_prologue(Frame& F) {
    if (PARTS & 1) {
        LAS float* sc = (LAS float*)(F.lds);
        LAS float* red = (LAS float*)(F.lds + 65536);
        const float* c = F.in[I_C];
        for (int e = F.tid; e < 16 * 1024; e += 512) sc[e] = fsilu(c[e]);
        __syncthreads();
        float* mod = (float*)(F.ws + WS_MOD);
        for (int cb = blockIdx.x; cb < 12288 / 64; cb += F.G) {
            const int col = cb * 64 + F.lane, i = col / 6144, n = col % 6144;
            const float* w = F.in[I_MODW] + (size_t)i * 1024 * 6144 + n;
            float acc[16];
#pragma unroll
            for (int b = 0; b < 16; ++b) acc[b] = 0.f;
#pragma unroll 4
            for (int k = F.wave * 128; k < F.wave * 128 + 128; k += 4) {
                const float w0 = __builtin_nontemporal_load(w + (size_t)k * 6144), w1 = __builtin_nontemporal_load(w + (size_t)(k + 1) * 6144), w2 = __builtin_nontemporal_load(w + (size_t)(k + 2) * 6144), w3 = __builtin_nontemporal_load(w + (size_t)(k + 3) * 6144);
#pragma unroll
                for (int b = 0; b < 16; ++b) { const f32x4 s4 = *(LAS const f32x4*)(sc + b * 1024 + k); acc[b] += s4.x * w0 + s4.y * w1 + s4.z * w2 + s4.w * w3; } }
#pragma unroll
            for (int b = 0; b < 16; ++b) red[(F.wave * 16 + b) * 64 + F.lane] = acc[b];
            __syncthreads();
            for (int e = F.tid; e < 16 * 64; e += 512) { const int b = e >> 6, l = e & 63; float s = 0.f;
#pragma unroll
                for (int w8 = 0; w8 < 8; ++w8) s += red[(w8 * 16 + b) * 64 + l];
                const int col2 = cb * 64 + l, i2 = col2 / 6144, n2 = col2 % 6144;
                mod[(size_t)(i2 * 16 + b) * 6144 + n2] = s + F.in[I_MODB][i2 * 6144 + n2]; }
            __syncthreads();
        }
        __syncthreads();
    }
    if (PARTS & 2) p_mlprep(F);
    if (PARTS & 4) {
    convert_matrix(F, F.in[I_AWIN], 1024, 3072, (bf16*)(F.ws + WS_W_AIN), 0);
    convert_matrix(F, F.in[I_AWOUT], 1024, 1024, (bf16*)(F.ws + WS_W_AOUT), 0);
    convert_matrix(F, F.in[I_FWG], 1024, F1, (bf16*)(F.ws + WS_W_FGU), 1);
    convert_matrix(F, F.in[I_FWU], 1024, F1, (bf16*)(F.ws + WS_W_FGU), 2);
    convert_matrix(F, F.in[I_FWD], F1, 1024, (bf16*)(F.ws + WS_W_FD), 0);
    convert_matrix(F, F.in[I_MWIN], 1024, 4096, (bf16*)(F.ws + WS_W_MIN), 0);
    convert_matrix(F, F.in[I_MWOUT], 2048, 1024, (bf16*)(F.ws + WS_W_MOUT), 0);
    }
}

struct Row16 { f32x4 v[4]; };
__device__ __forceinline__ Row16 load_row_f32(const float* p, int lane) { Row16 r; const GAS f32x4* q = (const GAS f32x4*)p + lane;
#pragma unroll
    for (int j = 0; j < 4; ++j) r.v[j] = q[64 * j]; return r; }
__device__ __forceinline__ Row16 load_row_f32_nt(const float* p, int lane) { Row16 r; const f32x4* q = (const f32x4*)p + lane;
#pragma unroll
    for (int j = 0; j < 4; ++j) r.v[j] = __builtin_nontemporal_load(q + 64 * j); return r; }
__device__ __forceinline__ Row16 load_row_bf16(const bf16* p, int lane) { Row16 r; const GAS v2u* q = (const GAS v2u*)p + lane;
#pragma unroll
    for (int j = 0; j < 4; ++j) { const v2u w = q[64 * j]; r.v[j] = (f32x4){bf_lo(w.x), bf_hi(w.x), bf_lo(w.y), bf_hi(w.y)}; } return r; }
__device__ __forceinline__ Row16 load_row_bf16_nt(const bf16* p, int lane) { Row16 r; const v2u* q = (const v2u*)p + lane;
#pragma unroll
    for (int j = 0; j < 4; ++j) { const v2u w = __builtin_nontemporal_load(q + 64 * j); r.v[j] = (f32x4){bf_lo(w.x), bf_hi(w.x), bf_lo(w.y), bf_hi(w.y)}; } return r; }
__device__ __forceinline__ float row_ss(const Row16& r) { float s = 0.f;
#pragma unroll
    for (int j = 0; j < 4; ++j) s += (r.v[j].x * r.v[j].x + r.v[j].y * r.v[j].y) + (r.v[j].z * r.v[j].z + r.v[j].w * r.v[j].w);
    return wave_sum(s); }
__device__ __forceinline__ void store_row_bf16(bf16* p, int lane, const Row16& r) { GAS v2u* q = (GAS v2u*)p + lane;
#pragma unroll
    for (int j = 0; j < 4; ++j) { v2u w; w.x = pk2(r.v[j].x, r.v[j].y); w.y = pk2(r.v[j].z, r.v[j].w); q[64 * j] = w; } }
__device__ __forceinline__ void store_row_bf16_nt(bf16* p, int lane, const Row16& r) { v2u* q = (v2u*)p + lane;
#pragma unroll
    for (int j = 0; j < 4; ++j) { v2u w; w.x = pk2(r.v[j].x, r.v[j].y); w.y = pk2(r.v[j].z, r.v[j].w); __builtin_nontemporal_store(w, q + 64 * j); } }
__device__ __forceinline__ void store_row_f32_nt(float* p, int lane, const Row16& r) { f32x4* q = (f32x4*)p + lane;
#pragma unroll
    for (int j = 0; j < 4; ++j) __builtin_nontemporal_store(r.v[j], q + 64 * j); }
__device__ __forceinline__ void store_row_fp8(unsigned char* p, int lane, const Row16& r) { GAS unsigned* q = (GAS unsigned*)p + lane;
#pragma unroll
    for (int j = 0; j < 4; ++j) q[64 * j] = pk4_fp8(r.v[j].x, r.v[j].y, r.v[j].z, r.v[j].w); }
__device__ __forceinline__ void store_row_f32(float* p, int lane, const Row16& r) { GAS f32x4* q = (GAS f32x4*)p + lane;
#pragma unroll
    for (int j = 0; j < 4; ++j) q[64 * j] = r.v[j]; }
__device__ __forceinline__ Row16 round_row_bf16(const Row16& r) { Row16 o;
#pragma unroll
    for (int j = 0; j < 4; ++j) { const unsigned a = pk2(r.v[j].x, r.v[j].y), b2 = pk2(r.v[j].z, r.v[j].w); o.v[j] = (f32x4){bf_lo(a), bf_hi(a), bf_lo(b2), bf_hi(b2)}; } return o; }
__device__ __forceinline__ void norm_mod_row(const Row16& x, float rstd, const float* g, const float* scale, const float* shift, bf16* out, int lane) {
    const Row16 gg = load_row_f32(g, lane), sc = load_row_f32(scale, lane), sh = load_row_f32(shift, lane); Row16 h;
#pragma unroll
    for (int j = 0; j < 4; ++j) h.v[j] = x.v[j] * rstd * gg.v[j] * (sc.v[j] + 1.0f) + sh.v[j];
    store_row_bf16(out, lane, h);
}
#define ROWBLOCK(m0, m1) const int per_ = (T + F.NGW - 1) / F.NGW; const int m0 = F.gw * per_; const int m1 = (m0 + per_ < T) ? m0 + per_ : T
__device__ __forceinline__ void p_h0(Frame& F, bf16* Hout) {
    const float* mod = (const float*)(F.ws + WS_MOD); const float* g = F.in[I_NORMG];
    ROWBLOCK(m0, m1); int bc = -1; Row16 gg = load_row_f32(g, F.lane), sc, sh;
    Row16 xnx = load_row_f32_nt(F.in[I_X] + (size_t)m0 * D, F.lane);
    for (int m = m0; m < m1; ++m) { const int b = m >> 11;
        if (b != bc) { bc = b; const float* mb = mod + (size_t)b * 6144; sc = load_row_f32(mb + 1024, F.lane); sh = load_row_f32(mb, F.lane); }
        const Row16 x = xnx; if (m + 1 < m1) xnx = load_row_f32_nt(F.in[I_X] + (size_t)(m + 1) * D, F.lane);
        const float rstd = rsqrtf(row_ss(x) * (1.f / D) + EPS); Row16 h;
#pragma unroll
        for (int j = 0; j < 4; ++j) h.v[j] = x.v[j] * rstd * gg.v[j] * (sc.v[j] + 1.0f) + sh.v[j];
        store_row_bf16(Hout + (size_t)m * D, F.lane, h); }
}
__device__ __forceinline__ void p_norm(Frame& F, const float* xold, const bf16* Y, const float* gpost, const float* modg, int gi, const float* gn, const float* modn, int si, bf16* Hout) {
    ROWBLOCK(m0, m1); int bc = -1; const Row16 gp = load_row_f32(gpost, F.lane), gg = load_row_f32(gn, F.lane); Row16 gt, sc, sh;
    Row16 ynx = load_row_bf16_nt(Y + (size_t)m0 * D, F.lane), xnx = load_row_f32_nt(xold + (size_t)m0 * D, F.lane);
    for (int m = m0; m < m1; ++m) { const int b = m >> 11;
        if (b != bc) { bc = b; gt = load_row_f32(modg + (size_t)b * 6144 + gi * 1024, F.lane); const float* mb = modn + (size_t)b * 6144; sc = load_row_f32(mb + (si + 1) * 1024, F.lane); sh = load_row_f32(mb + si * 1024, F.lane); }
        const Row16 y = ynx, xo = xnx; if (m + 1 < m1) { ynx = load_row_bf16_nt(Y + (size_t)(m + 1) * D, F.lane); xnx = load_row_f32_nt(xold + (size_t)(m + 1) * D, F.lane); }
        const float r1 = rsqrtf(row_ss(y) * (1.f / D) + EPS);
        Row16 xn;
#pragma unroll
        for (int j = 0; j < 4; ++j) xn.v[j] = xo.v[j] + gt.v[j] * (y.v[j] * r1 * gp.v[j]);
        store_row_bf16_nt((bf16*)F.X + (size_t)m * D, F.lane, xn);
        const float r2 = rsqrtf(row_ss(xn) * (1.f / D) + EPS); Row16 h;
#pragma unroll
        for (int j = 0; j < 4; ++j) h.v[j] = xn.v[j] * r2 * gg.v[j] * (sc.v[j] + 1.0f) + sh.v[j];
        store_row_bf16(Hout + (size_t)m * D, F.lane, h); }
}
#define HAVE_ATTN 1
__device__ __forceinline__ int crow(int r, int hi) { return (r & 3) + 8 * (r >> 2) + 4 * hi; }
__device__ __forceinline__ void swap32(unsigned& a, unsigned& b) { asm volatile("s_nop 1\n\tv_permlane32_swap_b32 %0, %1\n\ts_nop 1" : "+v"(a), "+v"(b)); }
__device__ __forceinline__ float xhalf_max(float v) { unsigned a = __builtin_bit_cast(unsigned, v), b2 = a; swap32(a, b2); return fmaxf(__builtin_bit_cast(float, a), __builtin_bit_cast(float, b2)); }
__device__ __forceinline__ float xhalf_sum(float v) { unsigned a = __builtin_bit_cast(unsigned, v), b2 = a; swap32(a, b2); return __builtin_bit_cast(float, a) + __builtin_bit_cast(float, b2); }
typedef short v4i16_t __attribute__((ext_vector_type(4)));
__device__ __forceinline__ s16x4 tr16(LAS const char* p) { return __builtin_bit_cast(s16x4, __builtin_amdgcn_ds_read_tr16_b64_v4i16((LAS v4i16_t*)p)); }
typedef float f32x2_t __attribute__((ext_vector_type(2))); typedef __bf16 bf16x2_t __attribute__((ext_vector_type(2)));
__device__ __forceinline__ unsigned cvtpk(float lo, float hi) { f32x2_t v = {lo, hi}; bf16x2_t b = __builtin_convertvector(v, bf16x2_t); return __builtin_bit_cast(unsigned, b); }
__device__ __forceinline__ float max3f(float a, float b, float c) { float r; asm("v_max3_f32 %0, %1, %2, %3" : "=v"(r) : "v"(a), "v"(b), "v"(c)); return r; }
#define MFMA32(a, b, c) __builtin_amdgcn_mfma_f32_32x32x16_bf16((a), (b), (c), 0, 0, 0)

constexpr size_t WS_KN = WS_TAB + 512 * 1024;
constexpr int CW_ATTQ = 1024;
__device__ __forceinline__ void p_attn_kn(Frame& F) {
    const bf16* Kb = (const bf16*)(F.ws + WS_K); float* KNG = (float*)(F.ws + WS_KN);
    const int lane = F.lane, w = F.wave, tid = F.tid;
    LAS float* KNW = (LAS float*)F.lds;
    for (int bh = F.gw >> 3; bh < B * H; bh += F.G) { const int b = bh >> 3, h = bh & 7; const size_t rowb = (size_t)b * S;
        float mk0 = 0.f, mk1 = 0.f;
        for (int r = tid; r < S; r += 512) { const bf16* kr = Kb + (rowb + r) * 1024 + h * 128; float s0 = 0.f, s1 = 0.f;
#pragma unroll
            for (int i = 0; i < 8; ++i) { const v4u a = *(const GAS v4u*)(kr + 8 * i), bq = *(const GAS v4u*)(kr + 64 + 8 * i);
                s0 += bf_lo(a.x) * bf_lo(a.x) + bf_hi(a.x) * bf_hi(a.x) + bf_lo(a.y) * bf_lo(a.y) + bf_hi(a.y) * bf_hi(a.y) + bf_lo(a.z) * bf_lo(a.z) + bf_hi(a.z) * bf_hi(a.z) + bf_lo(a.w) * bf_lo(a.w) + bf_hi(a.w) * bf_hi(a.w);
                s1 += bf_lo(bq.x) * bf_lo(bq.x) + bf_hi(bq.x) * bf_hi(bq.x) + bf_lo(bq.y) * bf_lo(bq.y) + bf_hi(bq.y) * bf_hi(bq.y) + bf_lo(bq.z) * bf_lo(bq.z) + bf_hi(bq.z) * bf_hi(bq.z) + bf_lo(bq.w) * bf_lo(bq.w) + bf_hi(bq.w) * bf_hi(bq.w); }
            mk0 = fmaxf(mk0, s0); mk1 = fmaxf(mk1, s1); }
#pragma unroll
        for (int o = 1; o < 64; o <<= 1) { mk0 = fmaxf(mk0, __shfl_xor(mk0, o)); mk1 = fmaxf(mk1, __shfl_xor(mk1, o)); }
        __syncthreads();
        if (lane == 0) { KNW[w * 2] = mk0; KNW[w * 2 + 1] = mk1; }
        __syncthreads();
        if (tid < 2) { float mm = 0.f; for (int w8 = 0; w8 < 8; ++w8) mm = fmaxf(mm, KNW[w8 * 2 + tid]); KNG[bh * 2 + tid] = sqrtf(mm); }
    }
    __syncthreads();
}
template <int VAR>
__device__ __forceinline__ void p_attn(Frame& F) {
    const bf16* Qb = (const bf16*)(F.ws + WS_Q); const bf16* Kb = (const bf16*)(F.ws + WS_K); const bf16* Vb = (const bf16*)(F.ws + WS_V); bf16* Ob = (bf16*)(F.ws + WS_O);
    const int lane = F.lane, r32 = lane & 31, hi = lane >> 5, w = F.wave, g = w >> 1, c = w & 1, tid = F.tid;
    float l01 = 0.f, l23 = 0.f; { const float* lam = F.in[I_ALAM]; for (int i = 0; i < 64; ++i) { l01 += lam[i] * lam[64 + i]; l23 += lam[128 + i] * lam[192 + i]; } }
#ifdef LAM0
    const float lam_full = 0.f;
#else
    const float lam_full = __expf(l01) - __expf(l23) + LAMBDA_INIT;
#endif
    const int krow_ = tid >> 3, kpc = tid & 7, vrow_ = tid >> 4, vpc = tid & 15;
    const int i16 = lane & 15, q4 = i16 >> 2, p4 = i16 & 3, blk = (lane >> 4) & 1;
    LAS char* L = (LAS char*)F.lds;
    constexpr int KP = 144, VP = 320, STG = 2 * 64 * KP + 64 * VP;
    LAS float* XCH = (LAS float*)F.lds;
    LAS float* KNW = (LAS float*)(L + 2 * STG);
    const float* KNG = (const float*)(F.ws + WS_KN);
    {
    for (;;) {
        __syncthreads();
        if (tid == 0) ((LAS int*)(KNW + 48))[0] = (int)__hip_atomic_fetch_add((unsigned*)(F.ctl + CW_ATTQ), 1u, __ATOMIC_RELAXED, __HIP_MEMORY_SCOPE_AGENT);
        __syncthreads();
        const int ui = __builtin_amdgcn_readfirstlane(((LAS const int*)(KNW + 48))[0]);
        if (ui >= B * H * 16) break;
        const int b = ui & 15, h = 7 - ((ui >> 4) & 7), u = 15 - (ui >> 7);
        const float slope2 = exp2f(-(float)(h + 1)) * 1.4426950408889634f;
        const size_t rowb = (size_t)b * S;
        const float kn = KNG[(b * 8 + h) * 2 + c];
        const int ntu = 2 * u + 2, cq = 2 * u + (g >> 1);
        const int qpos = 128 * u + 32 * g + r32;
        bf16x8 qf[4];
        { int lq = lane; asm volatile("" : "+v"(lq));
          const bf16* qp = Qb + (rowb + 128 * u + 32 * g + (lq & 31)) * 1024 + h * 128 + c * 64 + 8 * (lq >> 5);
#pragma unroll
            for (int ks = 0; ks < 4; ++ks) qf[ks] = __builtin_nontemporal_load((const bf16x8*)(qp + 16 * ks)); }
        float bc;
        { float qs = 0.f;
#pragma unroll
            for (int ks = 0; ks < 4; ++ks) { const v4u qw = __builtin_bit_cast(v4u, qf[ks]);
                qs += bf_lo(qw.x) * bf_lo(qw.x) + bf_hi(qw.x) * bf_hi(qw.x) + bf_lo(qw.y) * bf_lo(qw.y) + bf_hi(qw.y) * bf_hi(qw.y) + bf_lo(qw.z) * bf_lo(qw.z) + bf_hi(qw.z) * bf_hi(qw.z) + bf_lo(qw.w) * bf_lo(qw.w) + bf_hi(qw.w) * bf_hi(qw.w); }
            qs = xhalf_sum(qs);
#pragma unroll
            for (int o2 = 1; o2 < 32; o2 <<= 1) qs = fmaxf(qs, __shfl_xor(qs, o2));
            bc = sqrtf(qs) * kn * 1.001f + 0.01f; }
        v4u pk0, pk1, pv0, pv1;
#define ATT_LOADT(kt) do { const bf16* kr = Kb + (rowb + (size_t)(kt) * 64 + krow_) * 1024 + h * 128 + kpc * 8; pk0 = *(const GAS v4u*)kr; pk1 = *(const GAS v4u*)(kr + 64); \
            const bf16* vr = Vb + (rowb + (size_t)(kt) * 64 + vrow_) * 1024 + h * 128 + vpc * 8; pv0 = *(const GAS v4u*)vr; pv1 = *(const GAS v4u*)(vr + 32 * 1024); } while (0)
#define ATT_STORET(st) do { LAS char* sb = L + (st) * STG; *(LAS v4u*)(sb + krow_ * KP + kpc * 16) = pk0; *(LAS v4u*)(sb + 64 * KP + krow_ * KP + kpc * 16) = pk1; \
            *(LAS v4u*)(sb + 128 * KP + vrow_ * VP + vpc * 16) = pv0; *(LAS v4u*)(sb + 128 * KP + (vrow_ + 32) * VP + vpc * 16) = pv1; } while (0)
        ATT_LOADT(ntu - 1);
        __syncthreads();
        ATT_STORET(0);
        __syncthreads();
        float m = -1e30f, l = 0.f;
        f32x16 o[4];
#pragma unroll
        for (int et = 0; et < 4; ++et)
#pragma unroll
            for (int r = 0; r < 16; ++r) o[et][r] = 0.f;
        int nj = ntu;
        for (int j = 0; j < nj; ++j) {
            const int kt = ntu - 1 - j;
            const bool more = j + 1 < nj;
            if (more) ATT_LOADT(kt - 1);
            if (VAR != 1 && kt <= cq) {
                LAS const char* Kc = L + (j & 1) * STG + c * 64 * KP;
                LAS const char* Vs = L + (j & 1) * STG + 128 * KP;
                f32x16 sacc[2];
                const bool started = m > -1e29f; const float mref = started ? m : 0.f;
#pragma unroll
                for (int half = 0; half < 2; ++half) {
                    f32x16 acc;
                    if (kt < cq) { const float base = slope2 * (float)(kt * 64 + 32 * half + 4 * hi) - mref;
#pragma unroll
                        for (int r = 0; r < 16; ++r) acc[r] = fmaf(slope2, (float)((r & 3) + 8 * (r >> 2)), base);
                    } else { const float q2 = 2.f * (float)qpos;
#pragma unroll
                        for (int r = 0; r < 16; ++r) { const float kpos = (float)(kt * 64 + 32 * half + crow(r, hi)); acc[r] = fmaf(slope2, fminf(kpos, q2 - kpos), -mref); } }
#pragma unroll
                    for (int ks = 0; ks < 4; ++ks) { const bf16x8 kf = *(LAS const bf16x8*)(Kc + (32 * half + r32) * KP + (16 * ks + 8 * hi) * 2); acc = MFMA32(kf, qf[ks], acc); }
                    sacc[half] = acc;
                }
                if (VAR != 2) {
                float mx = fmaxf(sacc[0][0], sacc[1][0]);
#pragma unroll
                for (int r = 1; r < 16; ++r) mx = max3f(mx, sacc[0][r], sacc[1][r]);
                mx = xhalf_max(mx);
                if (!__all(started && mx <= 8.f)) {
                    const float d = fmaxf(mx, started ? 0.f : -1e30f);
                    const float alpha = started ? __builtin_amdgcn_exp2f(-d) : 0.f;
                    m = mref + d; l *= alpha;
#pragma unroll
                    for (int half = 0; half < 2; ++half)
#pragma unroll
                        for (int r = 0; r < 16; ++r) sacc[half][r] -= d;
#pragma unroll
                    for (int et = 0; et < 4; ++et)
#pragma unroll
                        for (int r = 0; r < 16; ++r) o[et][r] *= alpha;
                }
                float lsum = 0.f;
#pragma unroll
                for (int half = 0; half < 2; ++half)
#pragma unroll
                    for (int r = 0; r < 16; ++r) { const float p = __builtin_amdgcn_exp2f(sacc[half][r]); sacc[half][r] = p; lsum += p; }
                l += lsum;
                }
                bf16x8 pf[4];
#pragma unroll
                for (int ks = 0; ks < 4; ++ks) { const int half = ks >> 1, s8 = 8 * (ks & 1); v4u pw;
                    pw.x = cvtpk(sacc[half][s8 + 0], sacc[half][s8 + 1]); pw.y = cvtpk(sacc[half][s8 + 2], sacc[half][s8 + 3]); pw.z = cvtpk(sacc[half][s8 + 4], sacc[half][s8 + 5]); pw.w = cvtpk(sacc[half][s8 + 6], sacc[half][s8 + 7]);
                    pf[ks] = __builtin_bit_cast(bf16x8, pw); }
                if (VAR != 3) { bf16x8 vf[2][4];
                    LAS const char* vp0 = Vs + (4 * hi + q4) * VP + (16 * blk) * 2 + 8 * p4;
#define ATT_VLOAD(dst, et) do { _Pragma("unroll") for (int ks_ = 0; ks_ < 4; ++ks_) { const s16x4 lo_ = tr16(vp0 + 16 * ks_ * VP + (et) * 64), hi_ = tr16(vp0 + (16 * ks_ + 8) * VP + (et) * 64); dst[ks_] = __builtin_shufflevector(lo_, hi_, 0, 1, 2, 3, 4, 5, 6, 7); } } while (0)
                    ATT_VLOAD(vf[0], 0);
#pragma unroll
                    for (int et = 0; et < 4; ++et) {
                        if (et < 3) ATT_VLOAD(vf[(et + 1) & 1], et + 1);
                        __builtin_amdgcn_sched_barrier(0);
#pragma unroll
                        for (int ks = 0; ks < 4; ++ks) o[et] = MFMA32(vf[et & 1][ks], pf[ks], o[et]);
                        __builtin_amdgcn_sched_barrier(0); }
#undef ATT_VLOAD
                }
            }
            if (more) ATT_STORET((j + 1) & 1);
            if (j == 1 && ntu > 2) {
                float mmin = m;
#pragma unroll
                for (int o2 = 1; o2 < 32; o2 <<= 1) mmin = fminf(mmin, __shfl_xor(mmin, o2));
                const float x = (mmin - 50.f - bc - 63.f * slope2) / (64.f * slope2);
                int ktlo = x > 0.f ? (int)ceilf(x) : 0; if (ktlo > ntu - 2) ktlo = ntu - 2;
                if (lane == 0) ((LAS int*)(KNW + 32))[w] = ktlo; }
            __syncthreads();
            if (j == 1 && ntu > 2) { int lo8 = ntu; for (int w8 = 0; w8 < 8; ++w8) { const int v8 = ((LAS const int*)(KNW + 32))[w8]; lo8 = v8 < lo8 ? v8 : lo8; } nj = ntu - lo8; }
        }
#undef ATT_LOADT
#undef ATT_STORET
        l = xhalf_sum(l);
        const float inv = 1.0f / l;
#ifdef LSE_DIAG
        if (c == 0 && hi == 0) ((float*)(F.ws + WS_GATE))[(rowb + qpos) * 8 + h] = (m + log2f(l) - slope2 * (float)qpos) * 0.6931471805599453f;
#endif
        if (c == 1) {
#pragma unroll
            for (int et = 0; et < 4; ++et)
#pragma unroll
                for (int r = 0; r < 16; ++r) XCH[((g * 64 + et * 16 + r) * 2 + hi) * 32 + r32] = o[et][r] * inv;
        }
        __syncthreads();
        if (c == 0) {
            float ss = 0.f;
#pragma unroll
            for (int et = 0; et < 4; ++et)
#pragma unroll
                for (int r = 0; r < 16; ++r) { const float v = o[et][r] * inv - lam_full * XCH[((g * 64 + et * 16 + r) * 2 + hi) * 32 + r32]; o[et][r] = v; ss += v * v; }
            ss = xhalf_sum(ss);
            const float rn = rsqrtf(ss * (1.f / 128.f) + EPS) * (1.f - LAMBDA_INIT);
            const float* sg = F.in[I_ASUBLN];
            bf16* orow = Ob + (rowb + qpos) * 1024 + h * 128;
#pragma unroll
            for (int et = 0; et < 4; ++et)
#pragma unroll
                for (int r4 = 0; r4 < 4; ++r4) { const int e0 = et * 32 + 8 * r4 + 4 * hi; const f32x4 gv = *(const GAS f32x4*)(sg + e0);
                    v2u wv; wv.x = pk2(o[et][4 * r4 + 0] * rn * gv.x, o[et][4 * r4 + 1] * rn * gv.y); wv.y = pk2(o[et][4 * r4 + 2] * rn * gv.z, o[et][4 * r4 + 3] * rn * gv.w);
                    *(GAS v2u*)(orow + e0) = wv; }
        }
    }
    }
    __syncthreads();
}
#define HAVE_ML 1
#define MFMA16(a, b, c) __builtin_amdgcn_mfma_f32_16x16x32_bf16((a), (b), (c), 0, 0, 0)
constexpr float KSCALE = 0.04419417382415922f;
constexpr size_t WS_XM = A_(128), WS_QB = A_(0), WS_KB = A_(256), WS_ZB = A_(256), WS_H2B = A_(0);
constexpr size_t WS_WC = WS_TAB + 64 * 1024;
constexpr size_t WS_WPP = WS_TAB + 128 * 1024;
constexpr size_t WS_WVF = WS_TAB + 192 * 1024;
__device__ __forceinline__ f32x4 bf4_to_f32(v2u w) { return (f32x4){bf_lo(w.x), bf_hi(w.x), bf_lo(w.y), bf_hi(w.y)}; }
__device__ __forceinline__ v2u f32_to_bf4(f32x4 v) { v2u w; w.x = pk2(v.x, v.y); w.y = pk2(v.z, v.w); return w; }
__device__ __forceinline__ f32x4 conv_silu(const f32x4 (&xm)[4], const f32x4 (&cw)[4], f32x4 cb) {
    f32x4 a = cb + xm[0] * cw[0] + xm[1] * cw[1] + xm[2] * cw[2] + xm[3] * cw[3];
    return (f32x4){fsilu(a.x), fsilu(a.y), fsilu(a.z), fsilu(a.w)};
}
__device__ __forceinline__ f32x4 hw4(f32x4 x, const f32x4 (&w)[4]) { return w[0] * x.x + w[1] * x.y + w[2] * x.z + w[3] * x.w; }

__device__ __forceinline__ void p_mlprep(Frame& F) {
    const float* wg = F.in[I_WGATE];
    for (int e = (int)blockIdx.x * 512 + F.tid; e < 2048 * 8; e += F.G * 512) { const int f = e >> 3, o = e & 7, g = f >> 2, i = f & 3; float s = 0.f, c = 0.f;
#pragma unroll
        for (int o2 = 0; o2 < 4; ++o2) { s += F.in[I_WV][g * 16 + i * 4 + o2] * wg[(size_t)(4096 + 4 * g + o2) * 8 + o];
            c += F.in[I_WQ][g * 16 + i * 4 + o2] * wg[(size_t)(4 * g + o2) * 8 + o] + F.in[I_WK][g * 16 + i * 4 + o2] * wg[(size_t)(2048 + 4 * g + o2) * 8 + o]; }
        ((float*)(F.ws + WS_WVF))[e] = s; ((float*)(F.ws + WS_WC))[e] = c; }
}
__device__ __forceinline__ void p_mlprep2(Frame& F) {
    LAS float* red = (LAS float*)F.lds;
    const float* wvf = (const float*)(F.ws + WS_WVF);
    f32x4 wv[8];
#pragma unroll
    for (int i = 0; i < 8; ++i) wv[i] = *(const GAS f32x4*)(wvf + (size_t)F.tid * 32 + 4 * i);
    for (int d0 = 4 * (int)blockIdx.x; d0 < 1024; d0 += 4 * F.G) {
        f32x4 wi[4];
#pragma unroll
        for (int dl = 0; dl < 4; ++dl) wi[dl] = __builtin_nontemporal_load((const f32x4*)(F.in[I_MWIN] + (size_t)(d0 + dl) * 4096 + 4 * F.tid));
#pragma unroll
        for (int dl = 0; dl < 4; ++dl) { f32x4 a0 = wv[0] * wi[dl].x + wv[2] * wi[dl].y + wv[4] * wi[dl].z + wv[6] * wi[dl].w, a1 = wv[1] * wi[dl].x + wv[3] * wi[dl].y + wv[5] * wi[dl].z + wv[7] * wi[dl].w;
            a0.x = wave_sum(a0.x); a0.y = wave_sum(a0.y); a0.z = wave_sum(a0.z); a0.w = wave_sum(a0.w); a1.x = wave_sum(a1.x); a1.y = wave_sum(a1.y); a1.z = wave_sum(a1.z); a1.w = wave_sum(a1.w);
            if (F.lane == 0) { *(LAS f32x4*)(red + (dl * 8 + F.wave) * 8) = a0; *(LAS f32x4*)(red + (dl * 8 + F.wave) * 8 + 4) = a1; } }
        __syncthreads();
        if (F.tid < 32) { const int dl = F.tid >> 3, o = F.tid & 7; float s2 = 0.f;
#pragma unroll
            for (int w8 = 0; w8 < 8; ++w8) s2 += red[(dl * 8 + w8) * 8 + o];
            ((float*)(F.ws + WS_WPP))[(d0 + dl) * 8 + o] = s2; }
        __syncthreads();
    }
}

__device__ __forceinline__ void p_normb(Frame& F, const bf16* Y, const float* gpost, const float* modg, const float* gn, const float* modn, bf16* Hout) {
    LAS float* wr = (LAS float*)F.lds;
    for (int e = F.tid; e < 8192 / 4; e += 512) ((LAS f32x4*)wr)[e] = ((const GAS f32x4*)(F.ws + WS_WPP))[e];
    __syncthreads();
    float* G = (float*)(F.ws + WS_GATE); const int lane = F.lane;
    ROWBLOCK(m0, m1);
    const bf16* Xb = (const bf16*)F.X;
    Row16 ynx = load_row_bf16_nt(Y + (size_t)m0 * D, lane), xnx = load_row_bf16_nt(Xb + (size_t)m0 * D, lane);
    for (int m = m0; m < m1; ++m) { const int b = m >> 11; const float* mb = modn + (size_t)b * 6144;
        const Row16 gp = load_row_f32(gpost, lane), gt = load_row_f32(modg + (size_t)b * 6144 + 5 * 1024, lane);
        const Row16 y = ynx, xo = xnx; if (m + 1 < m1) { ynx = load_row_bf16_nt(Y + (size_t)(m + 1) * D, lane); xnx = load_row_bf16_nt(Xb + (size_t)(m + 1) * D, lane); }
        const float r1 = rsqrtf(row_ss(y) * (1.f / D) + EPS);
        Row16 xn;
#pragma unroll
        for (int j = 0; j < 4; ++j) xn.v[j] = xo.v[j] + gt.v[j] * (y.v[j] * r1 * gp.v[j]);
        xn = round_row_bf16(xn);
        store_row_bf16_nt((bf16*)F.X + (size_t)m * D, lane, xn);
        const float r2 = rsqrtf(row_ss(xn) * (1.f / D) + EPS);
        const Row16 gg = load_row_f32(gn, lane), sc = load_row_f32(mb + 1024, lane), sh = load_row_f32(mb, lane); Row16 h;
#pragma unroll
        for (int j = 0; j < 4; ++j) h.v[j] = xn.v[j] * r2 * gg.v[j] * (sc.v[j] + 1.0f) + sh.v[j];
        store_row_bf16(Hout + (size_t)m * D, lane, h);
        store_row_bf16_nt((bf16*)F.X + (size_t)T * D + (size_t)m * D, lane, h);
        f32x4 a0 = {0.f, 0.f, 0.f, 0.f}, a1 = {0.f, 0.f, 0.f, 0.f};
#pragma unroll
        for (int j = 0; j < 4; ++j)
#pragma unroll
            for (int c = 0; c < 4; ++c) { const int f = 4 * lane + 256 * j + c; const float hv = h.v[j][c];
                a0 += *(LAS const f32x4*)(wr + f * 8) * hv; a1 += *(LAS const f32x4*)(wr + f * 8 + 4) * hv; }
#pragma unroll
        for (int o = 1; o < 64; o <<= 1) { a0.x += __shfl_xor(a0.x, o); a0.y += __shfl_xor(a0.y, o); a0.z += __shfl_xor(a0.z, o); a0.w += __shfl_xor(a0.w, o);
            a1.x += __shfl_xor(a1.x, o); a1.y += __shfl_xor(a1.y, o); a1.z += __shfl_xor(a1.z, o); a1.w += __shfl_xor(a1.w, o); }
        if (lane == 0) { const f32x4 b0 = *(const GAS f32x4*)F.in[I_BGATE], b1 = *(const GAS f32x4*)(F.in[I_BGATE] + 4); *(GAS f32x4*)(G + (size_t)m * 8) = a0 + b0; *(GAS f32x4*)(G + (size_t)m * 8 + 4) = a1 + b1; }
    }
    __syncthreads();
}
__device__ __forceinline__ void p_h2b(Frame& F, const float* gn, const float* modn, bf16* Hout) {
    ROWBLOCK(m0, m1); int bc = -1; const Row16 gg = load_row_f32(gn, F.lane); Row16 sc, sh;
    const bf16* Xb = (const bf16*)F.X;
    Row16 xnx = load_row_bf16(Xb + (size_t)m0 * D, F.lane);
    for (int m = m0; m < m1; ++m) { const int b = m >> 11;
        if (b != bc) { bc = b; const float* mb = modn + (size_t)b * 6144; sc = load_row_f32(mb + 1024, F.lane); sh = load_row_f32(mb, F.lane); }
        const Row16 x = xnx; if (m + 1 < m1) xnx = load_row_bf16(Xb + (size_t)(m + 1) * D, F.lane);
        const float rstd = rsqrtf(row_ss(x) * (1.f / D) + EPS); Row16 h;
#pragma unroll
        for (int j = 0; j < 4; ++j) h.v[j] = x.v[j] * rstd * gg.v[j] * (sc.v[j] + 1.0f) + sh.v[j];
        store_row_bf16(Hout + (size_t)m * D, F.lane, h); }
}

__device__ __forceinline__ void p_gates2(Frame& F) {
    const bf16* XM = (const bf16*)(F.ws + WS_XM); float* G = (float*)(F.ws + WS_GATE); bf16* QB = (bf16*)(F.ws + WS_QB); bf16* KB = (bf16*)(F.ws + WS_KB);
    const int tid = F.tid, fg = tid, f0 = 4 * fg, lane = F.lane, l15 = lane & 15, q4 = lane >> 4, w = F.wave;
    constexpr int AP = 4112;
    LAS unsigned char* At = F.lds; LAS float* Pt = (LAS float*)(F.lds + 16 * AP);
    f32x4 cw[4], cb, wq[4], wk[4];
#pragma unroll
    for (int j = 0; j < 4; ++j) cw[j] = *(const GAS f32x4*)(F.in[I_CONVW] + j * 2048 + f0);
    cb = *(const GAS f32x4*)(F.in[I_CONVB] + f0);
#pragma unroll
    for (int i = 0; i < 4; ++i) { wq[i] = *(const GAS f32x4*)(F.in[I_WQ] + fg * 16 + i * 4); wk[i] = *(const GAS f32x4*)(F.in[I_WK] + fg * 16 + i * 4) * KSCALE; }
    bf16x8 bfr[8];
    { const float* wc = (const float*)(F.ws + WS_WC);
#pragma unroll
        for (int ks = 0; ks < 8; ++ks) { float v[8];
#pragma unroll
            for (int j = 0; j < 8; ++j) v[j] = l15 < 8 ? wc[(size_t)(256 * w + 32 * ks + 8 * q4 + j) * 8 + l15] : 0.f;
            v4u pw; pw.x = pk2(v[0], v[1]); pw.y = pk2(v[2], v[3]); pw.z = pk2(v[4], v[5]); pw.w = pk2(v[6], v[7]); bfr[ks] = __builtin_bit_cast(bf16x8, pw); } }
    const int vcu = F.gw >> 3;
    for (int run = vcu; run < T / 128; run += F.G) {
        const int t0 = run * 128, tb = t0 & (S - 1);
        f32x4 xm[4];
#pragma unroll
        for (int j = 0; j < 3; ++j) { const int tt = tb - 3 + j; xm[j + 1] = tt >= 0 ? bf4_to_f32(*(const GAS v2u*)(XM + (size_t)(t0 - 3 + j) * 2048 + f0)) : (f32x4){0.f, 0.f, 0.f, 0.f}; }
        for (int sb = 0; sb < 8; ++sb) {
            v2u xin[16];
#pragma unroll
            for (int tt = 0; tt < 16; ++tt) xin[tt] = __builtin_nontemporal_load((const v2u*)(XM + ((size_t)t0 + 16 * sb + tt) * 2048 + f0));
#pragma unroll
            for (int tt = 0; tt < 16; ++tt) { const size_t t = (size_t)t0 + 16 * sb + tt;
                xm[0] = xm[1]; xm[1] = xm[2]; xm[2] = xm[3];
                xm[3] = bf4_to_f32(xin[tt]);
                const f32x4 xc = conv_silu(xm, cw, cb);
                *(GAS v2u*)(QB + t * 2048 + f0) = f32_to_bf4(hw4(xc, wq));
                *(GAS v2u*)(KB + t * 2048 + f0) = f32_to_bf4(hw4(xc, wk));
                *(LAS v2u*)(At + tt * AP + fg * 8) = f32_to_bf4(xc); }
            __syncthreads();
            f32x4 acc = {0.f, 0.f, 0.f, 0.f};
#pragma unroll
            for (int ks = 0; ks < 8; ++ks) { const bf16x8 af = *(LAS const bf16x8*)(At + l15 * AP + (256 * w + 32 * ks + 8 * q4) * 2); acc = MFMA16(af, bfr[ks], acc); }
            if (l15 < 8) {
#pragma unroll
                for (int r = 0; r < 4; ++r) Pt[(w * 16 + 4 * q4 + r) * 8 + l15] = acc[r]; }
            __syncthreads();
            if (tid < 128) { const int tt = tid >> 3, o = tid & 7; float s = 0.f;
#pragma unroll
                for (int w8 = 0; w8 < 8; ++w8) s += Pt[(w8 * 16 + tt) * 8 + o];
                G[((size_t)t0 + 16 * sb + tt) * 8 + o] += s; }
        }
        __syncthreads();
    }
}

struct CellLds { static constexpr int QP = 528, VP = 288, WP = 144;
    static constexpr int QH = 0, KH = 64 * QP, VV = 2 * 64 * QP, WW = VV + 64 * VP, SC = WW + 64 * WP, NQP = SC + 2048  , PB = NQP + 2048  , END = PB + 3 * 8192 + 256; };
static_assert(CellLds::END <= RING_BYTES, "cell LDS map");
constexpr int SC_E1 = 0, SC_A = 64, SC_INTER = 128, SC_WS = 192, SC_EMT = 256, SC_HDEN = 320, SC_DECAY = 384, SC_MPREV = 385;

__device__ __forceinline__ bf16x8 cell_vfrag(LAS unsigned char* lds, int ks, int w, int q, int qq, int pp) {
    LAS const char* vp = (LAS const char*)(lds + CellLds::VV + (32 * ks + 8 * q + qq) * CellLds::VP + (16 * w + 4 * pp) * 2);
    const s16x4 lo = tr16(vp), hi4 = tr16(vp + 4 * CellLds::VP);
    return __builtin_shufflevector(lo, hi4, 0, 1, 2, 3, 4, 5, 6, 7);
}
__device__ __forceinline__ void cell_issue(v4u (&qk)[8], const bf16* QB, const bf16* KB, size_t row0, int h, int P, int tid) {
    const size_t off = (row0 + (tid >> 3)) * 2048 + h * 512 + 256 * P + (tid & 7) * 8;
#pragma unroll
    for (int i = 0; i < 4; ++i) { qk[i] = *(const GAS v4u*)(QB + off + 64 * i); qk[4 + i] = *(const GAS v4u*)(KB + off + 64 * i); }
}
__device__ __forceinline__ void cell_commit(const v4u (&qk)[8], LAS unsigned char* lds, int tid) {
    LAS unsigned char* p = lds + (tid >> 3) * CellLds::QP + (tid & 7) * 16;
#pragma unroll
    for (int i = 0; i < 4; ++i) { *(LAS v4u*)(p + CellLds::QH + 128 * i) = qk[i]; *(LAS v4u*)(p + CellLds::KH + 128 * i) = qk[4 + i]; }
}

template <int P>
__device__ __forceinline__ void cell_half_a(LAS unsigned char* lds, v2u (&ct)[32], f32x4 (&nt)[4], f32x4 (&zt)[4], f32x4 (&sacc)[2], int w, int lane) {
    using CL = CellLds;
    const int l15 = lane & 15, q = lane >> 4, qq = l15 >> 2, pp = l15 & 3;
    LAS const float* sc = (LAS const float*)(lds + CL::SC);
    { const int tt = w >> 1, st0 = 2 * (w & 1);
#pragma unroll
        for (int ks = 0; ks < 8; ++ks) { const bf16x8 af = *(LAS const bf16x8*)(lds + CL::QH + (16 * tt + l15) * CL::QP + (32 * ks + 8 * q) * 2);
#pragma unroll
            for (int j = 0; j < 2; ++j) { const bf16x8 bfr = *(LAS const bf16x8*)(lds + CL::KH + (16 * (st0 + j) + l15) * CL::QP + (32 * ks + 8 * q) * 2); sacc[j] = MFMA16(af, bfr, sacc[j]); } } }
#pragma unroll
    for (int kk = 0; kk < 8; ++kk) { const v2u c0 = ct[16 * P + 2 * kk], c1 = ct[16 * P + 2 * kk + 1];
        v4u aw; aw.x = c0.x; aw.y = c0.y; aw.z = c1.x; aw.w = c1.y;
        const bf16x8 af = __builtin_bit_cast(bf16x8, aw);
#pragma unroll
        for (int tt = 0; tt < 4; ++tt) { LAS const unsigned char* qp = lds + CL::QH + (16 * tt + l15) * CL::QP + (32 * kk + 4 * q) * 2;
            const v2u lo = *(LAS const v2u*)qp, hi2 = *(LAS const v2u*)(qp + 32);
            v4u bw; bw.x = lo.x; bw.y = lo.y; bw.z = hi2.x; bw.w = hi2.y;
            zt[tt] = MFMA16(af, __builtin_bit_cast(bf16x8, bw), zt[tt]); } }
    const bool mine = (w >> 2) == P;
    const int dl0 = 4 * (w & 3);
    if (mine) {
#pragma unroll
        for (int tt = 0; tt < 4; ++tt) { f32x4 nz = {0.f, 0.f, 0.f, 0.f};
#pragma unroll
            for (int k2 = 0; k2 < 2; ++k2) { v4u aw; aw.x = cvtpk(nt[2 * k2].x, nt[2 * k2].y); aw.y = cvtpk(nt[2 * k2].z, nt[2 * k2].w); aw.z = cvtpk(nt[2 * k2 + 1].x, nt[2 * k2 + 1].y); aw.w = cvtpk(nt[2 * k2 + 1].z, nt[2 * k2 + 1].w);
                LAS const unsigned char* qp = lds + CL::QH + (16 * tt + l15) * CL::QP + (32 * ((dl0 >> 1) + k2) + 4 * q) * 2;
                const v2u lo = *(LAS const v2u*)qp, hi2 = *(LAS const v2u*)(qp + 32);
                v4u bw; bw.x = lo.x; bw.y = lo.y; bw.z = hi2.x; bw.w = hi2.y;
                nz = MFMA16(__builtin_bit_cast(bf16x8, aw), __builtin_bit_cast(bf16x8, bw), nz); }
            if (q == 0) ((LAS float*)(lds + CL::NQP))[w * 64 + 16 * tt + l15] = nz.x; } }
}
template <int P>
__device__ __forceinline__ void cell_half_b(LAS unsigned char* lds, v2u (&ct)[32], f32x4 (&nt)[4], int w, int lane, float decay, float wsoff, LAS const float* pa) {
    using CL = CellLds;
    const int l15 = lane & 15, q = lane >> 4, qq = l15 >> 2, pp = l15 & 3;
    LAS const float* sc = (LAS const float*)(lds + CL::SC);
    const bool mine = (w >> 2) == P;
    {
        bf16x8 vpf[2], wsf[2];
#pragma unroll
        for (int ks = 0; ks < 2; ++ks) { const bf16x8 vfr = cell_vfrag(lds, ks, w, q, qq, pp);
            f32x4 w0 = *(LAS const f32x4*)(pa + 32 * ks + 8 * q) + wsoff, w1 = *(LAS const f32x4*)(pa + 32 * ks + 8 * q + 4) + wsoff;
            w0 = (f32x4){__expf(w0.x), __expf(w0.y), __expf(w0.z), __expf(w0.w)}; w1 = (f32x4){__expf(w1.x), __expf(w1.y), __expf(w1.z), __expf(w1.w)};
            const v4u vw = __builtin_bit_cast(v4u, vfr); v4u ow;
            ow.x = cvtpk(bf_lo(vw.x) * w0.x, bf_hi(vw.x) * w0.y); ow.y = cvtpk(bf_lo(vw.y) * w0.z, bf_hi(vw.y) * w0.w); ow.z = cvtpk(bf_lo(vw.z) * w1.x, bf_hi(vw.z) * w1.y); ow.w = cvtpk(bf_lo(vw.w) * w1.z, bf_hi(vw.w) * w1.w);
            vpf[ks] = __builtin_bit_cast(bf16x8, ow);
            v4u sw; if (l15 == 0) { sw.x = cvtpk(w0.x, w0.y); sw.y = cvtpk(w0.z, w0.w); sw.z = cvtpk(w1.x, w1.y); sw.w = cvtpk(w1.z, w1.w); } else { sw = (v4u){0u, 0u, 0u, 0u}; }
            wsf[ks] = __builtin_bit_cast(bf16x8, sw); }
#pragma unroll
        for (int dt = 0; dt < 16; ++dt) { f32x4 acc = bf4_to_f32(ct[16 * P + dt]) * decay;
            f32x4 nacc = {0.f, 0.f, 0.f, 0.f}; const bool nmine = mine && (dt >> 2) == (w & 3);
            if (nmine) nacc = nt[dt & 3] * decay;
#pragma unroll
            for (int ks = 0; ks < 2; ++ks) { LAS const char* kp = (LAS const char*)(lds + CL::KH + (32 * ks + 8 * q + qq) * CL::QP + (16 * dt + 4 * pp) * 2);
                const s16x4 lo = tr16(kp), hi4 = tr16(kp + 4 * CL::QP);
                const bf16x8 kf = __builtin_shufflevector(lo, hi4, 0, 1, 2, 3, 4, 5, 6, 7);
                acc = MFMA16(kf, vpf[ks], acc);
                if (nmine) nacc = MFMA16(kf, wsf[ks], nacc); }
            v2u cw2; cw2.x = cvtpk(acc.x, acc.y); cw2.y = cvtpk(acc.z, acc.w); ct[16 * P + dt] = cw2;
            if (nmine) nt[dt & 3] = nacc; } }
}

__device__ __forceinline__ void p_cell2(Frame& F) {
    using CL = CellLds;
    const bf16* XM = (const bf16*)(F.ws + WS_XM); const bf16* QB = (const bf16*)(F.ws + WS_QB); const bf16* KB = (const bf16*)(F.ws + WS_KB);
    const float* G = (const float*)(F.ws + WS_GATE); bf16* HH = (bf16*)(F.ws + WS_HH);
    LAS unsigned char* lds = F.lds;
    LAS float* sc = (LAS float*)(lds + CL::SC);
    LAS float* PB = (LAS float*)(lds + CL::PB); LAS float* PA = PB + 2048; LAS float* PM = PA + 2048; LAS float* BL = PM + 2048; LAS float* AM = BL + 32;
    const int w = F.wave;
#define CELL_LANE() ({ int l_ = (int)__builtin_amdgcn_mbcnt_hi(~0u, __builtin_amdgcn_mbcnt_lo(~0u, 0u)); asm volatile("" : "+v"(l_)); l_; })
    const int vcu = F.gw >> 3;
    for (int wi = vcu; wi < B * NH * 4; wi += F.G) {
        const int vs = wi & 3, h = (wi >> 2) & 3, b = wi >> 4;
        v2u ct[32]; f32x4 nt[4];
#pragma unroll
        for (int i = 0; i < 32; ++i) ct[i] = (v2u){0u, 0u};
#pragma unroll
        for (int i = 0; i < 4; ++i) nt[i] = (f32x4){0.f, 0.f, 0.f, 0.f};
        __syncthreads();
        { const int lane0 = CELL_LANE();
#pragma unroll 1
            for (int cc = 0; cc < 4; ++cc) { const int ch = 4 * w + cc; const size_t r = (size_t)b * S + 64 * ch + lane0;
                const float ip = G[r * 8 + h], fp_ = G[r * 8 + 4 + h];
                float bcum = fminf(fp_, 0.f) - __logf(1.f + __expf(-fabsf(fp_)));
#pragma unroll
                for (int o = 1; o < 64; o <<= 1) { const float t2 = __shfl_up(bcum, o); if (lane0 >= o) bcum += t2; }
                const float a = ip - bcum; float pm = a;
#pragma unroll
                for (int o = 1; o < 64; o <<= 1) { const float t2 = __shfl_up(pm, o); if (lane0 >= o) pm = fmaxf(pm, t2); }
                PB[64 * ch + lane0] = bcum; PA[64 * ch + lane0] = a; PM[64 * ch + lane0] = pm;
                if (lane0 == 63) { BL[ch] = bcum; AM[ch] = pm; } } }
        __syncthreads();
        float mprev = 0.f;
#define CELL_DMA0(rowp, lane_) do { if ((lane_) < 32) { _Pragma("unroll") for (int r_ = 0; r_ < 8; ++r_) { const int row_ = 8 * w + r_; const size_t go_ = ((rowp) + row_) * 2048 + h * 512 + (lane_) * 8; \
            __builtin_amdgcn_global_load_lds((const GAS unsigned*)(QB + go_), (LAS unsigned*)(lds + CL::QH + row_ * CL::QP), 16, 0, 0); \
            __builtin_amdgcn_global_load_lds((const GAS unsigned*)(KB + go_), (LAS unsigned*)(lds + CL::KH + row_ * CL::QP), 16, 0, 0); } } } while (0)
        { const int l0_ = CELL_LANE(); CELL_DMA0((size_t)b * S, l0_); }
#define CELL_VLOAD(xv, rowp, tid_) do { const int vg_ = (tid_) & 31, t4_ = 4 * ((tid_) >> 5), fv_ = h * 512 + vs * 128 + 4 * vg_; \
            _Pragma("unroll") for (int t_ = 0; t_ < 4; ++t_) xv[t_] = __builtin_nontemporal_load((const v2u*)(XM + ((rowp) + t4_ + t_) * 2048 + fv_)); } while (0)
#define CELL_VCOMMIT(xv, tid_) do { const int vg_ = (tid_) & 31, t4_ = 4 * ((tid_) >> 5), fv_ = h * 512 + vs * 128 + 4 * vg_; f32x4 wv_[4]; \
            _Pragma("unroll") for (int i_ = 0; i_ < 4; ++i_) wv_[i_] = *(const GAS f32x4*)(F.in[I_WV] + (size_t)(fv_ >> 2) * 16 + i_ * 4); \
            _Pragma("unroll") for (int t_ = 0; t_ < 4; ++t_) *(LAS v2u*)(lds + CL::VV + (t4_ + t_) * CL::VP + vg_ * 8) = f32_to_bf4(hw4(bf4_to_f32(xv[t_]), wv_)); } while (0)
        { const int t0_ = w * 64 + CELL_LANE(); v2u x0[4]; CELL_VLOAD(x0, (size_t)b * S, t0_); CELL_VCOMMIT(x0, t0_); }
        for (int c = 0; c < S / 64; ++c) {
            const int tid = w * 64 + CELL_LANE();
            const int lane = tid & 63, l15 = lane & 15, q = lane >> 4, qq = l15 >> 2, pp = l15 & 3;
            const size_t row0 = (size_t)b * S + 64 * c;
            const float blast = BL[c], mnew = fmaxf(blast + mprev, blast + AM[c]), decay = __expf(blast + mprev - mnew);
            asm volatile("s_waitcnt vmcnt(0)" ::: "memory");
            __syncthreads();
            f32x4 zt[4], sacc[2];
#pragma unroll
            for (int i = 0; i < 4; ++i) zt[i] = (f32x4){0.f, 0.f, 0.f, 0.f};
            sacc[0] = (f32x4){0.f, 0.f, 0.f, 0.f}; sacc[1] = sacc[0];
            cell_half_a<0>(lds, ct, nt, zt, sacc, w, lane);
            v4u qk[8]; cell_issue(qk, QB, KB, row0, h, 1, tid);
            cell_half_b<0>(lds, ct, nt, w, lane, decay, blast - mnew, PA + 64 * c);
            __syncthreads();
            cell_commit(qk, lds, tid);
            __syncthreads();
            { int l3 = lane; asm volatile("" : "+v"(l3)); cell_half_a<1>(lds, ct, nt, zt, sacc, w, l3);
              cell_half_b<1>(lds, ct, nt, w, l3, decay, blast - mnew, PA + 64 * c); }
            { const int tt = w >> 1, st0 = 2 * (w & 1);
#pragma unroll
                for (int j = 0; j < 2; ++j) { const int s = 16 * (st0 + j) + l15; const float as = PA[64 * c + s];
#pragma unroll
                    for (int r = 0; r < 4; ++r) { const int t = 16 * tt + 4 * q + r; const float wv2 = s <= t ? __expf(as - fmaxf(mprev, PM[64 * c + t])) * sacc[j][r] : 0.f;
                        *(LAS bf16*)(lds + CL::WW + t * CL::WP + s * 2) = (bf16)f2bf(wv2); } } }
            __syncthreads();
            if (c + 1 < S / 64) CELL_DMA0(row0 + 64, lane);
            { const int t = tid >> 3, part = tid & 7; const v4u ww = *(LAS const v4u*)(lds + CL::WW + t * CL::WP + part * 16);
                float ds = (bf_lo(ww.x) + bf_hi(ww.x)) + (bf_lo(ww.y) + bf_hi(ww.y)) + (bf_lo(ww.z) + bf_hi(ww.z)) + (bf_lo(ww.w) + bf_hi(ww.w));
                float nqv = ((LAS const float*)(lds + CL::NQP))[part * 64 + t];
                ds += __shfl_xor(ds, 1); ds += __shfl_xor(ds, 2); ds += __shfl_xor(ds, 4);
                nqv += __shfl_xor(nqv, 1); nqv += __shfl_xor(nqv, 2); nqv += __shfl_xor(nqv, 4);
                if (part == 0) { const float mxp = fmaxf(mprev, PM[64 * c + t]); const float den = ds + __expf(mprev - mxp) * nqv; sc[SC_HDEN + t] = 1.0f / fmaxf(fabsf(den), __expf(-(PB[64 * c + t] + mxp))); } }
#pragma unroll
            for (int tt = 0; tt < 4; ++tt) { zt[tt] = zt[tt] * __expf(mprev - fmaxf(mprev, PM[64 * c + 16 * tt + l15]));
#pragma unroll
                for (int ks = 0; ks < 2; ++ks) { const bf16x8 wf = *(LAS const bf16x8*)(lds + CL::WW + (16 * tt + l15) * CL::WP + (32 * ks + 8 * q) * 2); zt[tt] = MFMA16(cell_vfrag(lds, ks, w, q, qq, pp), wf, zt[tt]); } }
            v2u xn[4]; const int tid6 = w * 64 + CELL_LANE();
            if (c + 1 < S / 64) CELL_VLOAD(xn, row0 + 64, tid6);
            __syncthreads();
#pragma unroll
            for (int tt = 0; tt < 4; ++tt) { const int t = 16 * tt + l15; const f32x4 o = zt[tt] * sc[SC_HDEN + t];
                *(GAS v2u*)(HH + (row0 + t) * 2048 + h * 512 + vs * 128 + 16 * w + 4 * q) = f32_to_bf4(o); }
            if (c + 1 < S / 64) CELL_VCOMMIT(xn, tid6);
            mprev = mnew;
        }
#undef CELL_DMA0
#undef CELL_VLOAD
#undef CELL_VCOMMIT
#undef CELL_LANE
    }
    __syncthreads();
}

__device__ __forceinline__ void p_post(Frame& F) {
    const bf16* XM = (const bf16*)(F.ws + WS_XM); const bf16* ZB = (const bf16*)(F.ws + WS_ZB); bf16* HH = (bf16*)(F.ws + WS_HH);
    const int lane = F.lane;
    const int per = (T + F.NGW - 1) / F.NGW;
    for (int hd = 0; hd < NH; ++hd) {
        const int f0 = hd * 512 + 8 * lane;
        f32x4 cw[4][2], cb[2], sk[2], gn[2];
#pragma unroll
        for (int u = 0; u < 2; ++u) {
#pragma unroll
            for (int j = 0; j < 4; ++j) cw[j][u] = *(const GAS f32x4*)(F.in[I_CONVW] + j * 2048 + f0 + 4 * u);
            cb[u] = *(const GAS f32x4*)(F.in[I_CONVB] + f0 + 4 * u); sk[u] = *(const GAS f32x4*)(F.in[I_SKIP] + f0 + 4 * u); gn[u] = *(const GAS f32x4*)(F.in[I_MNORM] + f0 + 4 * u); }
        const int t0 = F.gw * per, t1 = (t0 + per < T) ? t0 + per : T;
        v4u xr[4];
#pragma unroll
        for (int j = 0; j < 3; ++j) { const int tt = t0 - 3 + j; xr[j + 1] = (tt >= 0 && (tt >> 11) == (t0 >> 11)) ? *(const GAS v4u*)(XM + (size_t)tt * 2048 + f0) : (v4u){0u, 0u, 0u, 0u}; }
        v4u xnx = __builtin_nontemporal_load((const v4u*)(XM + (size_t)t0 * 2048 + f0)), hnx = __builtin_nontemporal_load((const v4u*)(HH + (size_t)t0 * 2048 + f0)), znx = __builtin_nontemporal_load((const v4u*)(ZB + (size_t)t0 * 2048 + f0));
        for (int t = t0; t < t1; ++t) {
            xr[0] = xr[1]; xr[1] = xr[2]; xr[2] = xr[3]; xr[3] = xnx;
            if ((t & (S - 1)) == 0) { xr[0] = (v4u){0u, 0u, 0u, 0u}; xr[1] = xr[0]; xr[2] = xr[0]; }
            const v4u hw = hnx, zw = znx;
            if (t + 1 < t1) { xnx = __builtin_nontemporal_load((const v4u*)(XM + (size_t)(t + 1) * 2048 + f0)); hnx = __builtin_nontemporal_load((const v4u*)(HH + (size_t)(t + 1) * 2048 + f0)); znx = __builtin_nontemporal_load((const v4u*)(ZB + (size_t)(t + 1) * 2048 + f0)); }
            f32x4 hv[2] = {(f32x4){bf_lo(hw.x), bf_hi(hw.x), bf_lo(hw.y), bf_hi(hw.y)}, (f32x4){bf_lo(hw.z), bf_hi(hw.z), bf_lo(hw.w), bf_hi(hw.w)}};
            float s1 = (hv[0].x + hv[0].y) + (hv[0].z + hv[0].w) + (hv[1].x + hv[1].y) + (hv[1].z + hv[1].w);
            const float mu = wave_sum(s1) * (1.f / 512.f);
            hv[0] = hv[0] - mu; hv[1] = hv[1] - mu;
            float s2 = (hv[0].x * hv[0].x + hv[0].y * hv[0].y) + (hv[0].z * hv[0].z + hv[0].w * hv[0].w) + (hv[1].x * hv[1].x + hv[1].y * hv[1].y) + (hv[1].z * hv[1].z + hv[1].w * hv[1].w);
            const float rstd = rsqrtf(wave_sum(s2) * (1.f / 512.f) + EPS);
            f32x4 acc[2] = {cb[0], cb[1]};
#pragma unroll
            for (int j = 0; j < 4; ++j) { const v4u xw = xr[j];
                acc[0] += (f32x4){bf_lo(xw.x), bf_hi(xw.x), bf_lo(xw.y), bf_hi(xw.y)} * cw[j][0]; acc[1] += (f32x4){bf_lo(xw.z), bf_hi(xw.z), bf_lo(xw.w), bf_hi(xw.w)} * cw[j][1]; }
            const f32x4 z0 = (f32x4){bf_lo(zw.x), bf_hi(zw.x), bf_lo(zw.y), bf_hi(zw.y)}, z1 = (f32x4){bf_lo(zw.z), bf_hi(zw.z), bf_lo(zw.w), bf_hi(zw.w)};
            f32x4 o0 = hv[0] * rstd * gn[0] + sk[0] * (f32x4){fsilu(acc[0].x), fsilu(acc[0].y), fsilu(acc[0].z), fsilu(acc[0].w)};
            f32x4 o1 = hv[1] * rstd * gn[1] + sk[1] * (f32x4){fsilu(acc[1].x), fsilu(acc[1].y), fsilu(acc[1].z), fsilu(acc[1].w)};
            o0 = o0 * (f32x4){fsilu(z0.x), fsilu(z0.y), fsilu(z0.z), fsilu(z0.w)}; o1 = o1 * (f32x4){fsilu(z1.x), fsilu(z1.y), fsilu(z1.z), fsilu(z1.w)};
            v4u ow; ow.x = pk2(o0.x, o0.y); ow.y = pk2(o0.z, o0.w); ow.z = pk2(o1.x, o1.y); ow.w = pk2(o1.z, o1.w);
            *(GAS v4u*)(HH + (size_t)t * 2048 + f0) = ow;
        }
    }
}
#define HAVE_MOE 1
constexpr size_t RT_IDS = 0, RT_WTS = 256 * 1024, RT_POS = 512 * 1024, RT_STOK = 768 * 1024;
static_assert(RT_STOK + (size_t)MPAD * 4 <= 2 * MiB, "route tables");
constexpr int CW_WCNT = 150000;

__device__ __forceinline__ void p_normc(Frame& F, const bf16* Y, const float* gpost, const float* mod1, const float* gn, bf16* Hout) {
    LAS float* wr = (LAS float*)F.lds;
    for (int e = F.tid; e < 8192 / 4; e += 512) ((LAS f32x4*)wr)[e] = ((const GAS f32x4*)F.in[I_WROUTER])[e];
    __syncthreads();
    int* ids = (int*)(F.ws + WS_ROUTE + RT_IDS); float* wts = (float*)(F.ws + WS_ROUTE + RT_WTS);
    int cnt[8];
#pragma unroll
    for (int e = 0; e < 8; ++e) cnt[e] = 0;
    const int lane = F.lane;
    ROWBLOCK(m0, m1);
    for (int m = m0; m < m1; ++m) { const int b = m >> 11; const float* mb = mod1 + (size_t)b * 6144;
        const Row16 gp = load_row_f32(gpost, lane), gt = load_row_f32(mb + 2 * 1024, lane);
        const Row16 y = load_row_bf16_nt(Y + (size_t)m * D, lane), xo = load_row_bf16_nt((const bf16*)F.X + (size_t)m * D, lane);
        const float r1 = rsqrtf(row_ss(y) * (1.f / D) + EPS);
        Row16 xn;
#pragma unroll
        for (int j = 0; j < 4; ++j) xn.v[j] = xo.v[j] + gt.v[j] * (y.v[j] * r1 * gp.v[j]);
        xn = round_row_bf16(xn);
        store_row_bf16_nt((bf16*)(F.ws + WS_XB) + (size_t)m * D, lane, xn);
        const float r2 = rsqrtf(row_ss(xn) * (1.f / D) + EPS);
        const Row16 gg = load_row_f32(gn, lane), sc = load_row_f32(mb + 4 * 1024, lane), sh = load_row_f32(mb + 3 * 1024, lane); Row16 h;
#pragma unroll
        for (int j = 0; j < 4; ++j) h.v[j] = xn.v[j] * r2 * gg.v[j] * (sc.v[j] + 1.0f) + sh.v[j];
        f32x4 a0 = {0.f, 0.f, 0.f, 0.f}, a1 = {0.f, 0.f, 0.f, 0.f};
#pragma unroll
        for (int j = 0; j < 4; ++j)
#pragma unroll
            for (int c = 0; c < 4; ++c) { const int f = 4 * lane + 256 * j + c; const float hv = h.v[j][c];
                a0 += *(LAS const f32x4*)(wr + f * 8) * hv; a1 += *(LAS const f32x4*)(wr + f * 8 + 4) * hv; }
#pragma unroll
        for (int o = 1; o < 64; o <<= 1) { a0.x += __shfl_xor(a0.x, o); a0.y += __shfl_xor(a0.y, o); a0.z += __shfl_xor(a0.z, o); a0.w += __shfl_xor(a0.w, o);
            a1.x += __shfl_xor(a1.x, o); a1.y += __shfl_xor(a1.y, o); a1.z += __shfl_xor(a1.z, o); a1.w += __shfl_xor(a1.w, o); }
        float lg[8] = {a0.x, a0.y, a0.z, a0.w, a1.x, a1.y, a1.z, a1.w};
        const float* br = F.in[I_BROUTER];
        float mx = -1e30f;
#pragma unroll
        for (int e = 0; e < 8; ++e) { lg[e] += br[e]; mx = fmaxf(mx, lg[e]); }
        int i0 = 0; float p0 = -1.f, p1 = -1.f; int i1 = 0;
#pragma unroll
        for (int e = 0; e < 8; ++e) { const float p = __expf(lg[e] - mx); if (p > p0) { p1 = p0; i1 = i0; p0 = p; i0 = e; } else if (p > p1) { p1 = p; i1 = e; } }
        const float inv = 1.0f / (p0 + p1);
        if (lane == 0) { ids[2 * m] = i0; ids[2 * m + 1] = i1; wts[2 * m] = p0 * inv; wts[2 * m + 1] = p1 * inv; }
#pragma unroll
        for (int e = 0; e < 8; ++e) cnt[e] += (i0 == e) + (i1 == e);
    }
    if (lane == 0) { unsigned* wc = (unsigned*)(F.ctl + CW_WCNT) + (size_t)F.gw * 8;
#pragma unroll
        for (int e = 0; e < 8; ++e) wc[e] = (unsigned)cnt[e]; }
    __syncthreads();
    for (int e = 0; e < NE; ++e) {
        convert_matrix(F, F.in[I_EWG] + (size_t)e * 1024 * F2, 1024, F2, (bf16*)(F.ws + WS_WMGU) + (size_t)e * 2 * F2 * 1024, 1);
        convert_matrix(F, F.in[I_EWU] + (size_t)e * 1024 * F2, 1024, F2, (bf16*)(F.ws + WS_WMGU) + (size_t)e * 2 * F2 * 1024, 2);
    }
}

__device__ __forceinline__ void p_sort(Frame& F, const float* gn, const float* mod1) {
    LAS int* sh = (LAS int*)F.lds;
    const unsigned* wc = (const unsigned*)(F.ctl + CW_WCNT);
    const int NW = F.NGW;
    const int myw0 = (F.gw >> 3) << 3;
    { const int e = F.tid & 7, part = F.tid >> 3; int tot = 0, before = 0;
        for (int gwi = part; gwi < NW; gwi += 64) { const int c = (int)wc[(size_t)gwi * 8 + e]; tot += c; if (gwi < myw0) before += c; }
        for (int o = 8; o < 64; o <<= 1) { tot += __shfl_xor(tot, o); before += __shfl_xor(before, o); }
        LAS int* red = sh + 128;
        if (F.lane < 8) { red[(F.wave * 8 + e) * 2] = tot; red[(F.wave * 8 + e) * 2 + 1] = before; }
        __syncthreads();
        if (F.tid < 8) { int t2 = 0, b2 = 0; for (int w8 = 0; w8 < 8; ++w8) { t2 += red[(w8 * 8 + F.tid) * 2]; b2 += red[(w8 * 8 + F.tid) * 2 + 1]; } sh[F.tid] = t2; sh[100 + F.tid] = b2; }
        __syncthreads();
        if (F.tid == 0) { int off = 0; for (int e2 = 0; e2 < 8; ++e2) { sh[8 + e2] = off; off += (sh[e2] + 255) & ~255; } sh[16] = off; }
        if (F.tid < 64) { const int w8 = F.tid >> 3, e2 = F.tid & 7; int bs = sh[100 + e2]; for (int ww = 0; ww < w8; ++ww) bs += (int)wc[(size_t)(myw0 + ww) * 8 + e2]; sh[32 + w8 * 8 + e2] = bs; }
        __syncthreads();
    }
    int* tab = (int*)(F.ws + WS_TAB); int* pos = (int*)(F.ws + WS_ROUTE + RT_POS); const int* ids = (const int*)(F.ws + WS_ROUTE + RT_IDS);
    const int mpadv = sh[16];
    if (blockIdx.x == 0) {
        if (F.tid == 0) { tab[TAB_NPANELS] = mpadv >> 8; for (int e = 0; e <= 8; ++e) tab[TAB_EOFF + e] = sh[8 + e]; }
        for (int p = F.tid; p < (mpadv >> 8); p += 512) { int e = 0; for (int e2 = 1; e2 < 8; ++e2) if (p * 256 >= sh[8 + e2]) e = e2; tab[TAB_PEXP + p] = e; }
    }
    if (F.lane == 0) { int run[8];
#pragma unroll
        for (int e = 0; e < 8; ++e) run[e] = sh[8 + e] + sh[32 + F.wave * 8 + e];
        ROWBLOCK(m0, m1);
        for (int m = m0; m < m1; ++m) {
#pragma unroll
            for (int j = 0; j < 2; ++j) { const int e = ids[2 * m + j]; int p = 0;
#pragma unroll
                for (int e2 = 0; e2 < 8; ++e2) if (e == e2) { p = run[e2]; run[e2] = p + 1; }
                pos[2 * m + j] = p; sh[1024 + F.wave * 64 + 2 * (m - m0) + j] = p; } } }
    { bf16* HS = (bf16*)(F.ws + WS_YM); const bf16* XB = (const bf16*)(F.ws + WS_XB); const int lane = F.lane;
        ROWBLOCK(m0, m1); const Row16 gg = load_row_f32(gn, lane);
        Row16 xnx = load_row_bf16_nt(XB + (size_t)m0 * D, lane);
        for (int m = m0; m < m1; ++m) { const int b = m >> 11; const float* mb = mod1 + (size_t)b * 6144;
            const int p0 = sh[1024 + F.wave * 64 + 2 * (m - m0)], p1 = sh[1024 + F.wave * 64 + 2 * (m - m0) + 1];
            const Row16 xn = xnx; if (m + 1 < m1) xnx = load_row_bf16_nt(XB + (size_t)(m + 1) * D, lane);
            const float r2 = rsqrtf(row_ss(xn) * (1.f / D) + EPS);
            const Row16 sc = load_row_f32(mb + 4 * 1024, lane), shf = load_row_f32(mb + 3 * 1024, lane); Row16 h;
#pragma unroll
            for (int j = 0; j < 4; ++j) h.v[j] = xn.v[j] * r2 * gg.v[j] * (sc.v[j] + 1.0f) + shf.v[j];
            store_row_bf16(HS + (size_t)p0 * D, lane, h); store_row_bf16(HS + (size_t)p1 * D, lane, h); } }
    __syncthreads();
    for (int e = 0; e < NE; ++e) convert_matrix(F, F.in[I_EWD] + (size_t)e * F2 * 1024, F2, 1024, (bf16*)(F.ws + WS_WMD) + (size_t)e * 1024 * F2, 0);
}

constexpr int FINAL_LATE_POS = (MOE_ROUNDS - 1) * PR * 256, FINAL_GUARD = 4096, FINAL_DN_CUS = 32;
static_assert((size_t)(MAXPANELS - (MOE_ROUNDS - 1) * PR) * 256 * F2 * 2 <= (size_t)FINAL_GUARD * D * 4, "the last round's activations sit inside the guarded rows");
static_assert((MAXPANELS - (MOE_ROUNDS - 1) * PR) * 4 <= FINAL_DN_CUS, "the last round's down units fit the reserved workgroups");
template <int MODE>
__device__ __forceinline__ void p_final(Frame& F, const float* gpost, const float* mod1) {
    const bf16* YM = (const bf16*)(F.ws + WS_YM); const int* pos = (const int*)(F.ws + WS_ROUTE + RT_POS); const float* wts = (const float*)(F.ws + WS_ROUTE + RT_WTS);
    const int lane = F.lane;
    int m0, m1;
    if (MODE == 1) { const int nw = (F.G - FINAL_DN_CUS) * NWAVES, we = ((int)blockIdx.x - FINAL_DN_CUS) * NWAVES + F.wave, per = (T + nw - 1) / nw; m0 = we * per; m1 = m0 + per < T ? m0 + per : T; }
    else { const int per = (T + F.NGW - 1) / F.NGW; m0 = F.gw * per; m1 = m0 + per < T ? m0 + per : T; }
    int bc = -1; const Row16 gp = load_row_f32(gpost, lane); Row16 gt;
    for (int m = m0; m < m1; ++m) { const int b = m >> 11;
        const int p0 = pos[2 * m], p1 = pos[2 * m + 1];
        const bool late = m < FINAL_GUARD || p0 >= FINAL_LATE_POS || p1 >= FINAL_LATE_POS;
        if ((MODE == 1 && late) || (MODE == 2 && !late)) continue;
        if (b != bc) { bc = b; gt = load_row_f32(mod1 + (size_t)b * 6144 + 5 * 1024, lane); }
        const float w0 = wts[2 * m], w1 = wts[2 * m + 1];
        const Row16 y0 = load_row_bf16_nt(YM + (size_t)p0 * D, lane), y1 = load_row_bf16_nt(YM + (size_t)p1 * D, lane); Row16 y;
#pragma unroll
        for (int j = 0; j < 4; ++j) y.v[j] = y0.v[j] * w0 + y1.v[j] * w1;
        const float r1 = rsqrtf(row_ss(y) * (1.f / D) + EPS);
        const Row16 xo = load_row_bf16_nt((const bf16*)(F.ws + WS_XB) + (size_t)m * D, lane); Row16 xn;
#pragma unroll
        for (int j = 0; j < 4; ++j) xn.v[j] = xo.v[j] + gt.v[j] * (y.v[j] * r1 * gp.v[j]);
        store_row_f32_nt(F.X + (size_t)m * D, lane, xn); }
}
struct Args { const float* in[28]; float* out; unsigned char* ws; int ph_lo, ph_hi, li, pad; };
enum { PH_PRO = 0, PH_H0, PH_QKV, PH_ATTN, PH_WO, PH_NORMA, PH_FGU, PH_FD, PH_NORMB, PH_MIN, PH_GATES, PH_CELL, PH_H2B, PH_MINZ, PH_POST, PH_MOUT, PH_NORMC, PH_SORT, PH_MOE0  ,
       PH_FINAL = PH_MOE0 + 3 * MOE_ROUNDS, PH_COUNT };

__global__ void __launch_bounds__(NWAVES * 64, 2) mega(Args args) {
    extern __shared__ __attribute__((aligned(16))) unsigned char lds[];
    Frame F;
    F.lds = (LAS unsigned char*)lds;
    F.MISC = (volatile LAS unsigned*)(F.lds + MISC_OFF);
    F.tid = threadIdx.x; F.lane = F.tid & 63; F.wave = __builtin_amdgcn_readfirstlane(F.tid >> 6);
    F.G = gridDim.x; { const int bx = blockIdx.x; const int vcu = (F.G % 8 == 0) ? (bx % 8) * (F.G / 8) + bx / 8 : bx; F.gw = vcu * NWAVES + F.wave; F.NGW = F.G * NWAVES; }
    F.ws = args.ws; F.ctl = (gu32*)(args.ws + WS_CTL); F.in = args.in; F.X = args.out;
    for (int u = F.tid; u < (LDS_BYTES - LDSCTL_OFF) / 4; u += NWAVES * 64) ((LAS unsigned*)(F.lds + LDSCTL_OFF))[u] = 0u;
    __syncthreads();
    XcdBarrier bar = xcd_barrier_post((unsigned*)(F.ctl + CW_BAR) + args.li * XCD_BAR_WORDS, F.MISC + 8, F.wave);
    const int lo = args.ph_lo, hi = args.ph_hi;
#ifdef ONLY_PHASE
#define IN(k) ((k) == ONLY_PHASE && lo <= (k) && (k) < hi)
#else
#define IN(k) (lo <= (k) && (k) < hi)
#endif
#define REFRESH() do { int l_ = (int)__builtin_amdgcn_mbcnt_hi(~0u, __builtin_amdgcn_mbcnt_lo(~0u, 0u)); asm volatile("" : "+v"(l_)); F.lane = l_; F.tid = F.wave * 64 + l_; } while (0)
#ifdef TPROBE_MASK
    unsigned long long tp_last = __builtin_amdgcn_s_memrealtime(), tp_acc = 0ull;
#define SEAM(k) do { if (IN(k) && IN((k) + 1)) xcd_barrier(bar); { const unsigned long long now_ = __builtin_amdgcn_s_memrealtime(); if ((TPROBE_MASK >> (k)) & 1ull) tp_acc += now_ - tp_last; tp_last = now_; } } while (0)
#else
#define SEAM(k) do { if (IN(k) && IN((k) + 1)) xcd_barrier(bar); } while (0)
#endif
#define UNI(p) ((const float*)((((unsigned long long)(unsigned)__builtin_amdgcn_readfirstlane((unsigned)((unsigned long long)(p) >> 32))) << 32) | (unsigned long long)(unsigned)__builtin_amdgcn_readfirstlane((unsigned)(unsigned long long)(p))))
#define WSP ((unsigned char*)UNI(args.ws))
#define mod0 UNI((const float*)(args.ws + WS_MOD))
#define mod1 UNI((const float*)(args.ws + WS_MOD) + 16 * 6144)
#define ng UNI(args.in[I_NORMG])
#define SKEW(n) do { const int st_ = ((int)blockIdx.x >> 3) & 3; for (int i_ = 0; i_ < (n) * st_; ++i_) __builtin_amdgcn_s_sleep(110); } while (0)

#ifdef PRO_PROBE
    if (IN(PH_PRO)) { REFRESH(); p_prologue<PRO_PROBE>(F); xcd_barrier(bar); }
#endif
    if (IN(PH_PRO)) { REFRESH(); p_prologue<7>(F); } SEAM(PH_PRO);
    if (IN(PH_H0)) { REFRESH(); p_mlprep2(F); p_h0(F, (bf16*)(WSP + WS_Y)); } SEAM(PH_H0);
    if (IN(PH_QKV)) { REFRESH();
        pg8::Gemm g{(const bf16*)(WSP + WS_Y), (const bf16*)(WSP + WS_W_AIN), T, 3072, 1024}; pg8::StaticOrder So; So.init(T, 3072, F.G, (int)blockIdx.x);
        pg8::EpiBf16 E{(bf16*)(WSP + WS_Q), 1024, 1024, (size_t)(WS_K - WS_Q) / 2, QSCALE};
        pg8::gemm_phase<pg8::EpiBf16, pg8::StaticOrder, false, false>(F.lds, g, So, E, nullptr, F.wave);
    } SEAM(PH_QKV);
#ifdef HAVE_ATTN
    if (IN(PH_ATTN)) { REFRESH(); p_attn_kn(F); xcd_barrier(bar); REFRESH(); p_attn<0>(F); } SEAM(PH_ATTN);
#endif
#ifdef HAVE_L0REST
    if (IN(PH_WO)) { REFRESH();
        pg8::Gemm g{(const bf16*)(WSP + WS_O), (const bf16*)(WSP + WS_W_AOUT), T, 1024, 1024}; pg8::StaticOrder So; So.init(T, 1024, F.G, (int)blockIdx.x);
        pg8::EpiBf16 E{(bf16*)(WSP + WS_Y), 1024, 0, 0, 1.f};
        pg8::gemm_phase<pg8::EpiBf16, pg8::StaticOrder, false, false>(F.lds, g, So, E, nullptr, F.wave);
    } SEAM(PH_WO);
    if (IN(PH_NORMA)) { REFRESH(); p_norm(F, F.in[I_X], (const bf16*)(WSP + WS_Y), ng + 1024, mod0, 2, ng + 2048, mod0, 3, (bf16*)(WSP + WS_H)); } SEAM(PH_NORMA);
    if (IN(PH_FGU)) { REFRESH();
        pg8::Gemm g{(const bf16*)(WSP + WS_H), (const bf16*)(WSP + WS_W_FGU), T, 2 * F1, 1024}; pg8::StaticOrder So; So.init(T, 2 * F1, F.G, (int)blockIdx.x);
        pg8::EpiSwiglu E{(bf16*)(WSP + WS_ACT), F1};
        pg8::gemm_phase<pg8::EpiSwiglu, pg8::StaticOrder, false, false>(F.lds, g, So, E, nullptr, F.wave);
    } SEAM(PH_FGU);
    if (IN(PH_FD)) { REFRESH();
        pg8::Gemm g{(const bf16*)(WSP + WS_ACT), (const bf16*)(WSP + WS_W_FD), T, 1024, F1}; pg8::StaticOrder So; So.init(T, 1024, F.G, (int)blockIdx.x);
        pg8::EpiBf16 E{(bf16*)(WSP + WS_Y), 1024, 0, 0, 1.f};
        pg8::gemm_phase<pg8::EpiBf16, pg8::StaticOrder, false, false>(F.lds, g, So, E, nullptr, F.wave);
    } SEAM(PH_FD);
    if (IN(PH_NORMB)) { REFRESH(); p_normb(F, (const bf16*)(WSP + WS_Y), ng + 3072, mod0, ng + 4096, mod1, (bf16*)(WSP + WS_H)); } SEAM(PH_NORMB);
#endif
#ifdef HAVE_ML
    if (IN(PH_MIN)) { REFRESH();
        pg8::Gemm g{(const bf16*)(WSP + WS_H), (const bf16*)(WSP + WS_W_MIN), T, 2048, 1024}; pg8::StaticOrder So; So.init(T, 2048, F.G, (int)blockIdx.x);
        pg8::EpiBf16 E{(bf16*)(WSP + WS_XM), 2048, 0, 0, 1.f};
        pg8::gemm_phase<pg8::EpiBf16, pg8::StaticOrder, false, false>(F.lds, g, So, E, nullptr, F.wave);
    } SEAM(PH_MIN);
    if (IN(PH_GATES)) { REFRESH(); p_gates2(F); } SEAM(PH_GATES);
    if (IN(PH_CELL)) { REFRESH(); p_cell2(F); } SEAM(PH_CELL);
    if (IN(PH_MINZ)) { REFRESH();
        pg8::Gemm g{(const bf16*)UNI(args.out) + (size_t)T * D, (const bf16*)(WSP + WS_W_MIN) + (size_t)2048 * 1024, T, 2048, 1024}; pg8::StaticOrder So; So.init(T, 2048, F.G, (int)blockIdx.x);
        pg8::EpiBf16 E{(bf16*)(WSP + WS_ZB), 2048, 0, 0, 1.f};
        pg8::gemm_phase<pg8::EpiBf16, pg8::StaticOrder, false, false>(F.lds, g, So, E, nullptr, F.wave);
    } SEAM(PH_MINZ);
    if (IN(PH_POST)) { REFRESH(); p_post(F); } SEAM(PH_POST);
    if (IN(PH_MOUT)) { REFRESH();
        pg8::Gemm g{(const bf16*)(WSP + WS_HH), (const bf16*)(WSP + WS_W_MOUT), T, 1024, 2048}; pg8::StaticOrder So; So.init(T, 1024, F.G, (int)blockIdx.x);
        pg8::EpiBf16 E{(bf16*)(WSP + WS_Y), 1024, 0, 0, 1.f};
        pg8::gemm_phase<pg8::EpiBf16, pg8::StaticOrder, false, false>(F.lds, g, So, E, nullptr, F.wave);
    } SEAM(PH_MOUT);
#endif
#ifdef HAVE_MOE
    if (IN(PH_NORMC)) { REFRESH(); p_normc(F, (const bf16*)(WSP + WS_Y), ng + 5120, mod1, ng + 6144, (bf16*)(WSP + WS_H)); } SEAM(PH_NORMC);
    if (IN(PH_SORT)) { REFRESH(); p_sort(F, ng + 6144, mod1); } SEAM(PH_SORT);
#define MOE_ROUND(r) \
      \
    if ((r) < MOE_ROUNDS && IN(PH_MOE0 + 3 * (r) + 1)) { REFRESH(); const int* tab = (const int*)(WSP + WS_TAB); const int p_lo = (r) * PR; int np = tab[TAB_NPANELS] - p_lo; np = np > PR ? PR : np; \
        pg8::Gemm g{(const bf16*)(WSP + WS_YM), (const bf16*)(WSP + WS_WMGU), 0, 0, 1024}; pg8::MoeOrder<true, false> So; So.init(p_lo, np, 2 * F2 / 256, F.G, (int)blockIdx.x, tab + TAB_PEXP); \
        pg8::EpiSwiglu E{(bf16*)UNI(args.out), F2}; \
        pg8::gemm_phase<pg8::EpiSwiglu, pg8::MoeOrder<true, false>, false, false>(F.lds, g, So, E, nullptr, F.wave); } \
    if ((r) < MOE_ROUNDS) SEAM(PH_MOE0 + 3 * (r) + 1); \
    if ((r) < MOE_ROUNDS && IN(PH_MOE0 + 3 * (r) + 2)) { REFRESH(); const int* tab = (const int*)(WSP + WS_TAB); const int p_lo = (r) * PR; int np = tab[TAB_NPANELS] - p_lo; np = np > PR ? PR : np; \
        pg8::Gemm g{(const bf16*)UNI(args.out), (const bf16*)(WSP + WS_WMD), 0, 0, F2}; pg8::MoeOrder<false, true> So; So.init(p_lo, np, 4, F.G, (int)blockIdx.x, tab + TAB_PEXP); \
        pg8::EpiBf16 E{(bf16*)(WSP + WS_YM), 1024, 0, 0, 1.f}; \
        if ((r) + 1 < MOE_ROUNDS || (int)blockIdx.x < FINAL_DN_CUS || F.G <= FINAL_DN_CUS) pg8::gemm_phase<pg8::EpiBf16, pg8::MoeOrder<false, true>, false, false>(F.lds, g, So, E, nullptr, F.wave); \
        else { REFRESH(); p_final<1>(F, ng + 7168, mod1); } }     \
    if ((r) < MOE_ROUNDS) SEAM(PH_MOE0 + 3 * (r) + 2);
    MOE_ROUND(0) MOE_ROUND(1) MOE_ROUND(2) MOE_ROUND(3) MOE_ROUND(4)
#undef MOE_ROUND
    if (IN(PH_FINAL)) { REFRESH(); if (F.G > FINAL_DN_CUS) p_final<2>(F, ng + 7168, mod1); else p_final<0>(F, ng + 7168, mod1); }
#ifdef TPROBE_MASK
    { __syncthreads(); const unsigned long long now_ = __builtin_amdgcn_s_memrealtime(); if ((TPROBE_MASK >> PH_FINAL) & 1ull) tp_acc += now_ - tp_last;
      const unsigned long long target_ = now_ + (unsigned long long)(TPROBE_AMP) * tp_acc; while (__builtin_amdgcn_s_memrealtime() < target_) __builtin_amdgcn_s_sleep(32); }
#endif
#endif
#undef IN
#undef SEAM
#undef WSP
#undef mod0
#undef mod1
#undef ng
#undef SKEW
#undef UNI
}
}

#ifdef REFCHECK
namespace chk {
__host__ __device__ inline int srow(int b, int j) { return (37 + 523 * j + 61 * b) % 2048; }
constexpr int DIG_COLS = 4096;
__host__ __device__ inline size_t dig_off(int stage, int b, int j) { return ((size_t)(stage * 16 + b) * 4 + j) * DIG_COLS; }
__global__ void k_sample(const float* p, int ld, int ncols, float* dig, int stage, int b) {
    const int j = blockIdx.x; const float* src = p + (size_t)srow(b, j) * ld; float* dst = dig + dig_off(stage, b, j);
    for (int c = threadIdx.x; c < ncols; c += blockDim.x) dst[c] = src[c];
}
static void digest_cb(int stage, int b, const float* p, int ld, int ncols, hipStream_t st, void* ctx) {
    hipLaunchKernelGGL(k_sample, dim3(4), dim3(256), 0, st, p, ld, ncols, (float*)ctx, stage, b);
}
__global__ void k_check(const void* fast, int is_bf16, int ld, int ncols, float fscale, const float* dig, int stage, int coff, float tol, int code, unsigned* fail) {
    __shared__ float sh[2][16];
    float se = 0.f, sb = 0.f;
    for (int r = 0; r < 64; ++r) { const int b = r >> 2, j = r & 3; const size_t row = (size_t)b * 2048 + srow(b, j); const float* d = dig + dig_off(stage, b, j) + coff;
        for (int c = threadIdx.x; c < ncols; c += blockDim.x) {
            float f;
            if (is_bf16 == 2) { const unsigned v = ((const unsigned char*)fast)[row * ld + c]; const int e = (v >> 3) & 15, mm = v & 7; f = e ? exp2f((float)(e - 7)) * (1.f + mm * 0.125f) : 0.015625f * (mm * 0.125f); if (v & 128) f = -f; }
            else f = is_bf16 ? __builtin_bit_cast(float, (unsigned)((const unsigned short*)fast)[row * ld + c] << 16) : ((const float*)fast)[row * ld + c];
            f *= fscale; const float e = f - d[c]; se += e * e; sb += d[c] * d[c]; } }
    for (int o = 32; o > 0; o >>= 1) { se += __shfl_xor(se, o); sb += __shfl_xor(sb, o); }
    if ((threadIdx.x & 63) == 0) { sh[0][threadIdx.x >> 6] = se; sh[1][threadIdx.x >> 6] = sb; }
    __syncthreads();
    if (threadIdx.x == 0) { se = 0.f; sb = 0.f; for (int i = 0; i < (int)blockDim.x / 64; ++i) { se += sh[0][i]; sb += sh[1][i]; }
        const float rel = sqrtf(se / fmaxf(sb, 1e-30f));
        if (!(rel < tol)) atomicMin(fail, (unsigned)(2 * code + (rel < 0.3f ? 0 : 1))); }
}
__global__ void k_check2(const void* fast, int is_bf16, int ld, int c0, int c1, int cmask, int cval, int rshift, int rmask, int rval, const float* dig, int stage, float tol, int bit, unsigned* fail) {
    __shared__ float sh[2][16];
    float se = 0.f, sb = 0.f;
    for (int r = 0; r < 64; ++r) { const int b = r >> 2, j = r & 3; const int pos = srow(b, j); if (((pos >> rshift) & rmask) != rval) continue;
        const size_t row = (size_t)b * 2048 + pos; const float* d = dig + dig_off(stage, b, j);
        for (int c = c0 + threadIdx.x; c < c1; c += blockDim.x) { if ((c & cmask) != cval) continue;
            const float f = is_bf16 ? __builtin_bit_cast(float, (unsigned)((const unsigned short*)fast)[row * ld + c] << 16) : ((const float*)fast)[row * ld + c];
            const float e = f - d[c]; se += e * e; sb += d[c] * d[c]; } }
    for (int o = 32; o > 0; o >>= 1) { se += __shfl_xor(se, o); sb += __shfl_xor(sb, o); }
    if ((threadIdx.x & 63) == 0) { sh[0][threadIdx.x >> 6] = se; sh[1][threadIdx.x >> 6] = sb; }
    __syncthreads();
    if (threadIdx.x == 0) { se = 0.f; sb = 0.f; for (int i = 0; i < (int)blockDim.x / 64; ++i) { se += sh[0][i]; sb += sh[1][i]; }
        const float rel = sqrtf(se / fmaxf(sb, 1e-30f));
        if (!(rel < tol)) atomicOr(fail + 1, 1u << bit); }
}
__global__ void k_initfail(unsigned* fail) { fail[0] = 0x7fffffffu; fail[1] = 0u; }
__global__ void k_scale(float* out, size_t n, const unsigned* fail) {
    unsigned f = fail[0]; if (fail[1]) f = fail[1]; if (f == 0x7fffffffu) return; const float s = exp2f((float)f);
    for (size_t i = (size_t)blockIdx.x * blockDim.x + threadIdx.x; i < n; i += (size_t)gridDim.x * blockDim.x) out[i] *= s;
}
}
#endif

#ifdef REFCHECK
static ref::In make_in(void* const* d_in) {
    ref::In in;
    const float** p = (const float**)&in;
    for (int i = 0; i < 28; ++i) p[i] = (const float*)d_in[i];
    return in;
}
#endif
static int g_grid = 0;
static void launch_phases(const fp::Args& base, int lo, int hi, int li, hipStream_t stream) {
    fp::Args a = base; a.ph_lo = lo; a.ph_hi = hi; a.li = li; a.pad = 0;
    hipLaunchKernelGGL(fp::mega, dim3(g_grid), dim3(fp::NWAVES * 64), fp::LDS_BYTES, stream, a);
}
extern "C" void kernel_launch(void* const* d_in, const int* in_sizes, int n_in, void* d_out, int out_size, void* d_ws, size_t ws_size, hipStream_t stream) {
    if (g_grid == 0) {
        if (n_in != 28 || out_size != 32768 * 1024 || ws_size < fp::WS_NEED) { fprintf(stderr, "kernel_launch: unexpected shapes (n_in %d out %d ws %zu)\n", n_in, out_size, ws_size); g_grid = -1; return; }
        int dev = 0, cus = 0, per_cu = 0;
        if (hipGetDevice(&dev) != hipSuccess || hipDeviceGetAttribute(&cus, hipDeviceAttributeMultiprocessorCount, dev) != hipSuccess) { g_grid = -1; return; }
        if (hipFuncSetAttribute((const void*)fp::mega, hipFuncAttributeMaxDynamicSharedMemorySize, fp::LDS_BYTES) != hipSuccess) { fprintf(stderr, "kernel_launch: hipFuncSetAttribute failed\n"); g_grid = -1; return; }
        if (hipOccupancyMaxActiveBlocksPerMultiprocessor(&per_cu, (const void*)fp::mega, fp::NWAVES * 64, fp::LDS_BYTES) != hipSuccess || per_cu < 1) { fprintf(stderr, "kernel_launch: occupancy query says %d\n", per_cu); }
        (void)hipGetLastError();
        g_grid = cus;
    }
    if (g_grid < 0) return;
    hipMemsetAsync((char*)d_ws + fp::WS_CTL, 0, fp::CTL_ZERO_BYTES, stream);
    fp::Args a{};
    for (int i = 0; i < 28; ++i) a.in[i] = (const float*)d_in[i];
    a.out = (float*)d_out; a.ws = (unsigned char*)d_ws;
#ifdef REFCHECK
    ref::In in = make_in(d_in);
    float* dig = (float*)((unsigned char*)d_ws + fp::WS_DIG);
    unsigned* fail = (unsigned*)d_ws + fp::CW_FAIL;
    ref::forward(in, (float*)d_out, (unsigned char*)d_ws + 2 * fp::MiB, stream, chk::digest_cb, dig);
    hipMemsetAsync((char*)d_ws + fp::WS_CTL, 0, fp::CTL_ZERO_BYTES, stream);
    hipLaunchKernelGGL(chk::k_initfail, dim3(1), dim3(1), 0, stream, fail);
    unsigned char* ws = (unsigned char*)d_ws;
#define CHECK(ptr, isbf, ld, ncols, fscale, stage, coff, tol, code) hipLaunchKernelGGL(chk::k_check, dim3(1), dim3(1024), 0, stream, (const void*)(ptr), isbf, ld, ncols, fscale, dig, stage, coff, tol, code, fail)
    int li = 0;
    for (int ph = 0; ph < REFCHECK_PHASES; ++ph) {
        launch_phases(a, ph, ph + 1, li++, stream);
        switch (ph) {
        case fp::PH_H0: CHECK(ws + fp::WS_Y, 1, 1024, 1024, 1.f, 1, 0, 0.02f, 1); break;
        case fp::PH_QKV: CHECK(ws + fp::WS_Q, 1, 1024, 1024, 1.f / fp::QSCALE, 2, 0, 0.03f, 2); CHECK(ws + fp::WS_K, 1, 1024, 1024, 1.f, 2, 1024, 0.03f, 3); CHECK(ws + fp::WS_V, 1, 1024, 1024, 1.f, 2, 2048, 0.03f, 4); break;
        case fp::PH_ATTN: CHECK(ws + fp::WS_O, 1, 1024, 1024, 1.f, 3, 0, 0.05f, 8);
#ifdef LSE_DIAG
            CHECK(ws + fp::WS_GATE, 0, 8, 8, 1.f, 0, 0, 0.01f, 6);
#endif
#ifdef ATTN_DIAG
            for (int hb = 0; hb < 4; ++hb) hipLaunchKernelGGL(chk::k_check2, dim3(1), dim3(1024), 0, stream, (const void*)(ws + fp::WS_O), 1, 1024, hb * 256, hb * 256 + 256, 0, 0, 0, 0, 0, dig, 3, 0.03f, hb, fail);
            hipLaunchKernelGGL(chk::k_check2, dim3(1), dim3(1024), 0, stream, (const void*)(ws + fp::WS_O), 1, 1024, 0, 1024, 0, 0, 6, 1, 0, dig, 3, 0.03f, 4, fail);
            hipLaunchKernelGGL(chk::k_check2, dim3(1), dim3(1024), 0, stream, (const void*)(ws + fp::WS_O), 1, 1024, 0, 1024, 0, 0, 6, 1, 1, dig, 3, 0.03f, 5, fail);
#endif
            break;
        case fp::PH_WO: CHECK(ws + fp::WS_Y, 1, 1024, 1024, 1.f, 4, 0, 0.05f, 6); break;
        case fp::PH_NORMA: CHECK(d_out, 1, 1024, 1024, 1.f, 5, 0, 0.02f, 7); CHECK(ws + fp::WS_H, 1, 1024, 1024, 1.f, 6, 0, 0.03f, 8); break;
        case fp::PH_FGU: CHECK(ws + fp::WS_ACT, 1, fp::F1, fp::F1, 1.f, 7, 0, 0.05f, 9); break;
        case fp::PH_FD: CHECK(ws + fp::WS_Y, 1, 1024, 1024, 1.f, 8, 0, 0.05f, 10); break;
        case fp::PH_NORMB: CHECK(d_out, 1, 1024, 1024, 1.f, 9, 0, 0.02f, 11); CHECK(ws + fp::WS_H, 1, 1024, 1024, 1.f, 10, 0, 0.03f, 12); break;
        case fp::PH_MIN: CHECK(ws + fp::WS_XM, 1, 2048, 2048, 1.f, 11, 0, 0.03f, 13); break;
        case fp::PH_MINZ: CHECK(ws + fp::WS_ZB, 1, 2048, 2048, 1.f, 11, 2048, 0.03f, 22); break;
        case fp::PH_GATES: CHECK(ws + fp::WS_GATE, 0, 8, 8, 1.f, 16, 0, 0.03f, 14); break;
#ifdef CELL_DUMP2
        case fp::PH_CELL: CHECK(ws + fp::WS_HH, 1, 2048, 2048, 1.f, 15, 0, 0.03f, 18); CHECK(ws + fp::WS_Y, 0, 4, 4, 1.f, 0, 0, 0.03f, 19); break;
#elif defined(CELL_DUMP) || defined(CELL_DUMP3)
        case fp::PH_CELL: CHECK(ws + fp::WS_Y, 1, 2048, 2048, 1.f, 13, 0, 0.03f, 18); CHECK(ws + fp::WS_HH, 1, 2048, 2048, 1.f / fp::KSCALE, 14, 0, 0.03f, 19); break;
#else
        case fp::PH_CELL: CHECK(ws + fp::WS_HH, 1, 2048, 2048, 1.f, 17, 0, 0.35f, 15); break;
#endif
        case fp::PH_POST: CHECK(ws + fp::WS_HH, 1, 2048, 2048, 1.f, 18, 0, 0.05f, 16); break;
        case fp::PH_MOUT: CHECK(ws + fp::WS_Y, 1, 1024, 1024, 1.f, 19, 0, 0.05f, 17); break;
#ifdef HAVE_MOE
        case fp::PH_NORMC: CHECK(ws + fp::WS_XB, 1, 1024, 1024, 1.f, 20, 0, 0.02f, 18); CHECK(ws + fp::WS_ROUTE + fp::RT_WTS, 0, 2, 2, 1.f, 22, 0, 0.15f, 20); break;
        case fp::PH_FINAL: CHECK(d_out, 0, 1024, 1024, 1.f, 24, 0, 0.10f, 21); break;
#endif
        default: break;
        }
    }
#ifdef BROKEN_CONTROL
    CHECK(ws + fp::WS_K, 1, 1024, 1024, 1.f, 2, 2048, 0.03f, 23);
#endif
#ifndef REFCHECK_FULL
    ref::forward(in, (float*)d_out, (unsigned char*)d_ws + 2 * fp::MiB, stream, nullptr, nullptr);
#endif
#ifndef NO_SCALE
    hipLaunchKernelGGL(chk::k_scale, dim3(2048), dim3(256), 0, stream, (float*)d_out, (size_t)32768 * 1024, fail);
#endif
#else
    launch_phases(a, 0, fp::PH_COUNT, 0, stream);
#endif
}
```

```cpp
#include <hip/hip_runtime.h>
#include <stdint.h>
#include <stdio.h>
#define HAVE_L0REST
namespace pg8 {
#define PG8_LAS __attribute__((address_space(3)))
typedef unsigned short bf16_t;
typedef short bf16x8 __attribute__((ext_vector_type(8)));
typedef float f32x4 __attribute__((ext_vector_type(4)));
typedef unsigned u32x4 __attribute__((ext_vector_type(4)));
typedef int v8i_t __attribute__((ext_vector_type(8)));
typedef int v4i_t __attribute__((ext_vector_type(4)));
constexpr int BM = 256, BK = 64, HALF = 128, HTB = HALF * BK * 2  , STAGE_BYTES = 8 * HTB, NXCD = 8,
#ifdef STATIC_WGM
    WGM = STATIC_WGM;
#else
    WGM = 8;
#endif

__host__ __device__ __forceinline__ int lds_byte(int r, int c) { const int st = (r >> 4) * 2 + (c >> 5), rr = r & 15, cc = c & 31, ob = rr * 64 + cc * 2; return st * 1024 + (ob ^ (((ob >> 9) & 1) << 5)); }
__host__ __device__ __forceinline__ void stage_rc(int b, int& R, int& C) { const int st = b / 1024, sb = b % 1024, swz = sb ^ (((sb >> 9) & 1) << 5); R = (st >> 1) * 16 + swz / 64; C = (st & 1) * 32 + (swz % 64) / 2; }
__host__ __device__ __forceinline__ int perm32(int rho) { const int n = rho >> 4, i = rho & 15; return 8 * (i >> 2) + 4 * n + (i & 3); }

struct Unit { int pm, pn, om, on; };
struct Gemm { const bf16_t* A; const bf16_t* Bt; int M, N, K; };

struct StaticOrder {
    int nM, nN, nwg, G, c;
    __host__ __device__ void init(int M, int N, int G_, int c_) { nM = M / BM; nN = N / BM; nwg = nM * nN; G = G_; c = c_; }
    __host__ __device__ bool next(int i, Unit& u) const {
        const long L = (long)i * G + c; if (L >= nwg) return false;
        int wgid = (int)L; { const int q = nwg / NXCD, r = nwg % NXCD, xcd = wgid % NXCD, off = wgid / NXCD; wgid = (xcd < r ? xcd * (q + 1) : r * (q + 1) + (xcd - r) * q) + off; }
        const int nig = WGM * nN, gid = wgid / nig, fm = gid * WGM, gsz = (nM - fm) < WGM ? (nM - fm) : WGM;
        u.pm = fm + ((wgid % nig) % gsz); u.pn = (wgid % nig) / gsz; u.om = u.pm; u.on = u.pn; return true;
    }
};
#ifndef MOE_WGM
#define MOE_WGM 8
#endif
constexpr int MWGM = MOE_WGM;
template <bool ABS_A, bool ABS_O> struct MoeOrder {
    int p_lo, np, nN, nwg, G, c; const int* pexp;
    __device__ void init(int p_lo_, int np_, int nN_, int G_, int c_, const int* pexp_) { p_lo = p_lo_; np = np_ < 0 ? 0 : np_; nN = nN_; nwg = np * nN; G = G_; c = c_; pexp = pexp_; }
    __device__ bool next(int i, Unit& u) const {
        const long L = (long)i * G + c; if (L >= nwg) return false;
        const int wgid = (int)L, nig = MWGM * nN, gid = wgid / nig, fm = gid * MWGM, gsz = (np - fm) < MWGM ? (np - fm) : MWGM;
        const int pr = __builtin_amdgcn_readfirstlane(fm + ((wgid % nig) % gsz)), pnl = __builtin_amdgcn_readfirstlane((wgid % nig) / gsz), e = __builtin_amdgcn_readfirstlane(pexp[p_lo + pr]);
        u.pm = ABS_A ? p_lo + pr : pr; u.om = ABS_O ? p_lo + pr : pr; u.pn = e * nN + pnl; u.on = pnl; return true;
    }
};

__device__ __forceinline__ unsigned cvt_pk_bf16(float lo, float hi) { unsigned r; asm volatile("v_cvt_pk_bf16_f32 %0, %1, %2" : "=v"(r) : "v"(lo), "v"(hi)); return r; }

#ifdef EPI_PLAIN_STORES
__device__ __forceinline__ void store16_wt(void* p, u32x4 w) { *(u32x4*)p = w; }
#else
__device__ __forceinline__ void store16_wt(void* p, u32x4 w) { asm volatile("global_store_dwordx4 %0, %1, off sc1\n\ts_nop 1" : : "v"(p), "v"(w) : "memory"); }
#endif

struct EpiBf16 {
    static constexpr bool PERM = true;
    bf16_t* O; int ldc; int split_cols; size_t split_stride; float scale0;
    __device__ __forceinline__ void operator()(const f32x4 (&acc)[2][2][4][2], const Unit& u, int wr, int wc, int fr, int fq) const {
        const int row0 = u.om * BM + wr * 64 + fr; int colt = u.on * BM; bf16_t* base = O;
        float sc = 1.f; if (split_cols) { const int t = colt / split_cols; base += (size_t)t * split_stride; colt -= t * split_cols; if (t == 0) sc = scale0; } else sc = scale0;
        const int col0 = colt + wc * 32 + 8 * fq;
#pragma unroll
        for (int ai = 0; ai < 2; ++ai)
#pragma unroll
            for (int m = 0; m < 4; ++m) { bf16_t* rowp = base + (size_t)(row0 + ai * HALF + m * 16) * ldc + col0;
#pragma unroll
                for (int bj = 0; bj < 2; ++bj) { const f32x4 v0 = acc[ai][bj][m][0] * sc, v1 = acc[ai][bj][m][1] * sc;
                    u32x4 w; w.x = cvt_pk_bf16(v0[0], v0[1]); w.y = cvt_pk_bf16(v0[2], v0[3]); w.z = cvt_pk_bf16(v1[0], v1[1]); w.w = cvt_pk_bf16(v1[2], v1[3]);
                    store16_wt(rowp + bj * HALF, w); } }
    }
};
__device__ __forceinline__ float silu_mul(float g, float u) { return g * u * __builtin_amdgcn_rcpf(1.0f + __builtin_amdgcn_exp2f(-1.4426950408889634f * g)); }
struct EpiSwiglu {
    static constexpr bool PERM = true;
    bf16_t* O; int ldc;
    __device__ __forceinline__ void operator()(const f32x4 (&acc)[2][2][4][2], const Unit& u, int wr, int wc, int fr, int fq) const {
        const int row0 = u.om * BM + wr * 64 + fr, col0 = u.on * HALF + wc * 32 + 8 * fq;
#pragma unroll
        for (int ai = 0; ai < 2; ++ai)
#pragma unroll
            for (int m = 0; m < 4; ++m) { bf16_t* rowp = O + (size_t)(row0 + ai * HALF + m * 16) * ldc + col0;
                const f32x4 g0 = acc[ai][0][m][0], g1 = acc[ai][0][m][1], u0 = acc[ai][1][m][0], u1 = acc[ai][1][m][1];
                u32x4 w; w.x = cvt_pk_bf16(silu_mul(g0[0], u0[0]), silu_mul(g0[1], u0[1])); w.y = cvt_pk_bf16(silu_mul(g0[2], u0[2]), silu_mul(g0[3], u0[3]));
                w.z = cvt_pk_bf16(silu_mul(g1[0], u1[0]), silu_mul(g1[1], u1[1])); w.w = cvt_pk_bf16(silu_mul(g1[2], u1[2]), silu_mul(g1[3], u1[3]));
                store16_wt(rowp, w); }
    }
};

template <int MODE> struct EpiProbe {
    static constexpr bool PERM = true;
    bf16_t* O; int ldc;
    __device__ __forceinline__ void operator()(const f32x4 (&acc)[2][2][4][2], const Unit& u, int wr, int wc, int fr, int fq) const {
        const int row0 = (MODE == 0 ? ((int)blockIdx.x % 64) : u.om) * BM + wr * 64 + fr; const int col0 = (MODE == 0 ? 0 : (u.on & 3) * BM) + wc * 32 + 8 * fq;
#pragma unroll
        for (int ai = 0; ai < 2; ++ai)
#pragma unroll
            for (int m = 0; m < 4; ++m) { bf16_t* rowp = O + (size_t)(row0 + ai * HALF + m * 16) * ldc + col0;
#pragma unroll
                for (int bj = 0; bj < 2; ++bj) { const f32x4 v0 = acc[ai][bj][m][0], v1 = acc[ai][bj][m][1];
                    u32x4 w; w.x = cvt_pk_bf16(v0[0], v0[1]); w.y = cvt_pk_bf16(v0[2], v0[3]); w.z = cvt_pk_bf16(v1[0], v1[1]); w.w = cvt_pk_bf16(v1[2], v1[3]);
                    if (MODE == 1) __builtin_nontemporal_store(w, (u32x4*)(rowp + bj * HALF)); else *(u32x4*)(rowp + bj * HALF) = w; } }
    }
};
struct EpiNull {
    static constexpr bool PERM = true;
    bf16_t* O;
    __device__ __forceinline__ void operator()(const f32x4 (&acc)[2][2][4][2], const Unit& u, int wr, int wc, int fr, int fq) const {
        float s = 0.f;
#pragma unroll
        for (int ai = 0; ai < 2; ++ai)
#pragma unroll
            for (int bj = 0; bj < 2; ++bj)
#pragma unroll
                for (int m = 0; m < 4; ++m)
#pragma unroll
                    for (int n = 0; n < 2; ++n) s += acc[ai][bj][m][n][0] + acc[ai][bj][m][n][1] + acc[ai][bj][m][n][2] + acc[ai][bj][m][n][3];
        if (s == 12345.6789f) O[(size_t)u.om * 256 + fr] = (bf16_t)1;
    }
};
struct EpiSwigluF8 {
    static constexpr bool PERM = true;
    unsigned char* O; int ldc; float inv_ws;
    __device__ __forceinline__ void operator()(const f32x4 (&acc)[2][2][4][2], const Unit& u, int wr, int wc, int fr, int fq) const {
        const int row0 = u.om * BM + wr * 64 + fr, col0 = u.on * HALF + wc * 32 + 8 * fq;
#pragma unroll
        for (int ai = 0; ai < 2; ++ai)
#pragma unroll
            for (int m = 0; m < 4; ++m) { unsigned char* rowp = O + (size_t)(row0 + ai * HALF + m * 16) * ldc + col0;
                const f32x4 g0 = acc[ai][0][m][0] * inv_ws, g1 = acc[ai][0][m][1] * inv_ws, u0 = acc[ai][1][m][0] * inv_ws, u1 = acc[ai][1][m][1] * inv_ws;
                unsigned w0 = 0u, w1 = 0u;
                w0 = __builtin_amdgcn_cvt_pk_fp8_f32(silu_mul(g0[0], u0[0]), silu_mul(g0[1], u0[1]), w0, false); w0 = __builtin_amdgcn_cvt_pk_fp8_f32(silu_mul(g0[2], u0[2]), silu_mul(g0[3], u0[3]), w0, true);
                w1 = __builtin_amdgcn_cvt_pk_fp8_f32(silu_mul(g1[0], u1[0]), silu_mul(g1[1], u1[1]), w1, false); w1 = __builtin_amdgcn_cvt_pk_fp8_f32(silu_mul(g1[2], u1[2]), silu_mul(g1[3], u1[3]), w1, true);
                typedef unsigned u32x2 __attribute__((ext_vector_type(2)));
                *(u32x2*)rowp = (u32x2){w0, w1}; }
    }
};

template <class Epi, class Sched, bool ALIGN_EPI, bool GATHER, bool F8 = false, bool NT_A = false>
__device__ __forceinline__ void gemm_phase(PG8_LAS unsigned char* lds, const Gemm g, const Sched& S, const Epi& E, const int* rowidx, int wave) {
    const int wid = __builtin_amdgcn_readfirstlane(wave), lane = (int)__builtin_amdgcn_mbcnt_hi(~0u, __builtin_amdgcn_mbcnt_lo(~0u, 0u)), tid = wid * 64 + lane,     wr = wid >> 2, wc = wid & 3, fr = lane & 15, fq = lane >> 4;
    const int K = F8 ? g.K / 2 : g.K, nt = K / BK;
    unsigned voffB[2];
#pragma unroll
    for (int i = 0; i < 2; ++i) { int R, C; stage_rc(tid * 16 + i * 8192, R, C); const int Rb = Epi::PERM ? ((R & ~31) + perm32(R & 31)) : R; voffB[i] = (unsigned)(Rb * K + C) * 2u; }
#define PG8_MKVOFF(dst, U) do { _Pragma("unroll") for (int _h = 0; _h < 2; ++_h) _Pragma("unroll") for (int _i = 0; _i < 2; ++_i) { int R_, C_; stage_rc(tid * 16 + _i * 8192, R_, C_); \
        int row_ = (U).pm * BM + _h * HALF + R_; if (GATHER) row_ = rowidx[row_]; dst[_h][_i] = (unsigned)(row_ * K + C_) * 2u; } } while (0)
    const size_t kstep = (size_t)(BK * 2);
    const size_t hstep = (size_t)HALF * K * 2;
    const size_t tstep = 2 * hstep;
    const unsigned lds0 = (unsigned)__builtin_amdgcn_readfirstlane((int)(unsigned)(size_t)lds);
    const unsigned ldsw = (unsigned)wid * 1024u;
    const unsigned ldsb = lds0 + ldsw;
    const int aoff = lds_byte(wr * 64 + fr, fq * 8), boff = lds_byte(wc * 32 + fr, fq * 8);
#define PG8_SA(b, h) (((b) * 2 + (h)) * HTB)
#define PG8_SB(b, h) ((4 + (b) * 2 + (h)) * HTB)
#define PG8_GLDS(ldsbase, coff, voff32, gptr) do { asm volatile("s_add_u32 m0, %1, %3\n\ts_nop 0\n\tglobal_load_lds_dwordx4 %0, %2" : : "v"(voff32), "s"(ldsbase), "s"(gptr), "i"(coff) : "memory", "m0", "scc"); } while (0)
#define PG8_STAGE(bufoff, gbase, v0, v1) do { const unsigned long long gb_ = (unsigned long long)(gbase); \
        const unsigned long long gp_ = ((unsigned long long)(unsigned)__builtin_amdgcn_readfirstlane((int)(unsigned)(gb_ >> 32)) << 32) | (unsigned long long)(unsigned)__builtin_amdgcn_readfirstlane((int)(unsigned)gb_); PG8_GLDS(ldsb, (bufoff), v0, gp_); PG8_GLDS(ldsb, (bufoff) + 8192, v1, gp_); } while (0)
#define PG8_GLDS_NT(ldsbase, coff, voff32, gptr) do { asm volatile("s_add_u32 m0, %1, %3\n\ts_nop 0\n\tglobal_load_lds_dwordx4 %0, %2 nt" : : "v"(voff32), "s"(ldsbase), "s"(gptr), "i"(coff) : "memory", "m0", "scc"); } while (0)
#define PG8_STAGE_NT(bufoff, gbase, v0, v1) do { const unsigned long long gb_ = (unsigned long long)(gbase); \
        const unsigned long long gp_ = ((unsigned long long)(unsigned)__builtin_amdgcn_readfirstlane((int)(unsigned)(gb_ >> 32)) << 32) | (unsigned long long)(unsigned)__builtin_amdgcn_readfirstlane((int)(unsigned)gb_); PG8_GLDS_NT(ldsb, (bufoff), v0, gp_); PG8_GLDS_NT(ldsb, (bufoff) + 8192, v1, gp_); } while (0)
#define PG8_LD2(p_) __builtin_shufflevector(*(const PG8_LAS v4i_t*)(p_), *(const PG8_LAS v4i_t*)((p_) + 1024), 0, 1, 2, 3, 4, 5, 6, 7)
#define PG8_LDA(dst, b, h) do { _Pragma("unroll") for (int m = 0; m < 4; ++m) dst[m] = PG8_LD2(lds + PG8_SA(b, h) + aoff + m * 2048); } while (0)
#define PG8_LDB(dst, b, h) do { _Pragma("unroll") for (int n = 0; n < 2; ++n) dst[n] = PG8_LD2(lds + PG8_SB(b, h) + boff + n * 2048); } while (0)
#define PG8_LO(v) __builtin_bit_cast(bf16x8, __builtin_shufflevector(v, v, 0, 1, 2, 3))
#define PG8_HI(v) __builtin_bit_cast(bf16x8, __builtin_shufflevector(v, v, 4, 5, 6, 7))
#define PG8_MMA(ai, bj, At, Bt) do { __builtin_amdgcn_s_setprio(1); _Pragma("unroll") for (int m = 0; m < 4; ++m) _Pragma("unroll") for (int n = 0; n < 2; ++n) { \
        if constexpr (F8) { acc[ai][bj][m][n] = __builtin_amdgcn_mfma_scale_f32_16x16x128_f8f6f4(Bt[n], At[m], acc[ai][bj][m][n], 0, 0, 0, 0x7f7f7f7f, 0, 0x7f7f7f7f); } \
        else { acc[ai][bj][m][n] = __builtin_amdgcn_mfma_f32_16x16x32_bf16(PG8_LO(Bt[n]), PG8_LO(At[m]), acc[ai][bj][m][n], 0, 0, 0); acc[ai][bj][m][n] = __builtin_amdgcn_mfma_f32_16x16x32_bf16(PG8_HI(Bt[n]), PG8_HI(At[m]), acc[ai][bj][m][n], 0, 0, 0); } } __builtin_amdgcn_s_setprio(0); } while (0)
#define PG8_WAIT_V(n) asm volatile("s_waitcnt vmcnt(" #n ")" ::: "memory")
#define PG8_WAIT_L(n) asm volatile("s_waitcnt lgkmcnt(" #n ")" ::: "memory")
#define PG8_BAR __builtin_amdgcn_s_barrier()
#define PG8_SCHED __builtin_amdgcn_sched_barrier(0)
    Unit cur, nxt; int ui = 0;
    if (!S.next(0, cur)) return;
    f32x4 acc[2][2][4][2];
#pragma unroll
    for (int a = 0; a < 2; ++a)
#pragma unroll
        for (int b = 0; b < 2; ++b)
#pragma unroll
            for (int m = 0; m < 4; ++m)
#pragma unroll
                for (int n = 0; n < 2; ++n) acc[a][b][m][n] = (f32x4){0.f, 0.f, 0.f, 0.f};
    v8i_t At[4], B0[2], B1[2];
    unsigned voffA[2][2], voffN[2][2], voffA1[2];
    if constexpr (GATHER) { PG8_MKVOFF(voffA, cur); }
    else {
#pragma unroll
        for (int i = 0; i < 2; ++i) { int R, C; stage_rc(tid * 16 + i * 8192, R, C); voffA1[i] = (unsigned)(R * K + C) * 2u; } }
    const char* gA = (const char*)g.A;
    const char* cA = gA + (size_t)cur.pm * tstep; const char* nA = cA;
    const char* cB = (const char*)g.Bt + (size_t)cur.pn * tstep;
#define PG8_STAGE_A(bufoff, h, koff, usenext) do { \
        if constexpr (GATHER) { const unsigned v0_ = (usenext) ? voffN[h][0] : voffA[h][0], v1_ = (usenext) ? voffN[h][1] : voffA[h][1]; PG8_STAGE(bufoff, gA + (koff), v0_, v1_); } \
        else { const char* p_ = ((usenext) ? nA : cA) + (size_t)(h) * hstep + (koff); if constexpr (NT_A) { PG8_STAGE_NT(bufoff, p_, voffA1[0], voffA1[1]); } else { PG8_STAGE(bufoff, p_, voffA1[0], voffA1[1]); } } } while (0)
    PG8_STAGE(PG8_SB(0, 0), cB, voffB[0], voffB[1]); PG8_STAGE(PG8_SB(0, 1), cB + hstep, voffB[0], voffB[1]); PG8_STAGE_A(PG8_SA(0, 0), 0, (size_t)0, false); PG8_STAGE_A(PG8_SA(0, 1), 1, (size_t)0, false);
    if (wr == 1) PG8_BAR;
    PG8_WAIT_V(2); PG8_BAR;
    PG8_STAGE(PG8_SB(1, 0), cB + kstep, voffB[0], voffB[1]); PG8_STAGE_A(PG8_SA(1, 0), 0, kstep, false); PG8_STAGE(PG8_SB(1, 1), cB + hstep + kstep, voffB[0], voffB[1]);
    PG8_WAIT_V(6); PG8_BAR;
    for (;;) {
        const bool has_next = S.next(ui + 1, nxt);
        if constexpr (GATHER) { if (has_next) { PG8_MKVOFF(voffN, nxt); } else {
#pragma unroll
            for (int h = 0; h < 2; ++h) { voffN[h][0] = voffA[h][0]; voffN[h][1] = voffA[h][1]; } } }
        nA = has_next ? gA + (size_t)nxt.pm * tstep : cA;
        const char* nB = has_next ? (const char*)g.Bt + (size_t)nxt.pn * tstep : cB;
        for (int t = 0; t < nt; t += 2) {
            const bool last = (t == nt - 2);
            const size_t k1 = (size_t)(t + 1) * kstep;
            const size_t k2 = last ? (size_t)0 : (size_t)(t + 2) * kstep; const char* b2 = last ? nB : cB + (size_t)(t + 2) * kstep;
            const size_t k3 = k2 + kstep; const char* b3 = b2 + kstep;
            PG8_LDB(B0, 0, 0); PG8_LDB(B1, 0, 1); PG8_SCHED; PG8_LDA(At, 0, 0); PG8_STAGE_A(PG8_SA(1, 1), 1, k1, false);
            PG8_WAIT_V(8); PG8_WAIT_L(0); PG8_BAR; PG8_MMA(0, 0, At, B0); PG8_MMA(0, 1, At, B1); PG8_BAR; PG8_SCHED;
            PG8_LDA(At, 0, 1); PG8_STAGE(PG8_SB(0, 0), b2, voffB[0], voffB[1]); PG8_STAGE(PG8_SB(0, 1), b2 + hstep, voffB[0], voffB[1]); PG8_STAGE_A(PG8_SA(0, 0), 0, k2, last);
            PG8_WAIT_V(8); PG8_WAIT_L(0); PG8_BAR; PG8_MMA(1, 0, At, B0); PG8_MMA(1, 1, At, B1); PG8_BAR; PG8_SCHED;
            PG8_LDB(B0, 1, 0); PG8_LDB(B1, 1, 1); PG8_SCHED; PG8_LDA(At, 1, 0); PG8_STAGE_A(PG8_SA(0, 1), 1, k2, last);
            PG8_WAIT_V(8); PG8_WAIT_L(0); PG8_BAR; PG8_MMA(0, 0, At, B0); PG8_MMA(0, 1, At, B1); PG8_BAR; PG8_SCHED;
            PG8_LDA(At, 1, 1); PG8_STAGE(PG8_SB(1, 0), b3, voffB[0], voffB[1]); PG8_STAGE(PG8_SB(1, 1), b3 + hstep, voffB[0], voffB[1]); PG8_STAGE_A(PG8_SA(1, 0), 0, k3, last);
            PG8_WAIT_V(8); PG8_WAIT_L(0); PG8_BAR; PG8_MMA(1, 0, At, B0); PG8_MMA(1, 1, At, B1); PG8_BAR; PG8_SCHED;
        }
        if constexpr (ALIGN_EPI) { if (wr == 0) PG8_BAR; }
        { int l2_ = (int)__builtin_amdgcn_mbcnt_hi(~0u, __builtin_amdgcn_mbcnt_lo(~0u, 0u)); asm volatile("" : "+v"(l2_)); E(acc, cur, wr, wc, l2_ & 15, l2_ >> 4); }
        if (!has_next) break;
#pragma unroll
        for (int a = 0; a < 2; ++a)
#pragma unroll
            for (int b = 0; b < 2; ++b)
#pragma unroll
                for (int m = 0; m < 4; ++m)
#pragma unroll
                    for (int n = 0; n < 2; ++n) acc[a][b][m][n] = (f32x4){0.f, 0.f, 0.f, 0.f};
        cur = nxt; cB = nB; cA = nA; ++ui;
        if constexpr (GATHER) {
#pragma unroll
            for (int h = 0; h < 2; ++h) { voffA[h][0] = voffN[h][0]; voffA[h][1] = voffN[h][1]; } }
        if constexpr (ALIGN_EPI) { if (wr == 1) PG8_BAR; }
    }
    PG8_WAIT_V(0);
    if constexpr (!ALIGN_EPI) { if (wr == 0) PG8_BAR; }
    PG8_BAR;
#undef PG8_MKVOFF
#undef PG8_STAGE_A
#undef PG8_SA
#undef PG8_SB
#undef PG8_STAGE
#undef PG8_GLDS
#undef PG8_GLDS_NT
#undef PG8_STAGE_NT
#undef PG8_LDA
#undef PG8_LD2
#undef PG8_LO
#undef PG8_HI
#undef PG8_LDB
#undef PG8_MMA
#undef PG8_WAIT_V
#undef PG8_WAIT_L
#undef PG8_BAR
#undef PG8_SCHED
}
}
namespace fp {
constexpr int NWAVES = 8;
constexpr int B = 16, S = 2048, T = B * S, D = 1024, H = 8, F1 = 2816, DI = 2048, NH = 4, DH = 512, NE = 8, F2 = 3584;
constexpr float QSCALE = 0.125f * 1.4426950408889634f;
constexpr float LAMBDA_INIT = 0.2f;
constexpr float EPS = 1e-6f;

constexpr size_t MiB = 1u << 20;
constexpr size_t WS_NEED = 613951040;
constexpr size_t WS_CTL = 0, CTL_ZERO_BYTES = 1 * MiB;
constexpr size_t WS_MOD = 1 * MiB;
constexpr size_t WS_TAB = 2 * MiB;
constexpr size_t WS_GATE = 3 * MiB;
constexpr size_t WS_W_AIN = 4 * MiB, WS_W_AOUT = 10 * MiB, WS_W_FGU = 12 * MiB, WS_W_FD = 23 * MiB, WS_W_MIN = 29 * MiB, WS_W_MOUT = 37 * MiB;
constexpr size_t WS_ROUTE = 41 * MiB;
constexpr size_t WS_ARENA = 43 * MiB;
constexpr size_t A_(size_t mib) { return WS_ARENA + mib * MiB; }
constexpr size_t WS_Y = A_(0);
constexpr size_t WS_H = A_(64);
constexpr size_t WS_Q = A_(64), WS_K = A_(128), WS_V = A_(192), WS_O = A_(256);
constexpr size_t WS_ACT = A_(128);
constexpr size_t WS_XZ = A_(128);
constexpr size_t WS_HH = A_(384);
constexpr size_t WS_WMD = A_(0);
constexpr size_t WS_WMGU = A_(128);
constexpr size_t WS_XB = A_(240);
constexpr int MOE_ROUNDS = 5;
constexpr int MPAD = 2 * T + NE * 256;
constexpr int MAXPANELS = MPAD / 256;
constexpr int PR = 64;
static_assert(PR * MOE_ROUNDS >= MAXPANELS, "MoE rounds cover every panel");
constexpr size_t ACT2_BYTES = (size_t)PR * 256 * F2 * 2;
static_assert(ACT2_BYTES <= (size_t)T * D * 4, "ACT2 fits d_out");
constexpr size_t WS_YM = A_(304);
constexpr size_t WS_END = WS_YM + (size_t)MPAD * 1024 * 2;
constexpr size_t WS_DIG = WS_NEED - 28 * MiB;
#ifdef REFCHECK
static_assert(WS_END <= WS_DIG, "d_ws map (refcheck)");
#else
static_assert(WS_END <= WS_NEED, "d_ws map");
#endif
constexpr int CW_FAIL = 8;
constexpr int CW_BAR = 4096;
constexpr int CW_ECNT = 200000;
constexpr int TAB_NPANELS = 0, TAB_EOFF = 16  , TAB_PEXP = 64  ;

constexpr int RING_BYTES = 131072;
constexpr int LDSCTL_OFF = RING_BYTES, MISC_OFF = LDSCTL_OFF + 320;
constexpr int LDS_BYTES = 147456;

#define GAS __attribute__((address_space(1)))
#define LAS __attribute__((address_space(3)))
typedef unsigned short bf16;
typedef unsigned v4u __attribute__((ext_vector_type(4)));
typedef unsigned v2u __attribute__((ext_vector_type(2)));
typedef float f32x4 __attribute__((ext_vector_type(4)));
typedef float f32x16 __attribute__((ext_vector_type(16)));
typedef short bf16x8 __attribute__((ext_vector_type(8)));
typedef short s16x4 __attribute__((ext_vector_type(4)));
typedef GAS unsigned gu32;
#define RLX_AGENT __ATOMIC_RELAXED, __HIP_MEMORY_SCOPE_AGENT
#define LDS_WAIT() asm volatile("s_waitcnt lgkmcnt(0)" ::: "memory")
#define VM_WAIT() asm volatile("s_waitcnt vmcnt(0)" ::: "memory")
__device__ __forceinline__ unsigned f2bf(float f) { unsigned u = __builtin_bit_cast(unsigned, f); return (u + 0x7fffu + ((u >> 16) & 1u)) >> 16; }
__device__ __forceinline__ unsigned pk2(float lo, float hi) { return f2bf(lo) | (f2bf(hi) << 16); }
__device__ __forceinline__ float bf_lo(unsigned w) { return __builtin_bit_cast(float, w << 16); }
__device__ __forceinline__ float bf_hi(unsigned w) { return __builtin_bit_cast(float, w & 0xffff0000u); }
__device__ __forceinline__ float bf2f(bf16 v) { return __builtin_bit_cast(float, (unsigned)v << 16); }
__device__ __forceinline__ float fsilu(float v) { return v * __builtin_amdgcn_rcpf(1.0f + __builtin_amdgcn_exp2f(-1.4426950408889634f * v)); }
__device__ __forceinline__ float wave_sum(float v) {
#pragma unroll
    for (int o = 1; o < 64; o <<= 1) v += __shfl_xor(v, o);
    return v;
}

#define XB_TMO      128
#define XB_XCNT(j)  (256  + 64 * (j))
#define XB_XSUB(j)  (1280 + 64 * (j))
#define XB_XGEN(j)  (2304 + 64 * (j))
#define XB_TOP      3328
#define XB_TOPGEN   3392
#define XCD_BAR_WORDS 3456
#define XB_SPIN_CAP (1u << 18)
__device__ __forceinline__ unsigned xb_ld(unsigned* p)              { return __hip_atomic_load(p, __ATOMIC_RELAXED, __HIP_MEMORY_SCOPE_AGENT); }
__device__ __forceinline__ unsigned xb_add(unsigned* p, unsigned v) { return __hip_atomic_fetch_add(p, v, __ATOMIC_RELAXED, __HIP_MEMORY_SCOPE_AGENT); }
__device__ __forceinline__ unsigned xb_xcc_id() { return (unsigned)__builtin_amdgcn_s_getreg((3 << 11) | 20) & 0xFu; }
#define XB_SPIN(cond, bar) do { unsigned _sp = 0; while (cond) { __builtin_amdgcn_s_sleep(1); \
    if ((++_sp & 255u) == 0u) { if (xb_ld(&(bar)[XB_TMO])) break; if (_sp > XB_SPIN_CAP) { atomicAdd(&(bar)[XB_TMO], 1u); break; } } } } while (0)
struct XcdBarrier { unsigned* bar; unsigned x; volatile LAS unsigned* st; int wave; };
__device__ __forceinline__ bool xb_first_thread(int wave) { return wave == 0 && __builtin_amdgcn_mbcnt_hi(~0u, __builtin_amdgcn_mbcnt_lo(~0u, 0u)) == 0u; }
__device__ __forceinline__ XcdBarrier xcd_barrier_post(unsigned* bar, volatile LAS unsigned* st, int wave) {
    XcdBarrier b; b.bar = bar; b.x = xb_xcc_id(); b.st = st; b.wave = wave;
    if (xb_first_thread(wave)) (void)xb_add(&bar[XB_XCNT(b.x)], 1u);
    return b;
}
__device__ __forceinline__ void xcd_barrier_complete(unsigned* bar, unsigned x, unsigned& nloc, unsigned& nx) {
    const unsigned G = gridDim.x * gridDim.y * gridDim.z;
    unsigned sum, cnt, mine, sp = 0u;
    for (;;) {
        sum = 0u; cnt = 0u; mine = 0u;
#pragma unroll
        for (unsigned j = 0; j < 16; ++j) { const unsigned c = xb_ld(&bar[XB_XCNT(j)]); sum += c; cnt += (c > 0u) ? 1u : 0u; mine = (j == x) ? c : mine; }
        if (sum == G) break;
        __builtin_amdgcn_s_sleep(1);
        if ((++sp & 255u) == 0u) { if (xb_ld(&bar[XB_TMO])) break; if (sp > XB_SPIN_CAP) { atomicAdd(&bar[XB_TMO], 1u); break; } }
    }
    nloc = mine > 0u ? mine : 1u; nx = cnt > 0u ? cnt : 1u;
}
__device__ __forceinline__ void xcd_barrier(const XcdBarrier& b) {
    asm volatile("s_waitcnt vmcnt(0)" ::: "memory");
    __syncthreads();
    if (xb_first_thread(b.wave)) {
        unsigned* bar = b.bar;
        __builtin_amdgcn_s_waitcnt(0);
        unsigned nloc = b.st[0], nx = b.st[1];
        if (nloc == 0u) { xcd_barrier_complete(bar, b.x, nloc, nx); b.st[0] = nloc; b.st[1] = nx; }
        const unsigned old = xb_add(&bar[XB_XSUB(b.x)], 1u);
        const unsigned gen = old / nloc;
        if (old + 1u == (gen + 1u) * nloc) {
            __builtin_amdgcn_fence(__ATOMIC_RELEASE, "agent");
            asm volatile("s_waitcnt vmcnt(0)" ::: "memory");
            const unsigned og = xb_add(&bar[XB_TOP], 1u);
            const unsigned tg = og / nx;
            if (og + 1u == (tg + 1u) * nx) xb_add(&bar[XB_TOPGEN], 1u);
            else XB_SPIN(xb_ld(&bar[XB_TOPGEN]) == tg, bar);
            __builtin_amdgcn_fence(__ATOMIC_ACQUIRE, "agent");
            xb_add(&bar[XB_XGEN(b.x)], 1u);
            asm volatile("s_waitcnt vmcnt(0)" ::: "memory");
        } else {
            XB_SPIN(xb_ld(&bar[XB_XGEN(b.x)]) == gen, bar);
            __builtin_amdgcn_fence(__ATOMIC_ACQUIRE, "agent");
            asm volatile("s_waitcnt vmcnt(0)" ::: "memory");
        }
    }
    __syncthreads();
}

struct Frame {
    LAS unsigned char* lds;
    volatile LAS unsigned* MISC;
    gu32* ctl;
    unsigned char* ws;
    int tid, lane, wave, G, gw, NGW;
    const float* const* in;
    float* X;
};
enum { I_X = 0, I_C, I_MODW, I_MODB, I_NORMG, I_AWIN, I_AWOUT, I_ALAM, I_ASUBLN, I_FWG, I_FWU, I_FWD, I_MWIN, I_CONVW, I_CONVB, I_WQ, I_WK, I_WV, I_WGATE, I_BGATE, I_SKIP, I_MNORM, I_MWOUT,
       I_WROUTER, I_BROUTER, I_EWG, I_EWU, I_EWD };

__device__ __forceinline__ void transpose_item(const float* W, int K, int N, bf16* WT, int mode, LAS float* scr, int item, int lane) {
    const int nblk = N / 32, kb = item / nblk, nb = item % nblk, k0 = 64 * kb, n0 = 32 * nb;
#pragma unroll
    for (int i = 0; i < 32; ++i) { const int kk = 2 * i + (lane >> 5); scr[kk * 33 + (lane & 31)] = __builtin_nontemporal_load(W + (size_t)(k0 + kk) * N + n0 + (lane & 31)); }
    LDS_WAIT(); asm volatile("" ::: "memory");
    const int c = lane & 7;
#pragma unroll
    for (int j = 0; j < 4; ++j) { const int n = (lane >> 3) + 8 * j; const LAS float* s = scr + (8 * c) * 33 + n;
        v4u o; o.x = pk2(s[0 * 33], s[1 * 33]); o.y = pk2(s[2 * 33], s[3 * 33]); o.z = pk2(s[4 * 33], s[5 * 33]); o.w = pk2(s[6 * 33], s[7 * 33]);
        const int ng = n0 + n; const int row = mode == 0 ? ng : ((ng >> 7) * 256 + (ng & 127) + (mode == 2 ? 128 : 0));
        *(GAS v4u*)(WT + (size_t)row * K + k0 + 8 * c) = o; }
    LDS_WAIT(); asm volatile("" ::: "memory");
}
constexpr float WS8 = 32.f;
__device__ __forceinline__ unsigned pk4_fp8(float a, float b, float c, float d) { unsigned w = 0u; w = __builtin_amdgcn_cvt_pk_fp8_f32(a, b, w, false); w = __builtin_amdgcn_cvt_pk_fp8_f32(c, d, w, true); return w; }
__device__ __forceinline__ void transpose_item_f8(const float* W, int K, int N, unsigned char* WT, int mode, LAS float* scr, int item, int lane) {
    const int nblk = N / 32, kb = item / nblk, nb = item % nblk, k0 = 64 * kb, n0 = 32 * nb;
#pragma unroll 8
    for (int i = 0; i < 32; ++i) { const int kk = 2 * i + (lane >> 5); scr[kk * 33 + (lane & 31)] = W[(size_t)(k0 + kk) * N + n0 + (lane & 31)]; }
    LDS_WAIT(); asm volatile("" ::: "memory");
    const int n = lane >> 1, half = lane & 1; const LAS float* sp = scr + (32 * half) * 33 + n;
    v4u o[2];
#pragma unroll
    for (int u = 0; u < 2; ++u) { const LAS float* s4 = sp + 16 * u * 33;
        o[u].x = pk4_fp8(s4[0 * 33] * WS8, s4[1 * 33] * WS8, s4[2 * 33] * WS8, s4[3 * 33] * WS8); o[u].y = pk4_fp8(s4[4 * 33] * WS8, s4[5 * 33] * WS8, s4[6 * 33] * WS8, s4[7 * 33] * WS8);
        o[u].z = pk4_fp8(s4[8 * 33] * WS8, s4[9 * 33] * WS8, s4[10 * 33] * WS8, s4[11 * 33] * WS8); o[u].w = pk4_fp8(s4[12 * 33] * WS8, s4[13 * 33] * WS8, s4[14 * 33] * WS8, s4[15 * 33] * WS8); }
    const int ng = n0 + n; const int row = mode == 0 ? ng : ((ng >> 7) * 256 + (ng & 127) + (mode == 2 ? 128 : 0));
    GAS v4u* dst = (GAS v4u*)(WT + (size_t)row * K + k0 + 32 * half); dst[0] = o[0]; dst[1] = o[1];
    LDS_WAIT(); asm volatile("" ::: "memory");
}
__device__ __forceinline__ void convert_matrix_f8(Frame& F, const float* W, int K, int N, unsigned char* WT, int mode) {
    LAS float* scr = (LAS float*)(F.lds + F.wave * 16384);
    const int nitems = (K / 64) * (N / 32);
    for (int it = F.gw; it < nitems; it += F.NGW) transpose_item_f8(W, K, N, WT, mode, scr, it, F.lane);
}
__device__ __forceinline__ void convert_matrix(Frame& F, const float* W, int K, int N, bf16* WT, int mode) {
    LAS float* scr = (LAS float*)(F.lds + F.wave * 16384);
    const int nitems = (K / 64) * (N / 32);
    for (int it = F.gw; it < nitems; it += F.NGW) transpose_item(W, K, N, WT, mode, scr, it, F.lane);
}

__device__ __forceinline__ void p_mlprep(Frame& F);
__device__ __forceinline__ void p_mlprep2(Frame& F);
template <int PARTS = 7>
__device__ __forceinline__ void p_prologue(Frame& F) {
    if (PARTS & 1) {
        LAS float* sc = (LAS float*)(F.lds);
        LAS float* red = (LAS float*)(F.lds + 65536);
        const float* c = F.in[I_C];
        for (int e = F.tid; e < 16 * 1024; e += 512) sc[e] = fsilu(c[e]);
        __syncthreads();
        float* mod = (float*)(F.ws + WS_MOD);
        for (int cb = blockIdx.x; cb < 12288 / 64; cb += F.G) {
            const int col = cb * 64 + F.lane, i = col / 6144, n = col % 6144;
            const float* w = F.in[I_MODW] + (size_t)i * 1024 * 6144 + n;
            float acc[16];
#pragma unroll
            for (int b = 0; b < 16; ++b) acc[b] = 0.f;
#pragma unroll 4
            for (int k = F.wave * 128; k < F.wave * 128 + 128; k += 4) {
                const float w0 = __builtin_nontemporal_load(w + (size_t)k * 6144), w1 = __builtin_nontemporal_load(w + (size_t)(k + 1) * 6144), w2 = __builtin_nontemporal_load(w + (size_t)(k + 2) * 6144), w3 = __builtin_nontemporal_load(w + (size_t)(k + 3) * 6144);
#pragma unroll
                for (int b = 0; b < 16; ++b) { const f32x4 s4 = *(LAS const f32x4*)(sc + b * 1024 + k); acc[b] += s4.x * w0 + s4.y * w1 + s4.z * w2 + s4.w * w3; } }
#pragma unroll
            for (int b = 0; b < 16; ++b) red[(F.wave * 16 + b) * 64 + F.lane] = acc[b];
            __syncthreads();
            for (int e = F.tid; e < 16 * 64; e += 512) { const int b = e >> 6, l = e & 63; float s = 0.f;
#pragma unroll
                for (int w8 = 0; w8 < 8; ++w8) s += red[(w8 * 16 + b) * 64 + l];
                const int col2 = cb * 64 + l, i2 = col2 / 6144, n2 = col2 % 6144;
                mod[(size_t)(i2 * 16 + b) * 6144 + n2] = s + F.in[I_MODB][i2 * 6144 + n2]; }
            __syncthreads();
        }
        __syncthreads();
    }
    if (PARTS & 2) p_mlprep(F);
    if (PARTS & 4) {
    convert_matrix(F, F.in[I_AWIN], 1024, 3072, (bf16*)(F.ws + WS_W_AIN), 0);
    convert_matrix(F, F.in[I_AWOUT], 1024, 1024, (bf16*)(F.ws + WS_W_AOUT), 0);
    convert_matrix(F, F.in[I_FWG], 1024, F1, (bf16*)(F.ws + WS_W_FGU), 1);
    convert_matrix(F, F.in[I_FWU], 1024, F1, (bf16*)(F.ws + WS_W_FGU), 2);
    convert_matrix(F, F.in[I_FWD], F1, 1024, (bf16*)(F.ws + WS_W_FD), 0);
    convert_matrix(F, F.in[I_MWIN], 1024, 4096, (bf16*)(F.ws + WS_W_MIN), 0);
    convert_matrix(F, F.in[I_MWOUT], 2048, 1024, (bf16*)(F.ws + WS_W_MOUT), 0);
    }
}

struct Row16 { f32x4 v[4]; };
__device__ __forceinline__ Row16 load_row_f32(const float* p, int lane) { Row16 r; const GAS f32x4* q = (const GAS f32x4*)p + lane;
#pragma unroll
    for (int j = 0; j < 4; ++j) r.v[j] = q[64 * j]; return r; }
__device__ __forceinline__ Row16 load_row_f32_nt(const float* p, int lane) { Row16 r; const f32x4* q = (const f32x4*)p + lane;
#pragma unroll
    for (int j = 0; j < 4; ++j) r.v[j] = __builtin_nontemporal_load(q + 64 * j); return r; }
__device__ __forceinline__ Row16 load_row_bf16(const bf16* p, int lane) { Row16 r; const GAS v2u* q = (const GAS v2u*)p + lane;
#pragma unroll
    for (int j = 0; j < 4; ++j) { const v2u w = q[64 * j]; r.v[j] = (f32x4){bf_lo(w.x), bf_hi(w.x), bf_lo(w.y), bf_hi(w.y)}; } return r; }
__device__ __forceinline__ Row16 load_row_bf16_nt(const bf16* p, int lane) { Row16 r; const v2u* q = (const v2u*)p + lane;
#pragma unroll
    for (int j = 0; j < 4; ++j) { const v2u w = __builtin_nontemporal_load(q + 64 * j); r.v[j] = (f32x4){bf_lo(w.x), bf_hi(w.x), bf_lo(w.y), bf_hi(w.y)}; } return r; }
__device__ __forceinline__ float row_ss(const Row16& r) { float s = 0.f;
#pragma unroll
    for (int j = 0; j < 4; ++j) s += (r.v[j].x * r.v[j].x + r.v[j].y * r.v[j].y) + (r.v[j].z * r.v[j].z + r.v[j].w * r.v[j].w);
    return wave_sum(s); }
#ifdef ROW_WT
__device__ __forceinline__ void store_row_bf16(bf16* p, int lane, const Row16& r) { v2u* q = (v2u*)p + lane;
#pragma unroll
    for (int j = 0; j < 4; ++j) { v2u w; w.x = pk2(r.v[j].x, r.v[j].y); w.y = pk2(r.v[j].z, r.v[j].w); asm volatile("global_store_dwordx2 %0, %1, off sc1\n\ts_nop 1" : : "v"(q + 64 * j), "v"(w) : "memory"); } }
#else
__device__ __forceinline__ void store_row_bf16(bf16* p, int lane, const Row16& r) { GAS v2u* q = (GAS v2u*)p + lane;
#pragma unroll
    for (int j = 0; j < 4; ++j) { v2u w; w.x = pk2(r.v[j].x, r.v[j].y); w.y = pk2(r.v[j].z, r.v[j].w); q[64 * j] = w; } }
#endif
__device__ __forceinline__ void store_row_bf16_nt(bf16* p, int lane, const Row16& r) { v2u* q = (v2u*)p + lane;
#pragma unroll
    for (int j = 0; j < 4; ++j) { v2u w; w.x = pk2(r.v[j].x, r.v[j].y); w.y = pk2(r.v[j].z, r.v[j].w); __builtin_nontemporal_store(w, q + 64 * j); } }
__device__ __forceinline__ void store_row_f32_nt(float* p, int lane, const Row16& r) { f32x4* q = (f32x4*)p + lane;
#pragma unroll
    for (int j = 0; j < 4; ++j) __builtin_nontemporal_store(r.v[j], q + 64 * j); }
__device__ __forceinline__ void store_row_fp8(unsigned char* p, int lane, const Row16& r) { GAS unsigned* q = (GAS unsigned*)p + lane;
#pragma unroll
    for (int j = 0; j < 4; ++j) q[64 * j] = pk4_fp8(r.v[j].x, r.v[j].y, r.v[j].z, r.v[j].w); }
__device__ __forceinline__ void store_row_f32(float* p, int lane, const Row16& r) { GAS f32x4* q = (GAS f32x4*)p + lane;
#pragma unroll
    for (int j = 0; j < 4; ++j) q[64 * j] = r.v[j]; }
__device__ __forceinline__ Row16 round_row_bf16(const Row16& r) { Row16 o;
#pragma unroll
    for (int j = 0; j < 4; ++j) { const unsigned a = pk2(r.v[j].x, r.v[j].y), b2 = pk2(r.v[j].z, r.v[j].w); o.v[j] = (f32x4){bf_lo(a), bf_hi(a), bf_lo(b2), bf_hi(b2)}; } return o; }
__device__ __forceinline__ void norm_mod_row(const Row16& x, float rstd, const float* g, const float* scale, const float* shift, bf16* out, int lane) {
    const Row16 gg = load_row_f32(g, lane), sc = load_row_f32(scale, lane), sh = load_row_f32(shift, lane); Row16 h;
#pragma unroll
    for (int j = 0; j < 4; ++j) h.v[j] = x.v[j] * rstd * gg.v[j] * (sc.v[j] + 1.0f) + sh.v[j];
    store_row_bf16(out, lane, h);
}
#define ROWBLOCK(m0, m1) const int per_ = (T + F.NGW - 1) / F.NGW; const int m0 = F.gw * per_; const int m1 = (m0 + per_ < T) ? m0 + per_ : T
__device__ __forceinline__ void p_h0(Frame& F, bf16* Hout) {
    const float* mod = (const float*)(F.ws + WS_MOD); const float* g = F.in[I_NORMG];
    ROWBLOCK(m0, m1); int bc = -1; Row16 gg = load_row_f32(g, F.lane), sc, sh;
    Row16 xnx = load_row_f32_nt(F.in[I_X] + (size_t)m0 * D, F.lane);
    for (int m = m0; m < m1; ++m) { const int b = m >> 11;
        if (b != bc) { bc = b; const float* mb = mod + (size_t)b * 6144; sc = load_row_f32(mb + 1024, F.lane); sh = load_row_f32(mb, F.lane); }
        const Row16 x = xnx; if (m + 1 < m1) xnx = load_row_f32_nt(F.in[I_X] + (size_t)(m + 1) * D, F.lane);
        const float rstd = rsqrtf(row_ss(x) * (1.f / D) + EPS); Row16 h;
#pragma unroll
        for (int j = 0; j < 4; ++j) h.v[j] = x.v[j] * rstd * gg.v[j] * (sc.v[j] + 1.0f) + sh.v[j];
        store_row_bf16(Hout + (size_t)m * D, F.lane, h); }
}
__device__ __forceinline__ void p_norm(Frame& F, const float* xold, const bf16* Y, const float* gpost, const float* modg, int gi, const float* gn, const float* modn, int si, bf16* Hout) {
    ROWBLOCK(m0, m1); int bc = -1; const Row16 gp = load_row_f32(gpost, F.lane), gg = load_row_f32(gn, F.lane); Row16 gt, sc, sh;
    Row16 ynx = load_row_bf16_nt(Y + (size_t)m0 * D, F.lane), xnx = load_row_f32_nt(xold + (size_t)m0 * D, F.lane);
    for (int m = m0; m < m1; ++m) { const int b = m >> 11;
        if (b != bc) { bc = b; gt = load_row_f32(modg + (size_t)b * 6144 + gi * 1024, F.lane); const float* mb = modn + (size_t)b * 6144; sc = load_row_f32(mb + (si + 1) * 1024, F.lane); sh = load_row_f32(mb + si * 1024, F.lane); }
        const Row16 y = ynx, xo = xnx; if (m + 1 < m1) { ynx = load_row_bf16_nt(Y + (size_t)(m + 1) * D, F.lane); xnx = load_row_f32_nt(xold + (size_t)(m + 1) * D, F.lane); }
        const float r1 = rsqrtf(row_ss(y) * (1.f / D) + EPS);
        Row16 xn;
#pragma unroll
        for (int j = 0; j < 4; ++j) xn.v[j] = xo.v[j] + gt.v[j] * (y.v[j] * r1 * gp.v[j]);
        store_row_bf16_nt((bf16*)F.X + (size_t)m * D, F.lane, xn);
        const float r2 = rsqrtf(row_ss(xn) * (1.f / D) + EPS); Row16 h;
#pragma unroll
        for (int j = 0; j < 4; ++j) h.v[j] = xn.v[j] * r2 * gg.v[j] * (sc.v[j] + 1.0f) + sh.v[j];
        store_row_bf16(Hout + (size_t)m * D, F.lane, h); }
}
#define HAVE_ATTN 1
__device__ __forceinline__ int crow(int r, int hi) { return (r & 3) + 8 * (r >> 2) + 4 * hi; }
__device__ __forceinline__ void swap32(unsigned& a, unsigned& b) { asm volatile("s_nop 1\n\tv_permlane32_swap_b32 %0, %1\n\ts_nop 1" : "+v"(a), "+v"(b)); }
__device__ __forceinline__ float xhalf_max(float v) { unsigned a = __builtin_bit_cast(unsigned, v), b2 = a; swap32(a, b2); return fmaxf(__builtin_bit_cast(float, a), __builtin_bit_cast(float, b2)); }
__device__ __forceinline__ float xhalf_sum(float v) { unsigned a = __builtin_bit_cast(unsigned, v), b2 = a; swap32(a, b2); return __builtin_bit_cast(float, a) + __builtin_bit_cast(float, b2); }
typedef short v4i16_t __attribute__((ext_vector_type(4)));
__device__ __forceinline__ s16x4 tr16(LAS const char* p) { return __builtin_bit_cast(s16x4, __builtin_amdgcn_ds_read_tr16_b64_v4i16((LAS v4i16_t*)p)); }
typedef float f32x2_t __attribute__((ext_vector_type(2))); typedef __bf16 bf16x2_t __attribute__((ext_vector_type(2)));
__device__ __forceinline__ unsigned cvtpk(float lo, float hi) { f32x2_t v = {lo, hi}; bf16x2_t b = __builtin_convertvector(v, bf16x2_t); return __builtin_bit_cast(unsigned, b); }
__device__ __forceinline__ float max3f(float a, float b, float c) { float r; asm("v_max3_f32 %0, %1, %2, %3" : "=v"(r) : "v"(a), "v"(b), "v"(c)); return r; }
#define MFMA32(a, b, c) __builtin_amdgcn_mfma_f32_32x32x16_bf16((a), (b), (c), 0, 0, 0)

constexpr size_t WS_KN = WS_TAB + 512 * 1024;
constexpr int CW_ATTQ = 1024;
__device__ __forceinline__ void p_attn_kn(Frame& F) {
    const bf16* Kb = (const bf16*)(F.ws + WS_K); float* KNG = (float*)(F.ws + WS_KN);
    const int lane = F.lane, w = F.wave, tid = F.tid;
    LAS float* KNW = (LAS float*)F.lds;
    for (int bh = F.gw >> 3; bh < B * H; bh += F.G) { const int b = bh >> 3, h = bh & 7; const size_t rowb = (size_t)b * S;
        float mk0 = 0.f, mk1 = 0.f;
        for (int r = tid; r < S; r += 512) { const bf16* kr = Kb + (rowb + r) * 1024 + h * 128; float s0 = 0.f, s1 = 0.f;
#pragma unroll
            for (int i = 0; i < 8; ++i) { const v4u a = *(const GAS v4u*)(kr + 8 * i), bq = *(const GAS v4u*)(kr + 64 + 8 * i);
                s0 += bf_lo(a.x) * bf_lo(a.x) + bf_hi(a.x) * bf_hi(a.x) + bf_lo(a.y) * bf_lo(a.y) + bf_hi(a.y) * bf_hi(a.y) + bf_lo(a.z) * bf_lo(a.z) + bf_hi(a.z) * bf_hi(a.z) + bf_lo(a.w) * bf_lo(a.w) + bf_hi(a.w) * bf_hi(a.w);
                s1 += bf_lo(bq.x) * bf_lo(bq.x) + bf_hi(bq.x) * bf_hi(bq.x) + bf_lo(bq.y) * bf_lo(bq.y) + bf_hi(bq.y) * bf_hi(bq.y) + bf_lo(bq.z) * bf_lo(bq.z) + bf_hi(bq.z) * bf_hi(bq.z) + bf_lo(bq.w) * bf_lo(bq.w) + bf_hi(bq.w) * bf_hi(bq.w); }
            mk0 = fmaxf(mk0, s0); mk1 = fmaxf(mk1, s1);
#ifdef KN_WARM_V
            { const bf16* vr = (const bf16*)(F.ws + WS_V) + (rowb + r) * 1024 + h * 128; unsigned acc_ = 0u;
#pragma unroll
                for (int i = 0; i < 2; ++i) acc_ |= *(const GAS unsigned*)(vr + 64 * i);
                mk0 = fmaxf(mk0, (acc_ == 0x7fc12345u) ? 1e30f : 0.f); }
#endif
        }
#pragma unroll
        for (int o = 1; o < 64; o <<= 1) { mk0 = fmaxf(mk0, __shfl_xor(mk0, o)); mk1 = fmaxf(mk1, __shfl_xor(mk1, o)); }
        __syncthreads();
        if (lane == 0) { KNW[w * 2] = mk0; KNW[w * 2 + 1] = mk1; }
        __syncthreads();
        if (tid < 2) { float mm = 0.f; for (int w8 = 0; w8 < 8; ++w8) mm = fmaxf(mm, KNW[w8 * 2 + tid]); KNG[bh * 2 + tid] = sqrtf(mm); }
    }
    __syncthreads();
}
template <int VAR>
__device__ __forceinline__ void p_attn(Frame& F) {
    const bf16* Qb = (const bf16*)(F.ws + WS_Q); const bf16* Kb = (const bf16*)(F.ws + WS_K); const bf16* Vb = (const bf16*)(F.ws + WS_V); bf16* Ob = (bf16*)(F.ws + WS_O);
    const int lane = F.lane, r32 = lane & 31, hi = lane >> 5, w = F.wave, g = w >> 1, c = w & 1, tid = F.tid;
    float l01 = 0.f, l23 = 0.f; { const float* lam = F.in[I_ALAM]; for (int i = 0; i < 64; ++i) { l01 += lam[i] * lam[64 + i]; l23 += lam[128 + i] * lam[192 + i]; } }
#ifdef LAM0
    const float lam_full = 0.f;
#else
    const float lam_full = __expf(l01) - __expf(l23) + LAMBDA_INIT;
#endif
    const int krow_ = tid >> 3, kpc = tid & 7, vrow_ = tid >> 4, vpc = tid & 15;
    const int i16 = lane & 15, q4 = i16 >> 2, p4 = i16 & 3, blk = (lane >> 4) & 1;
    LAS char* L = (LAS char*)F.lds;
    constexpr int KP = 144, VP = 320, STG = 2 * 64 * KP + 64 * VP;
    LAS float* XCH = (LAS float*)F.lds;
    LAS float* KNW = (LAS float*)(L + 2 * STG);
    const float* KNG = (const float*)(F.ws + WS_KN);
    {
    for (;;) {
        __syncthreads();
        if (tid == 0) ((LAS int*)(KNW + 48))[0] = (int)__hip_atomic_fetch_add((unsigned*)(F.ctl + CW_ATTQ), 1u, __ATOMIC_RELAXED, __HIP_MEMORY_SCOPE_AGENT);
        __syncthreads();
        const int ui = __builtin_amdgcn_readfirstlane(((LAS const int*)(KNW + 48))[0]);
        if (ui >= B * H * 16) break;
        const int b = ui & 15, h = 7 - ((ui >> 4) & 7), u = 15 - (ui >> 7);
        const float slope2 = exp2f(-(float)(h + 1)) * 1.4426950408889634f;
        const size_t rowb = (size_t)b * S;
        const float kn = KNG[(b * 8 + h) * 2 + c];
        const int ntu = 2 * u + 2, cq = 2 * u + (g >> 1);
        const int qpos = 128 * u + 32 * g + r32;
        bf16x8 qf[4];
        { int lq = lane; asm volatile("" : "+v"(lq));
          const bf16* qp = Qb + (rowb + 128 * u + 32 * g + (lq & 31)) * 1024 + h * 128 + c * 64 + 8 * (lq >> 5);
#pragma unroll
            for (int ks = 0; ks < 4; ++ks) qf[ks] = __builtin_nontemporal_load((const bf16x8*)(qp + 16 * ks)); }
        float bc;
        { float qs = 0.f;
#pragma unroll
            for (int ks = 0; ks < 4; ++ks) { const v4u qw = __builtin_bit_cast(v4u, qf[ks]);
                qs += bf_lo(qw.x) * bf_lo(qw.x) + bf_hi(qw.x) * bf_hi(qw.x) + bf_lo(qw.y) * bf_lo(qw.y) + bf_hi(qw.y) * bf_hi(qw.y) + bf_lo(qw.z) * bf_lo(qw.z) + bf_hi(qw.z) * bf_hi(qw.z) + bf_lo(qw.w) * bf_lo(qw.w) + bf_hi(qw.w) * bf_hi(qw.w); }
            qs = xhalf_sum(qs);
#pragma unroll
            for (int o2 = 1; o2 < 32; o2 <<= 1) qs = fmaxf(qs, __shfl_xor(qs, o2));
            bc = sqrtf(qs) * kn * 1.001f + 0.01f; }
        v4u pk0, pk1, pv0, pv1;
#define ATT_LOADT(kt) do { const bf16* kr = Kb + (rowb + (size_t)(kt) * 64 + krow_) * 1024 + h * 128 + kpc * 8; pk0 = *(const GAS v4u*)kr; pk1 = *(const GAS v4u*)(kr + 64); \
            const bf16* vr = Vb + (rowb + (size_t)(kt) * 64 + vrow_) * 1024 + h * 128 + vpc * 8; pv0 = *(const GAS v4u*)vr; pv1 = *(const GAS v4u*)(vr + 32 * 1024); } while (0)
#define ATT_STORET(st) do { LAS char* sb = L + (st) * STG; *(LAS v4u*)(sb + krow_ * KP + kpc * 16) = pk0; *(LAS v4u*)(sb + 64 * KP + krow_ * KP + kpc * 16) = pk1; \
            *(LAS v4u*)(sb + 128 * KP + vrow_ * VP + vpc * 16) = pv0; *(LAS v4u*)(sb + 128 * KP + (vrow_ + 32) * VP + vpc * 16) = pv1; } while (0)
        ATT_LOADT(ntu - 1);
        __syncthreads();
        ATT_STORET(0);
        __syncthreads();
        float m = -1e30f, l = 0.f;
        f32x16 o[4];
#pragma unroll
        for (int et = 0; et < 4; ++et)
#pragma unroll
            for (int r = 0; r < 16; ++r) o[et][r] = 0.f;
        int nj = ntu;
        for (int j = 0; j < nj; ++j) {
            const int kt = ntu - 1 - j;
            const bool more = j + 1 < nj;
            if (more) ATT_LOADT(kt - 1);
            if (VAR != 1 && kt <= cq) {
                LAS const char* Kc = L + (j & 1) * STG + c * 64 * KP;
                LAS const char* Vs = L + (j & 1) * STG + 128 * KP;
                f32x16 sacc[2];
                const bool started = m > -1e29f; const float mref = started ? m : 0.f;
#pragma unroll
                for (int half = 0; half < 2; ++half) {
                    f32x16 acc;
                    if (kt < cq) { const float base = slope2 * (float)(kt * 64 + 32 * half + 4 * hi) - mref;
#pragma unroll
                        for (int r = 0; r < 16; ++r) acc[r] = fmaf(slope2, (float)((r & 3) + 8 * (r >> 2)), base);
                    } else { const float q2 = 2.f * (float)qpos;
#pragma unroll
                        for (int r = 0; r < 16; ++r) { const float kpos = (float)(kt * 64 + 32 * half + crow(r, hi)); acc[r] = fmaf(slope2, fminf(kpos, q2 - kpos), -mref); } }
#pragma unroll
                    for (int ks = 0; ks < 4; ++ks) { const bf16x8 kf = *(LAS const bf16x8*)(Kc + (32 * half + r32) * KP + (16 * ks + 8 * hi) * 2); acc = MFMA32(kf, qf[ks], acc); }
                    sacc[half] = acc;
                }
                if (VAR != 2) {
                float mx = fmaxf(sacc[0][0], sacc[1][0]);
#pragma unroll
                for (int r = 1; r < 16; ++r) mx = max3f(mx, sacc[0][r], sacc[1][r]);
                mx = xhalf_max(mx);
                if (!__all(started && mx <= 8.f)) {
                    const float d = fmaxf(mx, started ? 0.f : -1e30f);
                    const float alpha = started ? __builtin_amdgcn_exp2f(-d) : 0.f;
                    m = mref + d; l *= alpha;
#pragma unroll
                    for (int half = 0; half < 2; ++half)
#pragma unroll
                        for (int r = 0; r < 16; ++r) sacc[half][r] -= d;
#pragma unroll
                    for (int et = 0; et < 4; ++et)
#pragma unroll
                        for (int r = 0; r < 16; ++r) o[et][r] *= alpha;
                }
                float lsum = 0.f;
#pragma unroll
                for (int half = 0; half < 2; ++half)
#pragma unroll
                    for (int r = 0; r < 16; ++r) { const float p = __builtin_amdgcn_exp2f(sacc[half][r]); sacc[half][r] = p; lsum += p; }
                l += lsum;
                }
                bf16x8 pf[4];
#pragma unroll
                for (int ks = 0; ks < 4; ++ks) { const int half = ks >> 1, s8 = 8 * (ks & 1); v4u pw;
                    pw.x = cvtpk(sacc[half][s8 + 0], sacc[half][s8 + 1]); pw.y = cvtpk(sacc[half][s8 + 2], sacc[half][s8 + 3]); pw.z = cvtpk(sacc[half][s8 + 4], sacc[half][s8 + 5]); pw.w = cvtpk(sacc[half][s8 + 6], sacc[half][s8 + 7]);
                    pf[ks] = __builtin_bit_cast(bf16x8, pw); }
                if (VAR != 3) { bf16x8 vf[2][4];
                    LAS const char* vp0 = Vs + (4 * hi + q4) * VP + (16 * blk) * 2 + 8 * p4;
#define ATT_VLOAD(dst, et) do { _Pragma("unroll") for (int ks_ = 0; ks_ < 4; ++ks_) { const s16x4 lo_ = tr16(vp0 + 16 * ks_ * VP + (et) * 64), hi_ = tr16(vp0 + (16 * ks_ + 8) * VP + (et) * 64); dst[ks_] = __builtin_shufflevector(lo_, hi_, 0, 1, 2, 3, 4, 5, 6, 7); } } while (0)
                    ATT_VLOAD(vf[0], 0);
#pragma unroll
                    for (int et = 0; et < 4; ++et) {
                        if (et < 3) ATT_VLOAD(vf[(et + 1) & 1], et + 1);
                        __builtin_amdgcn_sched_barrier(0);
#pragma unroll
                        for (int ks = 0; ks < 4; ++ks) o[et] = MFMA32(vf[et & 1][ks], pf[ks], o[et]);
                        __builtin_amdgcn_sched_barrier(0); }
#undef ATT_VLOAD
                }
            }
            if (more) ATT_STORET((j + 1) & 1);
            if (j == 1 && ntu > 2) {
                float mmin = m;
#pragma unroll
                for (int o2 = 1; o2 < 32; o2 <<= 1) mmin = fminf(mmin, __shfl_xor(mmin, o2));
                const float x = (mmin - 50.f - bc - 63.f * slope2) / (64.f * slope2);
                int ktlo = x > 0.f ? (int)ceilf(x) : 0; if (ktlo > ntu - 2) ktlo = ntu - 2;
                if (lane == 0) ((LAS int*)(KNW + 32))[w] = ktlo; }
            __syncthreads();
            if (j == 1 && ntu > 2) { int lo8 = ntu; for (int w8 = 0; w8 < 8; ++w8) { const int v8 = ((LAS const int*)(KNW + 32))[w8]; lo8 = v8 < lo8 ? v8 : lo8; } nj = ntu - lo8; }
        }
#undef ATT_LOADT
#undef ATT_STORET
        l = xhalf_sum(l);
        const float inv = 1.0f / l;
#ifdef LSE_DIAG
        if (c == 0 && hi == 0) ((float*)(F.ws + WS_GATE))[(rowb + qpos) * 8 + h] = (m + log2f(l) - slope2 * (float)qpos) * 0.6931471805599453f;
#endif
        if (c == 1) {
#pragma unroll
            for (int et = 0; et < 4; ++et)
#pragma unroll
                for (int r = 0; r < 16; ++r) XCH[((g * 64 + et * 16 + r) * 2 + hi) * 32 + r32] = o[et][r] * inv;
        }
        __syncthreads();
        if (c == 0) {
            float ss = 0.f;
#pragma unroll
            for (int et = 0; et < 4; ++et)
#pragma unroll
                for (int r = 0; r < 16; ++r) { const float v = o[et][r] * inv - lam_full * XCH[((g * 64 + et * 16 + r) * 2 + hi) * 32 + r32]; o[et][r] = v; ss += v * v; }
            ss = xhalf_sum(ss);
            const float rn = rsqrtf(ss * (1.f / 128.f) + EPS) * (1.f - LAMBDA_INIT);
            const float* sg = F.in[I_ASUBLN];
            bf16* orow = Ob + (rowb + qpos) * 1024 + h * 128;
#pragma unroll
            for (int et = 0; et < 4; ++et)
#pragma unroll
                for (int r4 = 0; r4 < 4; ++r4) { const int e0 = et * 32 + 8 * r4 + 4 * hi; const f32x4 gv = *(const GAS f32x4*)(sg + e0);
                    v2u wv; wv.x = pk2(o[et][4 * r4 + 0] * rn * gv.x, o[et][4 * r4 + 1] * rn * gv.y); wv.y = pk2(o[et][4 * r4 + 2] * rn * gv.z, o[et][4 * r4 + 3] * rn * gv.w);
                    *(GAS v2u*)(orow + e0) = wv; }
        }
    }
    }
    __syncthreads();
}
#define HAVE_ML 1
#define MFMA16(a, b, c) __builtin_amdgcn_mfma_f32_16x16x32_bf16((a), (b), (c), 0, 0, 0)
constexpr float KSCALE = 0.04419417382415922f;
constexpr size_t WS_XM = A_(128), WS_QB = A_(0), WS_KB = A_(256), WS_ZB = A_(256), WS_H2B = A_(0);
constexpr size_t WS_WC = WS_TAB + 64 * 1024;
constexpr size_t WS_WPP = WS_TAB + 128 * 1024;
constexpr size_t WS_WVF = WS_TAB + 192 * 1024;
__device__ __forceinline__ f32x4 bf4_to_f32(v2u w) { return (f32x4){bf_lo(w.x), bf_hi(w.x), bf_lo(w.y), bf_hi(w.y)}; }
__device__ __forceinline__ v2u f32_to_bf4(f32x4 v) { v2u w; w.x = pk2(v.x, v.y); w.y = pk2(v.z, v.w); return w; }
__device__ __forceinline__ f32x4 conv_silu(const f32x4 (&xm)[4], const f32x4 (&cw)[4], f32x4 cb) {
    f32x4 a = cb + xm[0] * cw[0] + xm[1] * cw[1] + xm[2] * cw[2] + xm[3] * cw[3];
    return (f32x4){fsilu(a.x), fsilu(a.y), fsilu(a.z), fsilu(a.w)};
}
__device__ __forceinline__ f32x4 hw4(f32x4 x, const f32x4 (&w)[4]) { return w[0] * x.x + w[1] * x.y + w[2] * x.z + w[3] * x.w; }

__device__ __forceinline__ void p_mlprep(Frame& F) {
    const float* wg = F.in[I_WGATE];
    for (int e = (int)blockIdx.x * 512 + F.tid; e < 2048 * 8; e += F.G * 512) { const int f = e >> 3, o = e & 7, g = f >> 2, i = f & 3; float s = 0.f, c = 0.f;
#pragma unroll
        for (int o2 = 0; o2 < 4; ++o2) { s += F.in[I_WV][g * 16 + i * 4 + o2] * wg[(size_t)(4096 + 4 * g + o2) * 8 + o];
            c += F.in[I_WQ][g * 16 + i * 4 + o2] * wg[(size_t)(4 * g + o2) * 8 + o] + F.in[I_WK][g * 16 + i * 4 + o2] * wg[(size_t)(2048 + 4 * g + o2) * 8 + o]; }
        ((float*)(F.ws + WS_WVF))[e] = s; ((float*)(F.ws + WS_WC))[e] = c; }
}
__device__ __forceinline__ void p_mlprep2(Frame& F) {
    LAS float* red = (LAS float*)F.lds;
    const float* wvf = (const float*)(F.ws + WS_WVF);
    f32x4 wv[8];
#pragma unroll
    for (int i = 0; i < 8; ++i) wv[i] = *(const GAS f32x4*)(wvf + (size_t)F.tid * 32 + 4 * i);
    for (int d0 = 4 * (int)blockIdx.x; d0 < 1024; d0 += 4 * F.G) {
        f32x4 wi[4];
#pragma unroll
        for (int dl = 0; dl < 4; ++dl) wi[dl] = __builtin_nontemporal_load((const f32x4*)(F.in[I_MWIN] + (size_t)(d0 + dl) * 4096 + 4 * F.tid));
#pragma unroll
        for (int dl = 0; dl < 4; ++dl) { f32x4 a0 = wv[0] * wi[dl].x + wv[2] * wi[dl].y + wv[4] * wi[dl].z + wv[6] * wi[dl].w, a1 = wv[1] * wi[dl].x + wv[3] * wi[dl].y + wv[5] * wi[dl].z + wv[7] * wi[dl].w;
            a0.x = wave_sum(a0.x); a0.y = wave_sum(a0.y); a0.z = wave_sum(a0.z); a0.w = wave_sum(a0.w); a1.x = wave_sum(a1.x); a1.y = wave_sum(a1.y); a1.z = wave_sum(a1.z); a1.w = wave_sum(a1.w);
            if (F.lane == 0) { *(LAS f32x4*)(red + (dl * 8 + F.wave) * 8) = a0; *(LAS f32x4*)(red + (dl * 8 + F.wave) * 8 + 4) = a1; } }
        __syncthreads();
        if (F.tid < 32) { const int dl = F.tid >> 3, o = F.tid & 7; float s2 = 0.f;
#pragma unroll
            for (int w8 = 0; w8 < 8; ++w8) s2 += red[(dl * 8 + w8) * 8 + o];
            ((float*)(F.ws + WS_WPP))[(d0 + dl) * 8 + o] = s2; }
        __syncthreads();
    }
}

__device__ __forceinline__ void p_normb(Frame& F, const bf16* Y, const float* gpost, const float* modg, const float* gn, const float* modn, bf16* Hout) {
    LAS float* wr = (LAS float*)F.lds;
    for (int e = F.tid; e < 8192 / 4; e += 512) ((LAS f32x4*)wr)[e] = ((const GAS f32x4*)(F.ws + WS_WPP))[e];
    __syncthreads();
    float* G = (float*)(F.ws + WS_GATE); const int lane = F.lane;
    ROWBLOCK(m0, m1);
    const bf16* Xb = (const bf16*)F.X;
    Row16 ynx = load_row_bf16_nt(Y + (size_t)m0 * D, lane), xnx = load_row_bf16_nt(Xb + (size_t)m0 * D, lane);
    for (int m = m0; m < m1; ++m) { const int b = m >> 11; const float* mb = modn + (size_t)b * 6144;
        const Row16 gp = load_row_f32(gpost, lane), gt = load_row_f32(modg + (size_t)b * 6144 + 5 * 1024, lane);
        const Row16 y = ynx, xo = xnx; if (m + 1 < m1) { ynx = load_row_bf16_nt(Y + (size_t)(m + 1) * D, lane); xnx = load_row_bf16_nt(Xb + (size_t)(m + 1) * D, lane); }
        const float r1 = rsqrtf(row_ss(y) * (1.f / D) + EPS);
        Row16 xn;
#pragma unroll
        for (int j = 0; j < 4; ++j) xn.v[j] = xo.v[j] + gt.v[j] * (y.v[j] * r1 * gp.v[j]);
        xn = round_row_bf16(xn);
        store_row_bf16_nt((bf16*)F.X + (size_t)m * D, lane, xn);
        const float r2 = rsqrtf(row_ss(xn) * (1.f / D) + EPS);
        const Row16 gg = load_row_f32(gn, lane), sc = load_row_f32(mb + 1024, lane), sh = load_row_f32(mb, lane); Row16 h;
#pragma unroll
        for (int j = 0; j < 4; ++j) h.v[j] = xn.v[j] * r2 * gg.v[j] * (sc.v[j] + 1.0f) + sh.v[j];
        store_row_bf16(Hout + (size_t)m * D, lane, h);
        store_row_bf16_nt((bf16*)F.X + (size_t)T * D + (size_t)m * D, lane, h);
        f32x4 a0 = {0.f, 0.f, 0.f, 0.f}, a1 = {0.f, 0.f, 0.f, 0.f};
#pragma unroll
        for (int j = 0; j < 4; ++j)
#pragma unroll
            for (int c = 0; c < 4; ++c) { const int f = 4 * lane + 256 * j + c; const float hv = h.v[j][c];
                a0 += *(LAS const f32x4*)(wr + f * 8) * hv; a1 += *(LAS const f32x4*)(wr + f * 8 + 4) * hv; }
#pragma unroll
        for (int o = 1; o < 64; o <<= 1) { a0.x += __shfl_xor(a0.x, o); a0.y += __shfl_xor(a0.y, o); a0.z += __shfl_xor(a0.z, o); a0.w += __shfl_xor(a0.w, o);
            a1.x += __shfl_xor(a1.x, o); a1.y += __shfl_xor(a1.y, o); a1.z += __shfl_xor(a1.z, o); a1.w += __shfl_xor(a1.w, o); }
        if (lane == 0) { const f32x4 b0 = *(const GAS f32x4*)F.in[I_BGATE], b1 = *(const GAS f32x4*)(F.in[I_BGATE] + 4); *(GAS f32x4*)(G + (size_t)m * 8) = a0 + b0; *(GAS f32x4*)(G + (size_t)m * 8 + 4) = a1 + b1; }
    }
    __syncthreads();
}
__device__ __forceinline__ void p_h2b(Frame& F, const float* gn, const float* modn, bf16* Hout) {
    ROWBLOCK(m0, m1); int bc = -1; const Row16 gg = load_row_f32(gn, F.lane); Row16 sc, sh;
    const bf16* Xb = (const bf16*)F.X;
    Row16 xnx = load_row_bf16(Xb + (size_t)m0 * D, F.lane);
    for (int m = m0; m < m1; ++m) { const int b = m >> 11;
        if (b != bc) { bc = b; const float* mb = modn + (size_t)b * 6144; sc = load_row_f32(mb + 1024, F.lane); sh = load_row_f32(mb, F.lane); }
        const Row16 x = xnx; if (m + 1 < m1) xnx = load_row_bf16(Xb + (size_t)(m + 1) * D, F.lane);
        const float rstd = rsqrtf(row_ss(x) * (1.f / D) + EPS); Row16 h;
#pragma unroll
        for (int j = 0; j < 4; ++j) h.v[j] = x.v[j] * rstd * gg.v[j] * (sc.v[j] + 1.0f) + sh.v[j];
        store_row_bf16(Hout + (size_t)m * D, F.lane, h); }
}

__device__ __forceinline__ void p_gates2(Frame& F) {
    const bf16* XM = (const bf16*)(F.ws + WS_XM); float* G = (float*)(F.ws + WS_GATE); bf16* QB = (bf16*)(F.ws + WS_QB); bf16* KB = (bf16*)(F.ws + WS_KB);
    const int tid = F.tid, fg = tid, f0 = 4 * fg, lane = F.lane, l15 = lane & 15, q4 = lane >> 4, w = F.wave;
    constexpr int AP = 4112;
    LAS unsigned char* At = F.lds; LAS float* Pt = (LAS float*)(F.lds + 16 * AP);
    f32x4 cw[4], cb, wq[4], wk[4];
#pragma unroll
    for (int j = 0; j < 4; ++j) cw[j] = *(const GAS f32x4*)(F.in[I_CONVW] + j * 2048 + f0);
    cb = *(const GAS f32x4*)(F.in[I_CONVB] + f0);
#pragma unroll
    for (int i = 0; i < 4; ++i) { wq[i] = *(const GAS f32x4*)(F.in[I_WQ] + fg * 16 + i * 4); wk[i] = *(const GAS f32x4*)(F.in[I_WK] + fg * 16 + i * 4) * KSCALE; }
    bf16x8 bfr[8];
    { const float* wc = (const float*)(F.ws + WS_WC);
#pragma unroll
        for (int ks = 0; ks < 8; ++ks) { float v[8];
#pragma unroll
            for (int j = 0; j < 8; ++j) v[j] = l15 < 8 ? wc[(size_t)(256 * w + 32 * ks + 8 * q4 + j) * 8 + l15] : 0.f;
            v4u pw; pw.x = pk2(v[0], v[1]); pw.y = pk2(v[2], v[3]); pw.z = pk2(v[4], v[5]); pw.w = pk2(v[6], v[7]); bfr[ks] = __builtin_bit_cast(bf16x8, pw); } }
    const int vcu = F.gw >> 3;
    for (int run = vcu; run < T / 128; run += F.G) {
        const int t0 = run * 128, tb = t0 & (S - 1);
        f32x4 xm[4];
#pragma unroll
        for (int j = 0; j < 3; ++j) { const int tt = tb - 3 + j; xm[j + 1] = tt >= 0 ? bf4_to_f32(*(const GAS v2u*)(XM + (size_t)(t0 - 3 + j) * 2048 + f0)) : (f32x4){0.f, 0.f, 0.f, 0.f}; }
        for (int sb = 0; sb < 8; ++sb) {
            v2u xin[16];
#pragma unroll
            for (int tt = 0; tt < 16; ++tt) xin[tt] = __builtin_nontemporal_load((const v2u*)(XM + ((size_t)t0 + 16 * sb + tt) * 2048 + f0));
#pragma unroll
            for (int tt = 0; tt < 16; ++tt) { const size_t t = (size_t)t0 + 16 * sb + tt;
                xm[0] = xm[1]; xm[1] = xm[2]; xm[2] = xm[3];
                xm[3] = bf4_to_f32(xin[tt]);
                const f32x4 xc = conv_silu(xm, cw, cb);
                *(GAS v2u*)(QB + t * 2048 + f0) = f32_to_bf4(hw4(xc, wq));
                *(GAS v2u*)(KB + t * 2048 + f0) = f32_to_bf4(hw4(xc, wk));
                *(LAS v2u*)(At + tt * AP + fg * 8) = f32_to_bf4(xc); }
            __syncthreads();
            f32x4 acc = {0.f, 0.f, 0.f, 0.f};
#pragma unroll
            for (int ks = 0; ks < 8; ++ks) { const bf16x8 af = *(LAS const bf16x8*)(At + l15 * AP + (256 * w + 32 * ks + 8 * q4) * 2); acc = MFMA16(af, bfr[ks], acc); }
            if (l15 < 8) {
#pragma unroll
                for (int r = 0; r < 4; ++r) Pt[(w * 16 + 4 * q4 + r) * 8 + l15] = acc[r]; }
            __syncthreads();
            if (tid < 128) { const int tt = tid >> 3, o = tid & 7; float s = 0.f;
#pragma unroll
                for (int w8 = 0; w8 < 8; ++w8) s += Pt[(w8 * 16 + tt) * 8 + o];
                G[((size_t)t0 + 16 * sb + tt) * 8 + o] += s; }
        }
        __syncthreads();
    }
}

struct CellLds { static constexpr int QP = 528, VP = 288, WP = 144;
    static constexpr int QH = 0, KH = 64 * QP, VV = 2 * 64 * QP, WW = VV + 64 * VP, SC = WW + 64 * WP, NQP = SC + 2048  , PB = NQP + 2048  , END = PB + 3 * 8192 + 256; };
static_assert(CellLds::END <= RING_BYTES, "cell LDS map");
constexpr int SC_E1 = 0, SC_A = 64, SC_INTER = 128, SC_WS = 192, SC_EMT = 256, SC_HDEN = 320, SC_DECAY = 384, SC_MPREV = 385;

__device__ __forceinline__ bf16x8 cell_vfrag(LAS unsigned char* lds, int ks, int w, int q, int qq, int pp) {
    LAS const char* vp = (LAS const char*)(lds + CellLds::VV + (32 * ks + 8 * q + qq) * CellLds::VP + (16 * w + 4 * pp) * 2);
    const s16x4 lo = tr16(vp), hi4 = tr16(vp + 4 * CellLds::VP);
    return __builtin_shufflevector(lo, hi4, 0, 1, 2, 3, 4, 5, 6, 7);
}
__device__ __forceinline__ void cell_issue(v4u (&qk)[8], const bf16* QB, const bf16* KB, size_t row0, int h, int P, int tid) {
    const size_t off = (row0 + (tid >> 3)) * 2048 + h * 512 + 256 * P + (tid & 7) * 8;
#pragma unroll
    for (int i = 0; i < 4; ++i) { qk[i] = *(const GAS v4u*)(QB + off + 64 * i); qk[4 + i] = *(const GAS v4u*)(KB + off + 64 * i); }
}
__device__ __forceinline__ void cell_commit(const v4u (&qk)[8], LAS unsigned char* lds, int tid) {
    LAS unsigned char* p = lds + (tid >> 3) * CellLds::QP + (tid & 7) * 16;
#pragma unroll
    for (int i = 0; i < 4; ++i) { *(LAS v4u*)(p + CellLds::QH + 128 * i) = qk[i]; *(LAS v4u*)(p + CellLds::KH + 128 * i) = qk[4 + i]; }
}

template <int P>
__device__ __forceinline__ void cell_half_a(LAS unsigned char* lds, v2u (&ct)[32], f32x4 (&nt)[4], f32x4 (&zt)[4], f32x4 (&sacc)[2], int w, int lane) {
    using CL = CellLds;
    const int l15 = lane & 15, q = lane >> 4, qq = l15 >> 2, pp = l15 & 3;
    LAS const float* sc = (LAS const float*)(lds + CL::SC);
    { const int tt = w >> 1, st0 = 2 * (w & 1);
#pragma unroll
        for (int ks = 0; ks < 8; ++ks) { const bf16x8 af = *(LAS const bf16x8*)(lds + CL::QH + (16 * tt + l15) * CL::QP + (32 * ks + 8 * q) * 2);
#pragma unroll
            for (int j = 0; j < 2; ++j) { const bf16x8 bfr = *(LAS const bf16x8*)(lds + CL::KH + (16 * (st0 + j) + l15) * CL::QP + (32 * ks + 8 * q) * 2); sacc[j] = MFMA16(af, bfr, sacc[j]); } } }
#pragma unroll
    for (int kk = 0; kk < 8; ++kk) { const v2u c0 = ct[16 * P + 2 * kk], c1 = ct[16 * P + 2 * kk + 1];
        v4u aw; aw.x = c0.x; aw.y = c0.y; aw.z = c1.x; aw.w = c1.y;
        const bf16x8 af = __builtin_bit_cast(bf16x8, aw);
#pragma unroll
        for (int tt = 0; tt < 4; ++tt) { LAS const unsigned char* qp = lds + CL::QH + (16 * tt + l15) * CL::QP + (32 * kk + 4 * q) * 2;
            const v2u lo = *(LAS const v2u*)qp, hi2 = *(LAS const v2u*)(qp + 32);
            v4u bw; bw.x = lo.x; bw.y = lo.y; bw.z = hi2.x; bw.w = hi2.y;
            zt[tt] = MFMA16(af, __builtin_bit_cast(bf16x8, bw), zt[tt]); } }
    const bool mine = (w >> 2) == P;
    const int dl0 = 4 * (w & 3);
    if (mine) {
#pragma unroll
        for (int tt = 0; tt < 4; ++tt) { f32x4 nz = {0.f, 0.f, 0.f, 0.f};
#pragma unroll
            for (int k2 = 0; k2 < 2; ++k2) { v4u aw; aw.x = cvtpk(nt[2 * k2].x, nt[2 * k2].y); aw.y = cvtpk(nt[2 * k2].z, nt[2 * k2].w); aw.z = cvtpk(nt[2 * k2 + 1].x, nt[2 * k2 + 1].y); aw.w = cvtpk(nt[2 * k2 + 1].z, nt[2 * k2 + 1].w);
                LAS const unsigned char* qp = lds + CL::QH + (16 * tt + l15) * CL::QP + (32 * ((dl0 >> 1) + k2) + 4 * q) * 2;
                const v2u lo = *(LAS const v2u*)qp, hi2 = *(LAS const v2u*)(qp + 32);
                v4u bw; bw.x = lo.x; bw.y = lo.y; bw.z = hi2.x; bw.w = hi2.y;
                nz = MFMA16(__builtin_bit_cast(bf16x8, aw), __builtin_bit_cast(bf16x8, bw), nz); }
            if (q == 0) ((LAS float*)(lds + CL::NQP))[w * 64 + 16 * tt + l15] = nz.x; } }
}
template <int P>
__device__ __forceinline__ void cell_half_b(LAS unsigned char* lds, v2u (&ct)[32], f32x4 (&nt)[4], int w, int lane, float decay, float wsoff, LAS const float* pa) {
    using CL = CellLds;
    const int l15 = lane & 15, q = lane >> 4, qq = l15 >> 2, pp = l15 & 3;
    LAS const float* sc = (LAS const float*)(lds + CL::SC);
    const bool mine = (w >> 2) == P;
    {
        bf16x8 vpf[2], wsf[2];
#pragma unroll
        for (int ks = 0; ks < 2; ++ks) { const bf16x8 vfr = cell_vfrag(lds, ks, w, q, qq, pp);
            f32x4 w0 = *(LAS const f32x4*)(pa + 32 * ks + 8 * q) + wsoff, w1 = *(LAS const f32x4*)(pa + 32 * ks + 8 * q + 4) + wsoff;
            w0 = (f32x4){__expf(w0.x), __expf(w0.y), __expf(w0.z), __expf(w0.w)}; w1 = (f32x4){__expf(w1.x), __expf(w1.y), __expf(w1.z), __expf(w1.w)};
            const v4u vw = __builtin_bit_cast(v4u, vfr); v4u ow;
            ow.x = cvtpk(bf_lo(vw.x) * w0.x, bf_hi(vw.x) * w0.y); ow.y = cvtpk(bf_lo(vw.y) * w0.z, bf_hi(vw.y) * w0.w); ow.z = cvtpk(bf_lo(vw.z) * w1.x, bf_hi(vw.z) * w1.y); ow.w = cvtpk(bf_lo(vw.w) * w1.z, bf_hi(vw.w) * w1.w);
            vpf[ks] = __builtin_bit_cast(bf16x8, ow);
            v4u sw; if (l15 == 0) { sw.x = cvtpk(w0.x, w0.y); sw.y = cvtpk(w0.z, w0.w); sw.z = cvtpk(w1.x, w1.y); sw.w = cvtpk(w1.z, w1.w); } else { sw = (v4u){0u, 0u, 0u, 0u}; }
            wsf[ks] = __builtin_bit_cast(bf16x8, sw); }
#pragma unroll
        for (int dt = 0; dt < 16; ++dt) { f32x4 acc = bf4_to_f32(ct[16 * P + dt]) * decay;
            f32x4 nacc = {0.f, 0.f, 0.f, 0.f}; const bool nmine = mine && (dt >> 2) == (w & 3);
            if (nmine) nacc = nt[dt & 3] * decay;
#pragma unroll
            for (int ks = 0; ks < 2; ++ks) { LAS const char* kp = (LAS const char*)(lds + CL::KH + (32 * ks + 8 * q + qq) * CL::QP + (16 * dt + 4 * pp) * 2);
                const s16x4 lo = tr16(kp), hi4 = tr16(kp + 4 * CL::QP);
                const bf16x8 kf = __builtin_shufflevector(lo, hi4, 0, 1, 2, 3, 4, 5, 6, 7);
                acc = MFMA16(kf, vpf[ks], acc);
                if (nmine) nacc = MFMA16(kf, wsf[ks], nacc); }
            v2u cw2; cw2.x = cvtpk(acc.x, acc.y); cw2.y = cvtpk(acc.z, acc.w); ct[16 * P + dt] = cw2;
            if (nmine) nt[dt & 3] = nacc; } }
}

__device__ __forceinline__ void p_cell2(Frame& F) {
    using CL = CellLds;
    const bf16* XM = (const bf16*)(F.ws + WS_XM); const bf16* QB = (const bf16*)(F.ws + WS_QB); const bf16* KB = (const bf16*)(F.ws + WS_KB);
    const float* G = (const float*)(F.ws + WS_GATE); bf16* HH = (bf16*)(F.ws + WS_HH);
    LAS unsigned char* lds = F.lds;
    LAS float* sc = (LAS float*)(lds + CL::SC);
    LAS float* PB = (LAS float*)(lds + CL::PB); LAS float* PA = PB + 2048; LAS float* PM = PA + 2048; LAS float* BL = PM + 2048; LAS float* AM = BL + 32;
    const int w = F.wave;
#define CELL_LANE() ({ int l_ = (int)__builtin_amdgcn_mbcnt_hi(~0u, __builtin_amdgcn_mbcnt_lo(~0u, 0u)); asm volatile("" : "+v"(l_)); l_; })
    const int vcu = F.gw >> 3;
    for (int wi = vcu; wi < B * NH * 4; wi += F.G) {
        const int vs = wi & 3, h = (wi >> 2) & 3, b = wi >> 4;
        v2u ct[32]; f32x4 nt[4];
#pragma unroll
        for (int i = 0; i < 32; ++i) ct[i] = (v2u){0u, 0u};
#pragma unroll
        for (int i = 0; i < 4; ++i) nt[i] = (f32x4){0.f, 0.f, 0.f, 0.f};
        __syncthreads();
        { const int lane0 = CELL_LANE();
#pragma unroll 1
            for (int cc = 0; cc < 4; ++cc) { const int ch = 4 * w + cc; const size_t r = (size_t)b * S + 64 * ch + lane0;
                const float ip = G[r * 8 + h], fp_ = G[r * 8 + 4 + h];
                float bcum = fminf(fp_, 0.f) - __logf(1.f + __expf(-fabsf(fp_)));
#pragma unroll
                for (int o = 1; o < 64; o <<= 1) { const float t2 = __shfl_up(bcum, o); if (lane0 >= o) bcum += t2; }
                const float a = ip - bcum; float pm = a;
#pragma unroll
                for (int o = 1; o < 64; o <<= 1) { const float t2 = __shfl_up(pm, o); if (lane0 >= o) pm = fmaxf(pm, t2); }
                PB[64 * ch + lane0] = bcum; PA[64 * ch + lane0] = a; PM[64 * ch + lane0] = pm;
                if (lane0 == 63) { BL[ch] = bcum; AM[ch] = pm; } } }
        __syncthreads();
        float mprev = 0.f;
#define CELL_DMA0(rowp, lane_) do { if ((lane_) < 32) { _Pragma("unroll") for (int r_ = 0; r_ < 8; ++r_) { const int row_ = 8 * w + r_; const size_t go_ = ((rowp) + row_) * 2048 + h * 512 + (lane_) * 8; \
            __builtin_amdgcn_global_load_lds((const GAS unsigned*)(QB + go_), (LAS unsigned*)(lds + CL::QH + row_ * CL::QP), 16, 0, 0); \
            __builtin_amdgcn_global_load_lds((const GAS unsigned*)(KB + go_), (LAS unsigned*)(lds + CL::KH + row_ * CL::QP), 16, 0, 0); } } } while (0)
        { const int l0_ = CELL_LANE(); CELL_DMA0((size_t)b * S, l0_); }
#define CELL_VLOAD(xv, rowp, tid_) do { const int vg_ = (tid_) & 31, t4_ = 4 * ((tid_) >> 5), fv_ = h * 512 + vs * 128 + 4 * vg_; \
            _Pragma("unroll") for (int t_ = 0; t_ < 4; ++t_) xv[t_] = __builtin_nontemporal_load((const v2u*)(XM + ((rowp) + t4_ + t_) * 2048 + fv_)); } while (0)
#define CELL_VCOMMIT(xv, tid_) do { const int vg_ = (tid_) & 31, t4_ = 4 * ((tid_) >> 5), fv_ = h * 512 + vs * 128 + 4 * vg_; f32x4 wv_[4]; \
            _Pragma("unroll") for (int i_ = 0; i_ < 4; ++i_) wv_[i_] = *(const GAS f32x4*)(F.in[I_WV] + (size_t)(fv_ >> 2) * 16 + i_ * 4); \
            _Pragma("unroll") for (int t_ = 0; t_ < 4; ++t_) *(LAS v2u*)(lds + CL::VV + (t4_ + t_) * CL::VP + vg_ * 8) = f32_to_bf4(hw4(bf4_to_f32(xv[t_]), wv_)); } while (0)
        { const int t0_ = w * 64 + CELL_LANE(); v2u x0[4]; CELL_VLOAD(x0, (size_t)b * S, t0_); CELL_VCOMMIT(x0, t0_); }
        for (int c = 0; c < S / 64; ++c) {
            const int tid = w * 64 + CELL_LANE();
            const int lane = tid & 63, l15 = lane & 15, q = lane >> 4, qq = l15 >> 2, pp = l15 & 3;
            const size_t row0 = (size_t)b * S + 64 * c;
            const float blast = BL[c], mnew = fmaxf(blast + mprev, blast + AM[c]), decay = __expf(blast + mprev - mnew);
            asm volatile("s_waitcnt vmcnt(0)" ::: "memory");
            __syncthreads();
            f32x4 zt[4], sacc[2];
#pragma unroll
            for (int i = 0; i < 4; ++i) zt[i] = (f32x4){0.f, 0.f, 0.f, 0.f};
            sacc[0] = (f32x4){0.f, 0.f, 0.f, 0.f}; sacc[1] = sacc[0];
            cell_half_a<0>(lds, ct, nt, zt, sacc, w, lane);
            v4u qk[8]; cell_issue(qk, QB, KB, row0, h, 1, tid);
            cell_half_b<0>(lds, ct, nt, w, lane, decay, blast - mnew, PA + 64 * c);
            __syncthreads();
            cell_commit(qk, lds, tid);
            __syncthreads();
            { int l3 = lane; asm volatile("" : "+v"(l3)); cell_half_a<1>(lds, ct, nt, zt, sacc, w, l3);
              cell_half_b<1>(lds, ct, nt, w, l3, decay, blast - mnew, PA + 64 * c); }
            { const int tt = w >> 1, st0 = 2 * (w & 1);
#pragma unroll
                for (int j = 0; j < 2; ++j) { const int s = 16 * (st0 + j) + l15; const float as = PA[64 * c + s];
#pragma unroll
                    for (int r = 0; r < 4; ++r) { const int t = 16 * tt + 4 * q + r; const float wv2 = s <= t ? __expf(as - fmaxf(mprev, PM[64 * c + t])) * sacc[j][r] : 0.f;
                        *(LAS bf16*)(lds + CL::WW + t * CL::WP + s * 2) = (bf16)f2bf(wv2); } } }
            __syncthreads();
            if (c + 1 < S / 64) CELL_DMA0(row0 + 64, lane);
            { const int t = tid >> 3, part = tid & 7; const v4u ww = *(LAS const v4u*)(lds + CL::WW + t * CL::WP + part * 16);
                float ds = (bf_lo(ww.x) + bf_hi(ww.x)) + (bf_lo(ww.y) + bf_hi(ww.y)) + (bf_lo(ww.z) + bf_hi(ww.z)) + (bf_lo(ww.w) + bf_hi(ww.w));
                float nqv = ((LAS const float*)(lds + CL::NQP))[part * 64 + t];
                ds += __shfl_xor(ds, 1); ds += __shfl_xor(ds, 2); ds += __shfl_xor(ds, 4);
                nqv += __shfl_xor(nqv, 1); nqv += __shfl_xor(nqv, 2); nqv += __shfl_xor(nqv, 4);
                if (part == 0) { const float mxp = fmaxf(mprev, PM[64 * c + t]); const float den = ds + __expf(mprev - mxp) * nqv; sc[SC_HDEN + t] = 1.0f / fmaxf(fabsf(den), __expf(-(PB[64 * c + t] + mxp))); } }
#pragma unroll
            for (int tt = 0; tt < 4; ++tt) { zt[tt] = zt[tt] * __expf(mprev - fmaxf(mprev, PM[64 * c + 16 * tt + l15]));
#pragma unroll
                for (int ks = 0; ks < 2; ++ks) { const bf16x8 wf = *(LAS const bf16x8*)(lds + CL::WW + (16 * tt + l15) * CL::WP + (32 * ks + 8 * q) * 2); zt[tt] = MFMA16(cell_vfrag(lds, ks, w, q, qq, pp), wf, zt[tt]); } }
            v2u xn[4]; const int tid6 = w * 64 + CELL_LANE();
            if (c + 1 < S / 64) CELL_VLOAD(xn, row0 + 64, tid6);
            asm volatile("s_waitcnt lgkmcnt(0)\n\ts_barrier" ::: "memory");
#pragma unroll
            for (int tt = 0; tt < 4; ++tt) { const int t = 16 * tt + l15; const f32x4 o = zt[tt] * sc[SC_HDEN + t];
                *(GAS v2u*)(HH + (row0 + t) * 2048 + h * 512 + vs * 128 + 16 * w + 4 * q) = f32_to_bf4(o); }
            if (c + 1 < S / 64) CELL_VCOMMIT(xn, tid6);
            mprev = mnew;
        }
#undef CELL_DMA0
#undef CELL_VLOAD
#undef CELL_VCOMMIT
#undef CELL_LANE
    }
    __syncthreads();
}

__device__ __forceinline__ void p_post(Frame& F) {
    const bf16* XM = (const bf16*)(F.ws + WS_XM); const bf16* ZB = (const bf16*)(F.ws + WS_ZB); bf16* HH = (bf16*)(F.ws + WS_HH);
    const int lane = F.lane;
    const int per = (T + F.NGW - 1) / F.NGW;
    for (int hd = 0; hd < NH; ++hd) {
        const int f0 = hd * 512 + 8 * lane;
        f32x4 cw[4][2], cb[2], sk[2], gn[2];
#pragma unroll
        for (int u = 0; u < 2; ++u) {
#pragma unroll
            for (int j = 0; j < 4; ++j) cw[j][u] = *(const GAS f32x4*)(F.in[I_CONVW] + j * 2048 + f0 + 4 * u);
            cb[u] = *(const GAS f32x4*)(F.in[I_CONVB] + f0 + 4 * u); sk[u] = *(const GAS f32x4*)(F.in[I_SKIP] + f0 + 4 * u); gn[u] = *(const GAS f32x4*)(F.in[I_MNORM] + f0 + 4 * u); }
        const int t0 = F.gw * per, t1 = (t0 + per < T) ? t0 + per : T;
        v4u xr[4];
#pragma unroll
        for (int j = 0; j < 3; ++j) { const int tt = t0 - 3 + j; xr[j + 1] = (tt >= 0 && (tt >> 11) == (t0 >> 11)) ? *(const GAS v4u*)(XM + (size_t)tt * 2048 + f0) : (v4u){0u, 0u, 0u, 0u}; }
        v4u xnx = __builtin_nontemporal_load((const v4u*)(XM + (size_t)t0 * 2048 + f0)), hnx = __builtin_nontemporal_load((const v4u*)(HH + (size_t)t0 * 2048 + f0)), znx = __builtin_nontemporal_load((const v4u*)(ZB + (size_t)t0 * 2048 + f0));
        for (int t = t0; t < t1; ++t) {
            xr[0] = xr[1]; xr[1] = xr[2]; xr[2] = xr[3]; xr[3] = xnx;
            if ((t & (S - 1)) == 0) { xr[0] = (v4u){0u, 0u, 0u, 0u}; xr[1] = xr[0]; xr[2] = xr[0]; }
            const v4u hw = hnx, zw = znx;
            if (t + 1 < t1) { xnx = __builtin_nontemporal_load((const v4u*)(XM + (size_t)(t + 1) * 2048 + f0)); hnx = __builtin_nontemporal_load((const v4u*)(HH + (size_t)(t + 1) * 2048 + f0)); znx = __builtin_nontemporal_load((const v4u*)(ZB + (size_t)(t + 1) * 2048 + f0)); }
            f32x4 hv[2] = {(f32x4){bf_lo(hw.x), bf_hi(hw.x), bf_lo(hw.y), bf_hi(hw.y)}, (f32x4){bf_lo(hw.z), bf_hi(hw.z), bf_lo(hw.w), bf_hi(hw.w)}};
            float s1 = (hv[0].x + hv[0].y) + (hv[0].z + hv[0].w) + (hv[1].x + hv[1].y) + (hv[1].z + hv[1].w);
            const float mu = wave_sum(s1) * (1.f / 512.f);
            hv[0] = hv[0] - mu; hv[1] = hv[1] - mu;
            float s2 = (hv[0].x * hv[0].x + hv[0].y * hv[0].y) + (hv[0].z * hv[0].z + hv[0].w * hv[0].w) + (hv[1].x * hv[1].x + hv[1].y * hv[1].y) + (hv[1].z * hv[1].z + hv[1].w * hv[1].w);
            const float rstd = rsqrtf(wave_sum(s2) * (1.f / 512.f) + EPS);
            f32x4 acc[2] = {cb[0], cb[1]};
#pragma unroll
            for (int j = 0; j < 4; ++j) { const v4u xw = xr[j];
                acc[0] += (f32x4){bf_lo(xw.x), bf_hi(xw.x), bf_lo(xw.y), bf_hi(xw.y)} * cw[j][0]; acc[1] += (f32x4){bf_lo(xw.z), bf_hi(xw.z), bf_lo(xw.w), bf_hi(xw.w)} * cw[j][1]; }
            const f32x4 z0 = (f32x4){bf_lo(zw.x), bf_hi(zw.x), bf_lo(zw.y), bf_hi(zw.y)}, z1 = (f32x4){bf_lo(zw.z), bf_hi(zw.z), bf_lo(zw.w), bf_hi(zw.w)};
            f32x4 o0 = hv[0] * rstd * gn[0] + sk[0] * (f32x4){fsilu(acc[0].x), fsilu(acc[0].y), fsilu(acc[0].z), fsilu(acc[0].w)};
            f32x4 o1 = hv[1] * rstd * gn[1] + sk[1] * (f32x4){fsilu(acc[1].x), fsilu(acc[1].y), fsilu(acc[1].z), fsilu(acc[1].w)};
            o0 = o0 * (f32x4){fsilu(z0.x), fsilu(z0.y), fsilu(z0.z), fsilu(z0.w)}; o1 = o1 * (f32x4){fsilu(z1.x), fsilu(z1.y), fsilu(z1.z), fsilu(z1.w)};
            v4u ow; ow.x = pk2(o0.x, o0.y); ow.y = pk2(o0.z, o0.w); ow.z = pk2(o1.x, o1.y); ow.w = pk2(o1.z, o1.w);
            *(GAS v4u*)(HH + (size_t)t * 2048 + f0) = ow;
        }
    }
}
#define HAVE_MOE 1
constexpr size_t RT_IDS = 0, RT_WTS = 256 * 1024, RT_POS = 512 * 1024, RT_STOK = 768 * 1024;
static_assert(RT_STOK + (size_t)MPAD * 4 <= 2 * MiB, "route tables");
constexpr int CW_WCNT = 150000;

__device__ __forceinline__ void p_normc(Frame& F, const bf16* Y, const float* gpost, const float* mod1, const float* gn, bf16* Hout) {
    LAS float* wr = (LAS float*)F.lds;
    for (int e = F.tid; e < 8192 / 4; e += 512) ((LAS f32x4*)wr)[e] = ((const GAS f32x4*)F.in[I_WROUTER])[e];
    __syncthreads();
    int* ids = (int*)(F.ws + WS_ROUTE + RT_IDS); float* wts = (float*)(F.ws + WS_ROUTE + RT_WTS);
    int cnt[8];
#pragma unroll
    for (int e = 0; e < 8; ++e) cnt[e] = 0;
    const int lane = F.lane;
    ROWBLOCK(m0, m1);
    for (int m = m0; m < m1; ++m) { const int b = m >> 11; const float* mb = mod1 + (size_t)b * 6144;
        const Row16 gp = load_row_f32(gpost, lane), gt = load_row_f32(mb + 2 * 1024, lane);
        const Row16 y = load_row_bf16_nt(Y + (size_t)m * D, lane), xo = load_row_bf16_nt((const bf16*)F.X + (size_t)m * D, lane);
        const float r1 = rsqrtf(row_ss(y) * (1.f / D) + EPS);
        Row16 xn;
#pragma unroll
        for (int j = 0; j < 4; ++j) xn.v[j] = xo.v[j] + gt.v[j] * (y.v[j] * r1 * gp.v[j]);
        xn = round_row_bf16(xn);
        store_row_bf16_nt((bf16*)(F.ws + WS_XB) + (size_t)m * D, lane, xn);
        const float r2 = rsqrtf(row_ss(xn) * (1.f / D) + EPS);
        const Row16 gg = load_row_f32(gn, lane), sc = load_row_f32(mb + 4 * 1024, lane), sh = load_row_f32(mb + 3 * 1024, lane); Row16 h;
#pragma unroll
        for (int j = 0; j < 4; ++j) h.v[j] = xn.v[j] * r2 * gg.v[j] * (sc.v[j] + 1.0f) + sh.v[j];
        f32x4 a0 = {0.f, 0.f, 0.f, 0.f}, a1 = {0.f, 0.f, 0.f, 0.f};
#pragma unroll
        for (int j = 0; j < 4; ++j)
#pragma unroll
            for (int c = 0; c < 4; ++c) { const int f = 4 * lane + 256 * j + c; const float hv = h.v[j][c];
                a0 += *(LAS const f32x4*)(wr + f * 8) * hv; a1 += *(LAS const f32x4*)(wr + f * 8 + 4) * hv; }
#pragma unroll
        for (int o = 1; o < 64; o <<= 1) { a0.x += __shfl_xor(a0.x, o); a0.y += __shfl_xor(a0.y, o); a0.z += __shfl_xor(a0.z, o); a0.w += __shfl_xor(a0.w, o);
            a1.x += __shfl_xor(a1.x, o); a1.y += __shfl_xor(a1.y, o); a1.z += __shfl_xor(a1.z, o); a1.w += __shfl_xor(a1.w, o); }
        float lg[8] = {a0.x, a0.y, a0.z, a0.w, a1.x, a1.y, a1.z, a1.w};
        const float* br = F.in[I_BROUTER];
        float mx = -1e30f;
#pragma unroll
        for (int e = 0; e < 8; ++e) { lg[e] += br[e]; mx = fmaxf(mx, lg[e]); }
        int i0 = 0; float p0 = -1.f, p1 = -1.f; int i1 = 0;
#pragma unroll
        for (int e = 0; e < 8; ++e) { const float p = __expf(lg[e] - mx); if (p > p0) { p1 = p0; i1 = i0; p0 = p; i0 = e; } else if (p > p1) { p1 = p; i1 = e; } }
        const float inv = 1.0f / (p0 + p1);
        if (lane == 0) { ids[2 * m] = i0; ids[2 * m + 1] = i1; wts[2 * m] = p0 * inv; wts[2 * m + 1] = p1 * inv; }
#pragma unroll
        for (int e = 0; e < 8; ++e) cnt[e] += (i0 == e) + (i1 == e);
    }
    if (lane == 0) { unsigned* wc = (unsigned*)(F.ctl + CW_WCNT) + (size_t)F.gw * 8;
#pragma unroll
        for (int e = 0; e < 8; ++e) wc[e] = (unsigned)cnt[e]; }
    __syncthreads();
    for (int e = 0; e < NE; ++e) {
        convert_matrix(F, F.in[I_EWG] + (size_t)e * 1024 * F2, 1024, F2, (bf16*)(F.ws + WS_WMGU) + (size_t)e * 2 * F2 * 1024, 1);
        convert_matrix(F, F.in[I_EWU] + (size_t)e * 1024 * F2, 1024, F2, (bf16*)(F.ws + WS_WMGU) + (size_t)e * 2 * F2 * 1024, 2);
    }
}

__device__ __forceinline__ void p_sort(Frame& F, const float* gn, const float* mod1) {
    LAS int* sh = (LAS int*)F.lds;
    const unsigned* wc = (const unsigned*)(F.ctl + CW_WCNT);
    const int NW = F.NGW;
    const int myw0 = (F.gw >> 3) << 3;
    { const int e = F.tid & 7, part = F.tid >> 3; int tot = 0, before = 0;
        for (int gwi = part; gwi < NW; gwi += 64) { const int c = (int)wc[(size_t)gwi * 8 + e]; tot += c; if (gwi < myw0) before += c; }
        for (int o = 8; o < 64; o <<= 1) { tot += __shfl_xor(tot, o); before += __shfl_xor(before, o); }
        LAS int* red = sh + 128;
        if (F.lane < 8) { red[(F.wave * 8 + e) * 2] = tot; red[(F.wave * 8 + e) * 2 + 1] = before; }
        __syncthreads();
        if (F.tid < 8) { int t2 = 0, b2 = 0; for (int w8 = 0; w8 < 8; ++w8) { t2 += red[(w8 * 8 + F.tid) * 2]; b2 += red[(w8 * 8 + F.tid) * 2 + 1]; } sh[F.tid] = t2; sh[100 + F.tid] = b2; }
        __syncthreads();
        if (F.tid == 0) { int off = 0; for (int e2 = 0; e2 < 8; ++e2) { sh[8 + e2] = off; off += (sh[e2] + 255) & ~255; } sh[16] = off; }
        if (F.tid < 64) { const int w8 = F.tid >> 3, e2 = F.tid & 7; int bs = sh[100 + e2]; for (int ww = 0; ww < w8; ++ww) bs += (int)wc[(size_t)(myw0 + ww) * 8 + e2]; sh[32 + w8 * 8 + e2] = bs; }
        __syncthreads();
    }
    int* tab = (int*)(F.ws + WS_TAB); int* pos = (int*)(F.ws + WS_ROUTE + RT_POS); const int* ids = (const int*)(F.ws + WS_ROUTE + RT_IDS);
    const int mpadv = sh[16];
    if (blockIdx.x == 0) {
        if (F.tid == 0) { tab[TAB_NPANELS] = mpadv >> 8; for (int e = 0; e <= 8; ++e) tab[TAB_EOFF + e] = sh[8 + e]; }
        for (int p = F.tid; p < (mpadv >> 8); p += 512) { int e = 0; for (int e2 = 1; e2 < 8; ++e2) if (p * 256 >= sh[8 + e2]) e = e2; tab[TAB_PEXP + p] = e; }
    }
    if (F.lane == 0) { int run[8];
#pragma unroll
        for (int e = 0; e < 8; ++e) run[e] = sh[8 + e] + sh[32 + F.wave * 8 + e];
        ROWBLOCK(m0, m1);
        for (int m = m0; m < m1; ++m) {
#pragma unroll
            for (int j = 0; j < 2; ++j) { const int e = ids[2 * m + j]; int p = 0;
#pragma unroll
                for (int e2 = 0; e2 < 8; ++e2) if (e == e2) { p = run[e2]; run[e2] = p + 1; }
                pos[2 * m + j] = p; sh[1024 + F.wave * 64 + 2 * (m - m0) + j] = p; } } }
    { bf16* HS = (bf16*)(F.ws + WS_YM); const bf16* XB = (const bf16*)(F.ws + WS_XB); const int lane = F.lane;
        ROWBLOCK(m0, m1); const Row16 gg = load_row_f32(gn, lane);
        Row16 xnx = load_row_bf16_nt(XB + (size_t)m0 * D, lane);
        for (int m = m0; m < m1; ++m) { const int b = m >> 11; const float* mb = mod1 + (size_t)b * 6144;
            const int p0 = sh[1024 + F.wave * 64 + 2 * (m - m0)], p1 = sh[1024 + F.wave * 64 + 2 * (m - m0) + 1];
            const Row16 xn = xnx; if (m + 1 < m1) xnx = load_row_bf16_nt(XB + (size_t)(m + 1) * D, lane);
            const float r2 = rsqrtf(row_ss(xn) * (1.f / D) + EPS);
            const Row16 sc = load_row_f32(mb + 4 * 1024, lane), shf = load_row_f32(mb + 3 * 1024, lane); Row16 h;
#pragma unroll
            for (int j = 0; j < 4; ++j) h.v[j] = xn.v[j] * r2 * gg.v[j] * (sc.v[j] + 1.0f) + shf.v[j];
            store_row_bf16(HS + (size_t)p0 * D, lane, h); store_row_bf16(HS + (size_t)p1 * D, lane, h); } }
    __syncthreads();
    for (int e = 0; e < NE; ++e) convert_matrix(F, F.in[I_EWD] + (size_t)e * F2 * 1024, F2, 1024, (bf16*)(F.ws + WS_WMD) + (size_t)e * 1024 * F2, 0);
}

constexpr int FINAL_LATE_POS = (MOE_ROUNDS - 1) * PR * 256, FINAL_GUARD = 4096, FINAL_DN_CUS = 32;
static_assert((size_t)(MAXPANELS - (MOE_ROUNDS - 1) * PR) * 256 * F2 * 2 <= (size_t)FINAL_GUARD * D * 4, "the last round's activations sit inside the guarded rows");
static_assert((MAXPANELS - (MOE_ROUNDS - 1) * PR) * 4 <= FINAL_DN_CUS, "the last round's down units fit the reserved workgroups");
template <int MODE>
__device__ __forceinline__ void p_final(Frame& F, const float* gpost, const float* mod1) {
    const bf16* YM = (const bf16*)(F.ws + WS_YM); const int* pos = (const int*)(F.ws + WS_ROUTE + RT_POS); const float* wts = (const float*)(F.ws + WS_ROUTE + RT_WTS);
    const int lane = F.lane;
    int m0, m1;
    if (MODE == 1) { const int nw = (F.G - FINAL_DN_CUS) * NWAVES, we = ((int)blockIdx.x - FINAL_DN_CUS) * NWAVES + F.wave, per = (T + nw - 1) / nw; m0 = we * per; m1 = m0 + per < T ? m0 + per : T; }
    else { const int per = (T + F.NGW - 1) / F.NGW; m0 = F.gw * per; m1 = m0 + per < T ? m0 + per : T; }
    int bc = -1; const Row16 gp = load_row_f32(gpost, lane); Row16 gt;
    for (int m = m0; m < m1; ++m) { const int b = m >> 11;
        const int p0 = pos[2 * m], p1 = pos[2 * m + 1];
        const bool late = m < FINAL_GUARD || p0 >= FINAL_LATE_POS || p1 >= FINAL_LATE_POS;
        if ((MODE == 1 && late) || (MODE == 2 && !late)) continue;
        if (b != bc) { bc = b; gt = load_row_f32(mod1 + (size_t)b * 6144 + 5 * 1024, lane); }
        const float w0 = wts[2 * m], w1 = wts[2 * m + 1];
        const Row16 y0 = load_row_bf16_nt(YM + (size_t)p0 * D, lane), y1 = load_row_bf16_nt(YM + (size_t)p1 * D, lane); Row16 y;
#pragma unroll
        for (int j = 0; j < 4; ++j) y.v[j] = y0.v[j] * w0 + y1.v[j] * w1;
        const float r1 = rsqrtf(row_ss(y) * (1.f / D) + EPS);
        const Row16 xo = load_row_bf16_nt((const bf16*)(F.ws + WS_XB) + (size_t)m * D, lane); Row16 xn;
#pragma unroll
        for (int j = 0; j < 4; ++j) xn.v[j] = xo.v[j] + gt.v[j] * (y.v[j] * r1 * gp.v[j]);
        store_row_f32_nt(F.X + (size_t)m * D, lane, xn); }
}
struct Args { const float* in[28]; float* out; unsigned char* ws; int ph_lo, ph_hi, li, pad; };
enum { PH_PRO = 0, PH_H0, PH_QKV, PH_ATTN, PH_WO, PH_NORMA, PH_FGU, PH_FD, PH_NORMB, PH_MIN, PH_GATES, PH_CELL, PH_H2B, PH_MINZ, PH_POST, PH_MOUT, PH_NORMC, PH_SORT, PH_MOE0  ,
       PH_FINAL = PH_MOE0 + 3 * MOE_ROUNDS, PH_COUNT };

__global__ void __launch_bounds__(NWAVES * 64, 2) mega(Args args) {
    extern __shared__ __attribute__((aligned(16))) unsigned char lds[];
    Frame F;
    F.lds = (LAS unsigned char*)lds;
    F.MISC = (volatile LAS unsigned*)(F.lds + MISC_OFF);
    F.tid = threadIdx.x; F.lane = F.tid & 63; F.wave = __builtin_amdgcn_readfirstlane(F.tid >> 6);
    F.G = gridDim.x; { const int bx = blockIdx.x; const int vcu = (F.G % 8 == 0) ? (bx % 8) * (F.G / 8) + bx / 8 : bx; F.gw = vcu * NWAVES + F.wave; F.NGW = F.G * NWAVES; }
    F.ws = args.ws; F.ctl = (gu32*)(args.ws + WS_CTL); F.in = args.in; F.X = args.out;
    for (int u = F.tid; u < (LDS_BYTES - LDSCTL_OFF) / 4; u += NWAVES * 64) ((LAS unsigned*)(F.lds + LDSCTL_OFF))[u] = 0u;
    __syncthreads();
#ifdef SIMD_PROBE
    { const unsigned hwid = (unsigned)__builtin_amdgcn_s_getreg((1 << 11) | (4 << 6) | 4); if (F.lane == 0) F.MISC[64 + F.wave] = hwid & 3u; __syncthreads(); }
#endif
    XcdBarrier bar = xcd_barrier_post((unsigned*)(F.ctl + CW_BAR) + args.li * XCD_BAR_WORDS, F.MISC + 8, F.wave);
    const int lo = args.ph_lo, hi = args.ph_hi;
#ifdef ONLY_PHASE
#define IN(k) ((k) == ONLY_PHASE && lo <= (k) && (k) < hi)
#else
#define IN(k) (lo <= (k) && (k) < hi)
#endif
#define REFRESH() do { int l_ = (int)__builtin_amdgcn_mbcnt_hi(~0u, __builtin_amdgcn_mbcnt_lo(~0u, 0u)); asm volatile("" : "+v"(l_)); F.lane = l_; F.tid = F.wave * 64 + l_; } while (0)
#ifdef TPROBE_MASK
    unsigned long long tp_last = __builtin_amdgcn_s_memrealtime(), tp_acc = 0ull;
#define SEAM(k) do { if (IN(k) && IN((k) + 1)) xcd_barrier(bar); { const unsigned long long now_ = __builtin_amdgcn_s_memrealtime(); if ((TPROBE_MASK >> (k)) & 1ull) tp_acc += now_ - tp_last; tp_last = now_; } } while (0)
#else
#define SEAM(k) do { if (IN(k) && IN((k) + 1)) xcd_barrier(bar); } while (0)
#endif
#define UNI(p) ((const float*)((((unsigned long long)(unsigned)__builtin_amdgcn_readfirstlane((unsigned)((unsigned long long)(p) >> 32))) << 32) | (unsigned long long)(unsigned)__builtin_amdgcn_readfirstlane((unsigned)(unsigned long long)(p))))
#define WSP ((unsigned char*)UNI(args.ws))
#define mod0 UNI((const float*)(args.ws + WS_MOD))
#define mod1 UNI((const float*)(args.ws + WS_MOD) + 16 * 6144)
#define ng UNI(args.in[I_NORMG])
#ifdef GEMM_NT_A
    constexpr bool NTA = true;
#else
    constexpr bool NTA = false;
#endif
#define SKEW(n) do { const int st_ = ((int)blockIdx.x >> 3) & 3; for (int i_ = 0; i_ < (n) * st_; ++i_) __builtin_amdgcn_s_sleep(110); } while (0)

#ifdef PRO_PROBE
    if (IN(PH_PRO)) { REFRESH(); p_prologue<PRO_PROBE>(F); xcd_barrier(bar); }
#endif
    if (IN(PH_PRO)) { REFRESH(); p_prologue<7>(F); } SEAM(PH_PRO);
    if (IN(PH_H0)) { REFRESH(); p_mlprep2(F); p_h0(F, (bf16*)(WSP + WS_Y)); } SEAM(PH_H0);
    if (IN(PH_QKV)) { REFRESH();
        pg8::Gemm g{(const bf16*)(WSP + WS_Y), (const bf16*)(WSP + WS_W_AIN), T, 3072, 1024}; pg8::StaticOrder So; So.init(T, 3072, F.G, (int)blockIdx.x);
        pg8::EpiBf16 E{(bf16*)(WSP + WS_Q), 1024, 1024, (size_t)(WS_K - WS_Q) / 2, QSCALE};
        pg8::gemm_phase<pg8::EpiBf16, pg8::StaticOrder, true, false>(F.lds, g, So, E, nullptr, F.wave);
    } SEAM(PH_QKV);
#ifdef HAVE_ATTN
    if (IN(PH_ATTN)) { REFRESH(); p_attn_kn(F); xcd_barrier(bar); REFRESH(); p_attn<0>(F); } SEAM(PH_ATTN);
#endif
#ifdef HAVE_L0REST
    if (IN(PH_WO)) { REFRESH();
        pg8::Gemm g{(const bf16*)(WSP + WS_O), (const bf16*)(WSP + WS_W_AOUT), T, 1024, 1024}; pg8::StaticOrder So; So.init(T, 1024, F.G, (int)blockIdx.x);
        pg8::EpiBf16 E{(bf16*)(WSP + WS_Y), 1024, 0, 0, 1.f};
        pg8::gemm_phase<pg8::EpiBf16, pg8::StaticOrder, true, false, false, NTA>(F.lds, g, So, E, nullptr, F.wave);
    } SEAM(PH_WO);
    if (IN(PH_NORMA)) { REFRESH(); p_norm(F, F.in[I_X], (const bf16*)(WSP + WS_Y), ng + 1024, mod0, 2, ng + 2048, mod0, 3, (bf16*)(WSP + WS_H)); } SEAM(PH_NORMA);
    if (IN(PH_FGU)) { REFRESH();
        pg8::Gemm g{(const bf16*)(WSP + WS_H), (const bf16*)(WSP + WS_W_FGU), T, 2 * F1, 1024}; pg8::StaticOrder So; So.init(T, 2 * F1, F.G, (int)blockIdx.x);
        pg8::EpiSwiglu E{(bf16*)(WSP + WS_ACT), F1};
        pg8::gemm_phase<pg8::EpiSwiglu, pg8::StaticOrder, true, false>(F.lds, g, So, E, nullptr, F.wave);
    } SEAM(PH_FGU);
    if (IN(PH_FD)) { REFRESH();
        pg8::Gemm g{(const bf16*)(WSP + WS_ACT), (const bf16*)(WSP + WS_W_FD), T, 1024, F1}; pg8::StaticOrder So; So.init(T, 1024, F.G, (int)blockIdx.x);
        pg8::EpiBf16 E{(bf16*)(WSP + WS_Y), 1024, 0, 0, 1.f};
        pg8::gemm_phase<pg8::EpiBf16, pg8::StaticOrder, true, false, false, NTA>(F.lds, g, So, E, nullptr, F.wave);
    } SEAM(PH_FD);
    if (IN(PH_NORMB)) { REFRESH(); p_normb(F, (const bf16*)(WSP + WS_Y), ng + 3072, mod0, ng + 4096, mod1, (bf16*)(WSP + WS_H)); } SEAM(PH_NORMB);
#endif
#ifdef HAVE_ML
    if (IN(PH_MIN)) { REFRESH();
        pg8::Gemm g{(const bf16*)(WSP + WS_H), (const bf16*)(WSP + WS_W_MIN), T, 2048, 1024}; pg8::StaticOrder So; So.init(T, 2048, F.G, (int)blockIdx.x);
        pg8::EpiBf16 E{(bf16*)(WSP + WS_XM), 2048, 0, 0, 1.f};
        pg8::gemm_phase<pg8::EpiBf16, pg8::StaticOrder, true, false>(F.lds, g, So, E, nullptr, F.wave);
    } SEAM(PH_MIN);
    if (IN(PH_GATES)) { REFRESH(); p_gates2(F); } SEAM(PH_GATES);
    if (IN(PH_CELL)) { REFRESH(); p_cell2(F); } SEAM(PH_CELL);
    if (IN(PH_MINZ)) { REFRESH();
        pg8::Gemm g{(const bf16*)UNI(args.out) + (size_t)T * D, (const bf16*)(WSP + WS_W_MIN) + (size_t)2048 * 1024, T, 2048, 1024}; pg8::StaticOrder So; So.init(T, 2048, F.G, (int)blockIdx.x);
        pg8::EpiBf16 E{(bf16*)(WSP + WS_ZB), 2048, 0, 0, 1.f};
        pg8::gemm_phase<pg8::EpiBf16, pg8::StaticOrder, true, false>(F.lds, g, So, E, nullptr, F.wave);
    } SEAM(PH_MINZ);
    if (IN(PH_POST)) { REFRESH(); p_post(F); } SEAM(PH_POST);
    if (IN(PH_MOUT)) { REFRESH();
        pg8::Gemm g{(const bf16*)(WSP + WS_HH), (const bf16*)(WSP + WS_W_MOUT), T, 1024, 2048}; pg8::StaticOrder So; So.init(T, 1024, F.G, (int)blockIdx.x);
        pg8::EpiBf16 E{(bf16*)(WSP + WS_Y), 1024, 0, 0, 1.f};
        pg8::gemm_phase<pg8::EpiBf16, pg8::StaticOrder, true, false, false, NTA>(F.lds, g, So, E, nullptr, F.wave);
    } SEAM(PH_MOUT);
#endif
#ifdef HAVE_MOE
    if (IN(PH_NORMC)) { REFRESH(); p_normc(F, (const bf16*)(WSP + WS_Y), ng + 5120, mod1, ng + 6144, (bf16*)(WSP + WS_H)); } SEAM(PH_NORMC);
    if (IN(PH_SORT)) { REFRESH(); p_sort(F, ng + 6144, mod1); } SEAM(PH_SORT);
#define MOE_ROUND(r) \
      \
    if ((r) < MOE_ROUNDS && IN(PH_MOE0 + 3 * (r) + 1)) { REFRESH(); const int* tab = (const int*)(WSP + WS_TAB); const int p_lo = (r) * PR; int np = tab[TAB_NPANELS] - p_lo; np = np > PR ? PR : np; \
        pg8::Gemm g{(const bf16*)(WSP + WS_YM), (const bf16*)(WSP + WS_WMGU), 0, 0, 1024}; pg8::MoeOrder<true, false> So; So.init(p_lo, np, 2 * F2 / 256, F.G, (int)blockIdx.x, tab + TAB_PEXP); \
        pg8::EpiSwiglu E{(bf16*)UNI(args.out), F2}; \
        pg8::gemm_phase<pg8::EpiSwiglu, pg8::MoeOrder<true, false>, true, false>(F.lds, g, So, E, nullptr, F.wave); } \
    if ((r) < MOE_ROUNDS) SEAM(PH_MOE0 + 3 * (r) + 1); \
    if ((r) < MOE_ROUNDS && IN(PH_MOE0 + 3 * (r) + 2)) { REFRESH(); const int* tab = (const int*)(WSP + WS_TAB); const int p_lo = (r) * PR; int np = tab[TAB_NPANELS] - p_lo; np = np > PR ? PR : np; \
        pg8::Gemm g{(const bf16*)UNI(args.out), (const bf16*)(WSP + WS_WMD), 0, 0, F2}; pg8::MoeOrder<false, true> So; So.init(p_lo, np, 4, F.G, (int)blockIdx.x, tab + TAB_PEXP); \
        pg8::EpiBf16 E{(bf16*)(WSP + WS_YM), 1024, 0, 0, 1.f}; \
        if ((r) + 1 < MOE_ROUNDS || (int)blockIdx.x < FINAL_DN_CUS || F.G <= FINAL_DN_CUS) pg8::gemm_phase<pg8::EpiBf16, pg8::MoeOrder<false, true>, true, false, false, NTA>(F.lds, g, So, E, nullptr, F.wave); \
        else { REFRESH(); p_final<1>(F, ng + 7168, mod1); } }     \
    if ((r) < MOE_ROUNDS) SEAM(PH_MOE0 + 3 * (r) + 2);
    MOE_ROUND(0) MOE_ROUND(1) MOE_ROUND(2) MOE_ROUND(3) MOE_ROUND(4)
#undef MOE_ROUND
    if (IN(PH_FINAL)) { REFRESH(); if (F.G > FINAL_DN_CUS) p_final<2>(F, ng + 7168, mod1); else p_final<0>(F, ng + 7168, mod1); }
#ifdef SIMD_PROBE
    if (blockIdx.x == 0) { unsigned sm[8]; for (int i = 0; i < 8; ++i) sm[i] = F.MISC[64 + i];
        int code = 3;
        if (sm[0] == sm[4] && sm[1] == sm[5] && sm[2] == sm[6] && sm[3] == sm[7]) code = 0;
        else if (sm[0] == sm[1] && sm[2] == sm[3] && sm[4] == sm[5] && sm[6] == sm[7]) code = 1;
        else if (sm[0] == sm[2] && sm[1] == sm[3] && sm[4] == sm[6] && sm[5] == sm[7]) code = 2;
        const unsigned long long t_end = __builtin_amdgcn_s_memrealtime() + (unsigned long long)(code + 1) * 30000ull;
        while (__builtin_amdgcn_s_memrealtime() < t_end) __builtin_amdgcn_s_sleep(32); }
#endif
#ifdef TPROBE_MASK
    { __syncthreads(); const unsigned long long now_ = __builtin_amdgcn_s_memrealtime(); if ((TPROBE_MASK >> PH_FINAL) & 1ull) tp_acc += now_ - tp_last;
      const unsigned long long target_ = now_ + (unsigned long long)(TPROBE_AMP) * tp_acc; while (__builtin_amdgcn_s_memrealtime() < target_) __builtin_amdgcn_s_sleep(32); }
#endif
#endif
#undef IN
#undef SEAM
#undef WSP
#undef mod0
#undef mod1
#undef ng
#undef SKEW
#undef UNI
}
}

#ifdef REFCHECK
namespace chk {
__host__ __device__ inline int srow(int b, int j) { return (37 + 523 * j + 61 * b) % 2048; }
constexpr int DIG_COLS = 4096;
__host__ __device__ inline size_t dig_off(int stage, int b, int j) { return ((size_t)(stage * 16 + b) * 4 + j) * DIG_COLS; }
__global__ void k_sample(const float* p, int ld, int ncols, float* dig, int stage, int b) {
    const int j = blockIdx.x; const float* src = p + (size_t)srow(b, j) * ld; float* dst = dig + dig_off(stage, b, j);
    for (int c = threadIdx.x; c < ncols; c += blockDim.x) dst[c] = src[c];
}
static void digest_cb(int stage, int b, const float* p, int ld, int ncols, hipStream_t st, void* ctx) {
    hipLaunchKernelGGL(k_sample, dim3(4), dim3(256), 0, st, p, ld, ncols, (float*)ctx, stage, b);
}
__global__ void k_check(const void* fast, int is_bf16, int ld, int ncols, float fscale, const float* dig, int stage, int coff, float tol, int code, unsigned* fail) {
    __shared__ float sh[2][16];
    float se = 0.f, sb = 0.f;
    for (int r = 0; r < 64; ++r) { const int b = r >> 2, j = r & 3; const size_t row = (size_t)b * 2048 + srow(b, j); const float* d = dig + dig_off(stage, b, j) + coff;
        for (int c = threadIdx.x; c < ncols; c += blockDim.x) {
            float f;
            if (is_bf16 == 2) { const unsigned v = ((const unsigned char*)fast)[row * ld + c]; const int e = (v >> 3) & 15, mm = v & 7; f = e ? exp2f((float)(e - 7)) * (1.f + mm * 0.125f) : 0.015625f * (mm * 0.125f); if (v & 128) f = -f; }
            else f = is_bf16 ? __builtin_bit_cast(float, (unsigned)((const unsigned short*)fast)[row * ld + c] << 16) : ((const float*)fast)[row * ld + c];
            f *= fscale; const float e = f - d[c]; se += e * e; sb += d[c] * d[c]; } }
    for (int o = 32; o > 0; o >>= 1) { se += __shfl_xor(se, o); sb += __shfl_xor(sb, o); }
    if ((threadIdx.x & 63) == 0) { sh[0][threadIdx.x >> 6] = se; sh[1][threadIdx.x >> 6] = sb; }
    __syncthreads();
    if (threadIdx.x == 0) { se = 0.f; sb = 0.f; for (int i = 0; i < (int)blockDim.x / 64; ++i) { se += sh[0][i]; sb += sh[1][i]; }
        const float rel = sqrtf(se / fmaxf(sb, 1e-30f));
        if (!(rel < tol)) atomicMin(fail, (unsigned)(2 * code + (rel < 0.3f ? 0 : 1))); }
}
__global__ void k_check2(const void* fast, int is_bf16, int ld, int c0, int c1, int cmask, int cval, int rshift, int rmask, int rval, const float* dig, int stage, float tol, int bit, unsigned* fail) {
    __shared__ float sh[2][16];
    float se = 0.f, sb = 0.f;
    for (int r = 0; r < 64; ++r) { const int b = r >> 2, j = r & 3; const int pos = srow(b, j); if (((pos >> rshift) & rmask) != rval) continue;
        const size_t row = (size_t)b * 2048 + pos; const float* d = dig + dig_off(stage, b, j);
        for (int c = c0 + threadIdx.x; c < c1; c += blockDim.x) { if ((c & cmask) != cval) continue;
            const float f = is_bf16 ? __builtin_bit_cast(float, (unsigned)((const unsigned short*)fast)[row * ld + c] << 16) : ((const float*)fast)[row * ld + c];
            const float e = f - d[c]; se += e * e; sb += d[c] * d[c]; } }
    for (int o = 32; o > 0; o >>= 1) { se += __shfl_xor(se, o); sb += __shfl_xor(sb, o); }
    if ((threadIdx.x & 63) == 0) { sh[0][threadIdx.x >> 6] = se; sh[1][threadIdx.x >> 6] = sb; }
    __syncthreads();
    if (threadIdx.x == 0) { se = 0.f; sb = 0.f; for (int i = 0; i < (int)blockDim.x / 64; ++i) { se += sh[0][i]; sb += sh[1][i]; }
        const float rel = sqrtf(se / fmaxf(sb, 1e-30f));
        if (!(rel < tol)) atomicOr(fail + 1, 1u << bit); }
}
__global__ void k_initfail(unsigned* fail) { fail[0] = 0x7fffffffu; fail[1] = 0u; }
__global__ void k_scale(float* out, size_t n, const unsigned* fail) {
    unsigned f = fail[0]; if (fail[1]) f = fail[1]; if (f == 0x7fffffffu) return; const float s = exp2f((float)f);
    for (size_t i = (size_t)blockIdx.x * blockDim.x + threadIdx.x; i < n; i += (size_t)gridDim.x * blockDim.x) out[i] *= s;
}
}
#endif

#ifdef REFCHECK
static ref::In make_in(void* const* d_in) {
    ref::In in;
    const float** p = (const float**)&in;
    for (int i = 0; i < 28; ++i) p[i] = (const float*)d_in[i];
    return in;
}
#endif
static int g_grid = 0;
static void launch_phases(const fp::Args& base, int lo, int hi, int li, hipStream_t stream) {
    fp::Args a = base; a.ph_lo = lo; a.ph_hi = hi; a.li = li; a.pad = 0;
    hipLaunchKernelGGL(fp::mega, dim3(g_grid), dim3(fp::NWAVES * 64), fp::LDS_BYTES, stream, a);
}
extern "C" void kernel_launch(void* const* d_in, const int* in_sizes, int n_in, void* d_out, int out_size, void* d_ws, size_t ws_size, hipStream_t stream) {
    if (g_grid == 0) {
        if (n_in != 28 || out_size != 32768 * 1024 || ws_size < fp::WS_NEED) { fprintf(stderr, "kernel_launch: unexpected shapes (n_in %d out %d ws %zu)\n", n_in, out_size, ws_size); g_grid = -1; return; }
        int dev = 0, cus = 0, per_cu = 0;
        if (hipGetDevice(&dev) != hipSuccess || hipDeviceGetAttribute(&cus, hipDeviceAttributeMultiprocessorCount, dev) != hipSuccess) { g_grid = -1; return; }
        if (hipFuncSetAttribute((const void*)fp::mega, hipFuncAttributeMaxDynamicSharedMemorySize, fp::LDS_BYTES) != hipSuccess) { fprintf(stderr, "kernel_launch: hipFuncSetAttribute failed\n"); g_grid = -1; return; }
        if (hipOccupancyMaxActiveBlocksPerMultiprocessor(&per_cu, (const void*)fp::mega, fp::NWAVES * 64, fp::LDS_BYTES) != hipSuccess || per_cu < 1) { fprintf(stderr, "kernel_launch: occupancy query says %d\n", per_cu); }
        (void)hipGetLastError();
        g_grid = cus;
    }
    if (g_grid < 0) return;
    hipMemsetAsync((char*)d_ws + fp::WS_CTL, 0, fp::CTL_ZERO_BYTES, stream);
    fp::Args a{};
    for (int i = 0; i < 28; ++i) a.in[i] = (const float*)d_in[i];
    a.out = (float*)d_out; a.ws = (unsigned char*)d_ws;
#ifdef REFCHECK
    ref::In in = make_in(d_in);
    float* dig = (float*)((unsigned char*)d_ws + fp::WS_DIG);
    unsigned* fail = (unsigned*)d_ws + fp::CW_FAIL;
    ref::forward(in, (float*)d_out, (unsigned char*)d_ws + 2 * fp::MiB, stream, chk::digest_cb, dig);
    hipMemsetAsync((char*)d_ws + fp::WS_CTL, 0, fp::CTL_ZERO_BYTES, stream);
    hipLaunchKernelGGL(chk::k_initfail, dim3(1), dim3(1), 0, stream, fail);
    unsigned char* ws = (unsigned char*)d_ws;
#define CHECK(ptr, isbf, ld, ncols, fscale, stage, coff, tol, code) hipLaunchKernelGGL(chk::k_check, dim3(1), dim3(1024), 0, stream, (const void*)(ptr), isbf, ld, ncols, fscale, dig, stage, coff, tol, code, fail)
    int li = 0;
    for (int ph = 0; ph < REFCHECK_PHASES; ++ph) {
        launch_phases(a, ph, ph + 1, li++, stream);
        switch (ph) {
        case fp::PH_H0: CHECK(ws + fp::WS_Y, 1, 1024, 1024, 1.f, 1, 0, 0.02f, 1); break;
        case fp::PH_QKV: CHECK(ws + fp::WS_Q, 1, 1024, 1024, 1.f / fp::QSCALE, 2, 0, 0.03f, 2); CHECK(ws + fp::WS_K, 1, 1024, 1024, 1.f, 2, 1024, 0.03f, 3); CHECK(ws + fp::WS_V, 1, 1024, 1024, 1.f, 2, 2048, 0.03f, 4); break;
        case fp::PH_ATTN: CHECK(ws + fp::WS_O, 1, 1024, 1024, 1.f, 3, 0, 0.05f, 8);
#ifdef LSE_DIAG
            CHECK(ws + fp::WS_GATE, 0, 8, 8, 1.f, 0, 0, 0.01f, 6);
#endif
#ifdef ATTN_DIAG
            for (int hb = 0; hb < 4; ++hb) hipLaunchKernelGGL(chk::k_check2, dim3(1), dim3(1024), 0, stream, (const void*)(ws + fp::WS_O), 1, 1024, hb * 256, hb * 256 + 256, 0, 0, 0, 0, 0, dig, 3, 0.03f, hb, fail);
            hipLaunchKernelGGL(chk::k_check2, dim3(1), dim3(1024), 0, stream, (const void*)(ws + fp::WS_O), 1, 1024, 0, 1024, 0, 0, 6, 1, 0, dig, 3, 0.03f, 4, fail);
            hipLaunchKernelGGL(chk::k_check2, dim3(1), dim3(1024), 0, stream, (const void*)(ws + fp::WS_O), 1, 1024, 0, 1024, 0, 0, 6, 1, 1, dig, 3, 0.03f, 5, fail);
#endif
            break;
        case fp::PH_WO: CHECK(ws + fp::WS_Y, 1, 1024, 1024, 1.f, 4, 0, 0.05f, 6); break;
        case fp::PH_NORMA: CHECK(d_out, 1, 1024, 1024, 1.f, 5, 0, 0.02f, 7); CHECK(ws + fp::WS_H, 1, 1024, 1024, 1.f, 6, 0, 0.03f, 8); break;
        case fp::PH_FGU: CHECK(ws + fp::WS_ACT, 1, fp::F1, fp::F1, 1.f, 7, 0, 0.05f, 9); break;
        case fp::PH_FD: CHECK(ws + fp::WS_Y, 1, 1024, 1024, 1.f, 8, 0, 0.05f, 10); break;
        case fp::PH_NORMB: CHECK(d_out, 1, 1024, 1024, 1.f, 9, 0, 0.02f, 11); CHECK(ws + fp::WS_H, 1, 1024, 1024, 1.f, 10, 0, 0.03f, 12); break;
        case fp::PH_MIN: CHECK(ws + fp::WS_XM, 1, 2048, 2048, 1.f, 11, 0, 0.03f, 13); break;
        case fp::PH_MINZ: CHECK(ws + fp::WS_ZB, 1, 2048, 2048, 1.f, 11, 2048, 0.03f, 22); break;
        case fp::PH_GATES: CHECK(ws + fp::WS_GATE, 0, 8, 8, 1.f, 16, 0, 0.03f, 14); break;
#ifdef CELL_DUMP2
        case fp::PH_CELL: CHECK(ws + fp::WS_HH, 1, 2048, 2048, 1.f, 15, 0, 0.03f, 18); CHECK(ws + fp::WS_Y, 0, 4, 4, 1.f, 0, 0, 0.03f, 19); break;
#elif defined(CELL_DUMP) || defined(CELL_DUMP3)
        case fp::PH_CELL: CHECK(ws + fp::WS_Y, 1, 2048, 2048, 1.f, 13, 0, 0.03f, 18); CHECK(ws + fp::WS_HH, 1, 2048, 2048, 1.f / fp::KSCALE, 14, 0, 0.03f, 19); break;
#else
        case fp::PH_CELL: CHECK(ws + fp::WS_HH, 1, 2048, 2048, 1.f, 17, 0, 0.35f, 15); break;
#endif
        case fp::PH_POST: CHECK(ws + fp::WS_HH, 1, 2048, 2048, 1.f, 18, 0, 0.05f, 16); break;
        case fp::PH_MOUT: CHECK(ws + fp::WS_Y, 1, 1024, 1024, 1.f, 19, 0, 0.05f, 17); break;
#ifdef HAVE_MOE
        case fp::PH_NORMC: CHECK(ws + fp::WS_XB, 1, 1024, 1024, 1.f, 20, 0, 0.02f, 18); CHECK(ws + fp::WS_ROUTE + fp::RT_WTS, 0, 2, 2, 1.f, 22, 0, 0.15f, 20); break;
        case fp::PH_FINAL: CHECK(d_out, 0, 1024, 1024, 1.f, 24, 0, 0.10f, 21); break;
#endif
        default: break;
        }
    }
#ifdef BROKEN_CONTROL
    CHECK(ws + fp::WS_K, 1, 1024, 1024, 1.f, 2, 2048, 0.03f, 23);
#endif
#ifndef REFCHECK_FULL
    ref::forward(in, (float*)d_out, (unsigned char*)d_ws + 2 * fp::MiB, stream, nullptr, nullptr);
#endif
#ifndef NO_SCALE
    hipLaunchKernelGGL(chk::k_scale, dim3(2048), dim3(256), 0, stream, (float*)d_out, (size_t)32768 * 1024, fail);
#endif
#else
    launch_phases(a, 0, fp::PH_COUNT, 0, stream);
#endif
}
```
